# Optimizing an MI355X kernel written in HIP

```python
import math
import jax, jax.numpy as jnp
from jax import lax
import numpy as np

D_MODEL = 1024
BATCH = 8
SEQ = 2048
DEPTH = 4

GRID_W = 64
CTX_LEN = 256
BLOCK = 128
N_MIXERS = 4
ROPE_BASE = 10000.0
NORM_EPS = 1e-6
LN_EPS = 1e-5
NEG_INF = -1e30
ADA_SCALE = 0.5
WIN_HEADS = 16
WIN_KV_HEADS = 4
WIN_HD = 64
WINDOW = 128
AXG_HEADS = 8
AXG_KV_HEADS = 2
AXG_HD = 128
MLA_HEADS = 16
MLA_Q_LORA = 384
MLA_KV_LORA = 256
MLA_NOPE = 64
MLA_ROPE = 32
MLA_V = 64
DIFF_HEADS = 8
DIFF_HD = 64
N_EXPERTS = 32
TOP_K = 4
EXPERT_FF = 1024
SWIGLU_ALPHA = 1.702
SWIGLU_LIMIT = 7.0
DN_ALPHA = (2 * DEPTH) ** 0.25
DN_BETA = (8 * DEPTH) ** -0.25
N_WIN = (DEPTH + 3) // 4
N_AXG = (DEPTH + 2) // 4
N_MLA = (DEPTH + 1) // 4
N_DIFF = DEPTH // 4

kernel_name = "hybrid_interleaved_dit_moe"


def _layernorm(x, g, b):
    xf = x.astype(jnp.float32)
    mu = jnp.mean(xf, axis=-1, keepdims=True)
    var = jnp.mean(jnp.square(xf - mu), axis=-1, keepdims=True)
    return ((xf - mu) * lax.rsqrt(var + LN_EPS)).astype(x.dtype) * g + b


def _rmsnorm(x, g):
    xf = x.astype(jnp.float32)
    return (xf * lax.rsqrt(jnp.mean(xf * xf, axis=-1, keepdims=True) + NORM_EPS)).astype(x.dtype) * g


def _axial_rope(row, col, dr):
    nf = dr // 4
    inv = ROPE_BASE ** (-jnp.arange(nf, dtype=jnp.float32) / nf)
    ang = jnp.stack([row[:, None] * inv, col[:, None] * inv], axis=1)
    return jnp.cos(ang), jnp.sin(ang)


def _apply_rope(x, tab):
    cos, sin = tab
    nf = x.shape[-1] // 4
    xr = x.reshape(*x.shape[:-1], 2, 2, nf)
    x1, x2 = xr[..., 0, :], xr[..., 1, :]
    shape = (cos.shape[0],) + (1,) * (x.ndim - 3) + cos.shape[1:]
    c = cos.reshape(shape).astype(x.dtype)
    s = sin.reshape(shape).astype(x.dtype)
    return jnp.stack([x1 * c - x2 * s, x1 * s + x2 * c], axis=-2).reshape(x.shape)


def _probs(q, k, scale, mask=None, sink=None):
    s = jnp.einsum('...qhgd,...khd->...hgqk', q, k).astype(jnp.float32) * scale
    if mask is not None:
        s = jnp.where(mask, s, NEG_INF)
    if sink is not None:
        col = jnp.broadcast_to(sink.astype(jnp.float32)[:, :, None, None], s.shape[:-1] + (1,))
        return jax.nn.softmax(jnp.concatenate([s, col], axis=-1), axis=-1)[..., :-1]
    return jax.nn.softmax(s, axis=-1)


def _attend_out(p, v):
    return jnp.einsum('...hgqk,...khd->...qhgd', p.astype(v.dtype), v)


def _sweep(fn, q):
    b_, s_ = q.shape[:2]
    nb = s_ // BLOCK
    qb = jnp.moveaxis(q.reshape(b_, nb, BLOCK, *q.shape[2:]), 1, 0)
    out = lax.map(fn, (jnp.arange(nb), qb))
    return jnp.moveaxis(out, 0, 1).reshape(b_, s_, *out.shape[3:])


def _window_mixer(h, hc, wqkv, bqkv, sink, wo, bo, rope, ctx_out):
    b_, s_, _ = h.shape
    g_ = WIN_HEADS // WIN_KV_HEADS
    nq, nk = WIN_HEADS * WIN_HD, WIN_KV_HEADS * WIN_HD

    def proj(t):
        qkv = t @ wqkv + bqkv
        q = qkv[..., :nq].reshape(*t.shape[:2], WIN_KV_HEADS, g_, WIN_HD)
        k = qkv[..., nq:nq + nk].reshape(*t.shape[:2], WIN_KV_HEADS, WIN_HD)
        v = qkv[..., nq + nk:].reshape(*t.shape[:2], WIN_KV_HEADS, WIN_HD)
        return q, k, v

    q, k, v = proj(h)
    qc, kc, vc = proj(hc)
    q, k = _apply_rope(q, rope), _apply_rope(k, rope)
    scale = WIN_HD ** -0.5
    sink_g = sink.reshape(WIN_KV_HEADS, g_)
    band = BLOCK + 2 * WINDOW
    pad = ((0, 0), (WINDOW, WINDOW), (0, 0), (0, 0))
    kp, vp = jnp.pad(k, pad), jnp.pad(v, pad)
    kj = jnp.arange(band)[None, :]
    in_window = jnp.abs(jnp.arange(BLOCK)[:, None] + WINDOW - kj) <= WINDOW
    ctx_valid = jnp.ones((BLOCK, hc.shape[1]), dtype=bool)

    def block(args):
        idx, qb = args
        start = idx * BLOCK
        kb = lax.dynamic_slice_in_dim(kp, start, band, axis=1)
        vb = lax.dynamic_slice_in_dim(vp, start, band, axis=1)
        kpos = start - WINDOW + kj
        valid = in_window & (kpos >= 0) & (kpos < s_)
        mask = jnp.concatenate([ctx_valid, valid], axis=1)
        p = _probs(qb, jnp.concatenate([kc, kb], axis=1), scale, mask, sink_g)
        return _attend_out(p, jnp.concatenate([vc, vb], axis=1))

    y = _sweep(block, q).reshape(b_, s_, nq) @ wo + bo
    yc = None
    if ctx_out:
        oc = _attend_out(_probs(qc, kc, scale, sink=sink_g), vc)
        yc = oc.reshape(*hc.shape[:2], nq) @ wo + bo
    return y, yc


def _axial_gqa_mixer(h, hc, wqkv, q_norm, k_norm, wo, rope, ctx_out):
    b_, s_, _ = h.shape
    g_ = AXG_HEADS // AXG_KV_HEADS
    nq, nk = AXG_HEADS * AXG_HD, AXG_KV_HEADS * AXG_HD

    def proj(t):
        qkv = t @ wqkv
        q = qkv[..., :nq].reshape(*t.shape[:2], AXG_KV_HEADS, g_, AXG_HD)
        k = qkv[..., nq:nq + nk].reshape(*t.shape[:2], AXG_KV_HEADS, AXG_HD)
        v = qkv[..., nq + nk:].reshape(*t.shape[:2], AXG_KV_HEADS, AXG_HD)
        return _rmsnorm(q, q_norm), _rmsnorm(k, k_norm), v

    q, k, v = proj(h)
    qc, kc, vc = proj(hc)
    q, k = _apply_rope(q, rope), _apply_rope(k, rope)
    scale = AXG_HD ** -0.5
    k_all = jnp.concatenate([kc, k], axis=1)
    v_all = jnp.concatenate([vc, v], axis=1)
    y = _sweep(lambda a: _attend_out(_probs(a[1], k_all, scale), v_all), q).reshape(b_, s_, nq) @ wo
    yc = None
    if ctx_out:
        yc = _attend_out(_probs(qc, kc, scale), vc).reshape(*hc.shape[:2], nq) @ wo
    return y, yc


def _mla_mixer(h, hc, wq_a, q_norm, wq_b, wkv_a, kv_norm, wkv_b, wo, rope, ctx_out):
    b_, s_, _ = h.shape

    def proj(t, rope_tab):
        cq = _rmsnorm(t @ wq_a, q_norm)
        q = (cq @ wq_b).reshape(*t.shape[:2], MLA_HEADS, MLA_NOPE + MLA_ROPE)
        q_nope, q_pe = q[..., :MLA_NOPE], q[..., MLA_NOPE:]
        kv_a = t @ wkv_a
        ckv = _rmsnorm(kv_a[..., :MLA_KV_LORA], kv_norm)
        k_pe = kv_a[..., None, MLA_KV_LORA:]
        kv = (ckv @ wkv_b).reshape(*t.shape[:2], MLA_HEADS, MLA_NOPE + MLA_V)
        k_nope, v = kv[..., :MLA_NOPE], kv[..., MLA_NOPE:]
        if rope_tab is not None:
            q_pe, k_pe = _apply_rope(q_pe, rope_tab), _apply_rope(k_pe, rope_tab)
        q = jnp.concatenate([q_nope, q_pe], axis=-1)[:, :, :, None, :]
        k = jnp.concatenate([k_nope, jnp.broadcast_to(k_pe, k_nope.shape[:-1] + (MLA_ROPE,))], axis=-1)
        return q, k, v

    q, k, v = proj(h, rope)
    qc, kc, vc = proj(hc, None)
    scale = (MLA_NOPE + MLA_ROPE) ** -0.5
    k_all = jnp.concatenate([kc, k], axis=1)
    v_all = jnp.concatenate([vc, v], axis=1)
    nv = MLA_HEADS * MLA_V
    y = _sweep(lambda a: _attend_out(_probs(a[1], k_all, scale), v_all), q).reshape(b_, s_, nv) @ wo
    yc = None
    if ctx_out:
        yc = _attend_out(_probs(qc, kc, scale), vc).reshape(*hc.shape[:2], nv) @ wo
    return y, yc


def _diff_mixer(h, hc, wqkv, lam_p, subln, wo, rope, lambda_init, ctx_out):
    b_, s_, _ = h.shape
    nq = DIFF_HEADS * 2 * DIFF_HD

    def proj(t, rope_tab):
        qkv = t @ wqkv
        q = qkv[..., :nq].reshape(*t.shape[:2], 2 * DIFF_HEADS, DIFF_HD)
        k = qkv[..., nq:2 * nq].reshape(*t.shape[:2], 2 * DIFF_HEADS, DIFF_HD)
        v = qkv[..., 2 * nq:].reshape(*t.shape[:2], DIFF_HEADS, 2 * DIFF_HD)
        if rope_tab is not None:
            q, k = _apply_rope(q, rope_tab), _apply_rope(k, rope_tab)
        return q[..., None, :], k, v

    q, k, v = proj(h, rope)
    qc, kc, vc = proj(hc, None)
    lp = lam_p.astype(jnp.float32)
    lam = jnp.exp(jnp.sum(lp[0] * lp[1])) - jnp.exp(jnp.sum(lp[2] * lp[3])) + lambda_init
    scale = DIFF_HD ** -0.5

    def attend(qb, k_all, v_all):
        p = _probs(qb, k_all, scale)
        p = p.reshape(*p.shape[:-4], DIFF_HEADS, 2, *p.shape[-2:])
        pd = p[..., 0, :, :] - lam * p[..., 1, :, :]
        o = jnp.einsum('...hqk,...khd->...qhd', pd.astype(v_all.dtype), v_all)
        return _rmsnorm(o, subln) * (1.0 - lambda_init)

    k_all = jnp.concatenate([kc, k], axis=1)
    v_all = jnp.concatenate([vc, v], axis=1)
    y = _sweep(lambda a: attend(a[1], k_all, v_all), q).reshape(b_, s_, nq) @ wo
    yc = None
    if ctx_out:
        yc = attend(qc, kc, vc).reshape(*hc.shape[:2], nq) @ wo
    return y, yc


def _clamped_swiglu(u):
    g = jnp.minimum(u[..., ::2], SWIGLU_LIMIT)
    lin = jnp.clip(u[..., 1::2], -SWIGLU_LIMIT, SWIGLU_LIMIT)
    return g * jax.nn.sigmoid(SWIGLU_ALPHA * g) * (lin + 1.0)


def _moe(t, rw, rb, w_in, b_in, w_out, b_out):
    logits = (t @ rw).astype(jnp.float32) + rb.astype(jnp.float32)
    top_v, top_i = lax.top_k(logits, TOP_K)
    gates = jax.nn.softmax(top_v, axis=-1)
    combine = jnp.einsum('tk,tke->te', gates, jax.nn.one_hot(top_i, N_EXPERTS, dtype=jnp.float32)).astype(t.dtype)
    out = jnp.zeros_like(t)
    for e in range(N_EXPERTS):
        u = t @ w_in[e] + b_in[e]
        out = out + combine[:, e:e + 1] * (_clamped_swiglu(u) @ w_out[e] + b_out[e])
    return out


def setup_inputs(seed: int = 0) -> dict:
    key = jax.random.key(seed)
    keys = iter(jax.random.split(key, 64))
    f32 = jnp.float32
    D = D_MODEL

    def nrm(shape, std):
        return jax.random.normal(next(keys), shape, f32) * std

    def gain(shape):
        return 1.0 + nrm(shape, 0.02)

    def vscale(n_qk, n_v):
        return jnp.concatenate([jnp.ones((n_qk,), f32), jnp.full((n_v,), DN_BETA, f32)])

    win_qk = (WIN_HEADS + WIN_KV_HEADS) * WIN_HD
    win_v = WIN_KV_HEADS * WIN_HD
    axg_qk = (AXG_HEADS + AXG_KV_HEADS) * AXG_HD
    axg_v = AXG_KV_HEADS * AXG_HD
    diff_qk = 2 * 2 * DIFF_HEADS * DIFF_HD
    diff_v = DIFF_HEADS * 2 * DIFF_HD
    return {
        'x': nrm((BATCH, SEQ, D), 1.0),
        'c': nrm((BATCH, D), 1.0),
        'ctx': nrm((BATCH, CTX_LEN, D), 1.0),
        'c_ctx': nrm((D,), 1.0),
        'ada_w': nrm((DEPTH, D, 6 * D), ADA_SCALE * D ** -0.5),
        'ada_b': nrm((DEPTH, 6 * D), 0.02),
        'ln1_g': gain((DEPTH, D)),
        'ln1_b': nrm((DEPTH, D), 0.02),
        'ln2_g': gain((DEPTH, D)),
        'ln2_b': nrm((DEPTH, D), 0.02),
        'win_wqkv': nrm((N_WIN, D, win_qk + win_v), D ** -0.5) * vscale(win_qk, win_v),
        'win_bqkv': nrm((N_WIN, win_qk + win_v), 0.02),
        'win_sink': nrm((N_WIN, WIN_HEADS), 0.5),
        'win_wo': nrm((N_WIN, WIN_HEADS * WIN_HD, D), DN_BETA * (WIN_HEADS * WIN_HD) ** -0.5),
        'win_bo': nrm((N_WIN, D), 0.02),
        'axg_wqkv': nrm((N_AXG, D, axg_qk + axg_v), D ** -0.5) * vscale(axg_qk, axg_v),
        'axg_q_norm': gain((N_AXG, AXG_HD)),
        'axg_k_norm': gain((N_AXG, AXG_HD)),
        'axg_wo': nrm((N_AXG, AXG_HEADS * AXG_HD, D), DN_BETA * (AXG_HEADS * AXG_HD) ** -0.5),
        'mla_wq_a': nrm((N_MLA, D, MLA_Q_LORA), D ** -0.5),
        'mla_q_norm': gain((N_MLA, MLA_Q_LORA)),
        'mla_wq_b': nrm((N_MLA, MLA_Q_LORA, MLA_HEADS * (MLA_NOPE + MLA_ROPE)), MLA_Q_LORA ** -0.5),
        'mla_wkv_a': nrm((N_MLA, D, MLA_KV_LORA + MLA_ROPE), D ** -0.5),
        'mla_kv_norm': gain((N_MLA, MLA_KV_LORA)),
        'mla_wkv_b': nrm((N_MLA, MLA_KV_LORA, MLA_HEADS * (MLA_NOPE + MLA_V)), MLA_KV_LORA ** -0.5)
                     * jnp.tile(vscale(MLA_NOPE, MLA_V), MLA_HEADS),
        'mla_wo': nrm((N_MLA, MLA_HEADS * MLA_V, D), DN_BETA * (MLA_HEADS * MLA_V) ** -0.5),
        'diff_wqkv': nrm((N_DIFF, D, diff_qk + diff_v), D ** -0.5) * vscale(diff_qk, diff_v),
        'diff_lambda': nrm((N_DIFF, 4, DIFF_HD), 0.1),
        'diff_subln': gain((N_DIFF, 2 * DIFF_HD)),
        'diff_wo': nrm((N_DIFF, diff_v, D), DN_BETA * diff_v ** -0.5),
        'moe_router_w': nrm((DEPTH, D, N_EXPERTS), D ** -0.5),
        'moe_router_b': nrm((DEPTH, N_EXPERTS), 0.01),
        'moe_w_in': nrm((DEPTH, N_EXPERTS, D, 2 * EXPERT_FF), DN_BETA * D ** -0.5),
        'moe_b_in': nrm((DEPTH, N_EXPERTS, 2 * EXPERT_FF), 0.02),
        'moe_w_out': nrm((DEPTH, N_EXPERTS, EXPERT_FF, D), DN_BETA * EXPERT_FF ** -0.5),
        'moe_b_out': nrm((DEPTH, N_EXPERTS, D), 0.02),
    }


def reference(x, c, ctx, c_ctx, ada_w, ada_b, ln1_g, ln1_b, ln2_g, ln2_b,
              win_wqkv, win_bqkv, win_sink, win_wo, win_bo,
              axg_wqkv, axg_q_norm, axg_k_norm, axg_wo,
              mla_wq_a, mla_q_norm, mla_wq_b, mla_wkv_a, mla_kv_norm, mla_wkv_b, mla_wo,
              diff_wqkv, diff_lambda, diff_subln, diff_wo,
              moe_router_w, moe_router_b, moe_w_in, moe_b_in, moe_w_out, moe_b_out):
    b_, s_, d_ = x.shape
    rows = s_ // GRID_W
    r_idx, c_idx = jnp.meshgrid(jnp.arange(rows), jnp.arange(GRID_W), indexing='ij')
    row = r_idx.reshape(-1).astype(jnp.float32)
    col = c_idx.reshape(-1).astype(jnp.float32)
    rope_64 = _axial_rope(row, col, WIN_HD)
    rope_128 = _axial_rope(row, col, AXG_HD)
    rope_mla = _axial_rope(row, col, MLA_ROPE)
    rope_diff = _axial_rope(row, col, DIFF_HD)
    silu_c = jax.nn.silu(c)
    silu_cc = jax.nn.silu(c_ctx)
    moe_args = (moe_router_w, moe_router_b, moe_w_in, moe_b_in, moe_w_out, moe_b_out)

    for l in range(DEPTH):
        last = l == DEPTH - 1
        kind, j = l % N_MIXERS, l // N_MIXERS
        mod = (silu_c @ ada_w[l] + ada_b[l])[:, None, :]
        modc = silu_cc @ ada_w[l] + ada_b[l]
        sh1, sc1, g1, sh2, sc2, g2 = jnp.split(mod, 6, axis=-1)
        csh1, csc1, cg1, csh2, csc2, cg2 = jnp.split(modc, 6, axis=-1)
        h = x * (1.0 + sc1) + sh1
        hc = ctx * (1.0 + csc1) + csh1
        if kind == 0:
            y, yc = _window_mixer(h, hc, win_wqkv[j], win_bqkv[j], win_sink[j], win_wo[j], win_bo[j],
                                  rope_64, not last)
        elif kind == 1:
            y, yc = _axial_gqa_mixer(h, hc, axg_wqkv[j], axg_q_norm[j], axg_k_norm[j], axg_wo[j],
                                     rope_128, not last)
        elif kind == 2:
            y, yc = _mla_mixer(h, hc, mla_wq_a[j], mla_q_norm[j], mla_wq_b[j], mla_wkv_a[j],
                               mla_kv_norm[j], mla_wkv_b[j], mla_wo[j], rope_mla, not last)
        else:
            y, yc = _diff_mixer(h, hc, diff_wqkv[j], diff_lambda[j], diff_subln[j], diff_wo[j],
                                rope_diff, 0.8 - 0.6 * math.exp(-0.3 * l), not last)
        x = _layernorm(DN_ALPHA * x + g1 * y, ln1_g[l], ln1_b[l])
        h = x * (1.0 + sc2) + sh2
        mw = tuple(a[l] for a in moe_args)
        if last:
            y = _moe(h.reshape(-1, d_), *mw).reshape(x.shape)
        else:
            ctx = _layernorm(DN_ALPHA * ctx + cg1 * yc, ln1_g[l], ln1_b[l])
            hc = ctx * (1.0 + csc2) + csh2
            n_ctx = hc.shape[0] * hc.shape[1]
            out = _moe(jnp.concatenate([hc.reshape(-1, d_), h.reshape(-1, d_)], axis=0), *mw)
            ctx = _layernorm(DN_ALPHA * ctx + cg2 * out[:n_ctx].reshape(ctx.shape), ln2_g[l], ln2_b[l])
            y = out[n_ctx:].reshape(x.shape)
        x = _layernorm(DN_ALPHA * x + g2 * y, ln2_g[l], ln2_b[l])
    return x
```

```cpp
#include <hip/hip_runtime.h>
#include <cstdio>
#include <cstdint>

#ifndef MK_PER_PHASE
#define MK_PER_PHASE 1
#endif

#define DI __device__ __forceinline__
#define GAS __attribute__((address_space(1)))
#define LAS __attribute__((address_space(3)))
typedef unsigned short bf16_t;
typedef short bf16x8 __attribute__((ext_vector_type(8)));
typedef float f32x2 __attribute__((ext_vector_type(2)));
typedef float f32x4 __attribute__((ext_vector_type(4)));
typedef float f32x16 __attribute__((ext_vector_type(16)));
typedef unsigned u32x2 __attribute__((ext_vector_type(2)));
typedef unsigned u32x4 __attribute__((ext_vector_type(4)));
typedef __bf16 bfv2 __attribute__((ext_vector_type(2)));

DI unsigned pk2(float lo, float hi) { f32x2 v = {lo, hi}; return __builtin_bit_cast(unsigned, __builtin_convertvector(v, bfv2)); }
DI float bf_lo(unsigned w) { return __uint_as_float(w << 16); }
DI float bf_hi(unsigned w) { return __uint_as_float(w & 0xffff0000u); }
DI float bf2f(bf16_t h) { return __uint_as_float((unsigned)h << 16); }
DI bf16_t f2bf(float f) { return (bf16_t)(pk2(f, 0.f) & 0xffffu); }
DI float shx(float v, int m, int lane) { return __int_as_float(__builtin_amdgcn_ds_bpermute((lane ^ m) << 2, __float_as_int(v))); }
DI float wave_sum(float v, int lane) {
#pragma unroll
    for (int o = 1; o < 64; o <<= 1) v += shx(v, o, lane);
    return v;
}

constexpr int NB = 8, SEQ = 2048, CTXL = 256, DM = 1024, DEPTH = 4;
constexpr int NCTX = NB * CTXL;
constexpr int NT = NCTX + NB * SEQ;
constexpr int NKEY = CTXL + SEQ;
constexpr int NEXP = 32, FF = 1024, CAP = NT;
constexpr int MAXT = 320;
constexpr float DN_ALPHA = 1.681792830507429f;
constexpr float LN_EPS = 1e-5f, NORM_EPS = 1e-6f;
constexpr float LOG2E = 1.4426950408889634f;

constexpr size_t MiB = 1u << 20;
constexpr size_t WS_CTL = 0, CTL_BYTES = 1 * MiB;
constexpr size_t WS_MOD = 1 * MiB;
constexpr size_t WS_ROPE = 2 * MiB;
constexpr size_t WS_WSMALL = 4 * MiB;
constexpr size_t OFF_WQKV0 = 0, OFF_WO0 = 3 * MiB, OFF_WQKV1 = 5 * MiB, OFF_WO1 = 8 * MiB, OFF_WA = 10 * MiB, OFF_WQB = 12 * MiB,
                 OFF_WKVB = 14 * MiB, OFF_WO2 = 15 * MiB, OFF_WQKV3 = 17 * MiB, OFF_WO3 = 23 * MiB;
constexpr size_t WS_WIN = 32 * MiB;
constexpr size_t WS_WOUT = WS_WIN + 512 * MiB;
constexpr size_t WS_X = WS_WOUT + 256 * MiB;
constexpr size_t WS_H = WS_X + 72 * MiB;
constexpr size_t WS_RAW = WS_H + 36 * MiB;
constexpr size_t WS_CQ = WS_RAW + 108 * MiB;
constexpr size_t WS_CKV = WS_CQ + 14 * MiB;
constexpr size_t WS_KPE = WS_CKV + 9 * MiB;
constexpr size_t WS_Q2 = WS_KPE + 2 * MiB;
constexpr size_t WS_KV2 = WS_Q2 + 54 * MiB;
constexpr size_t WS_KF = WS_KV2 + 72 * MiB;
constexpr size_t WS_VT = WS_KF + 54 * MiB;
constexpr size_t WS_O = WS_VT + 36 * MiB;
constexpr size_t WS_Y = WS_O + 36 * MiB;
constexpr size_t WS_LIST = WS_Y + 72 * MiB;
constexpr size_t WS_GATE = WS_LIST + 3 * MiB;
constexpr size_t WS_POS = WS_GATE + 1 * MiB;
constexpr size_t WS_GS = WS_POS + 1 * MiB;
constexpr size_t WS_HS = WS_GS + 1 * MiB;
constexpr size_t WS_ACT = WS_HS + 160 * MiB;
constexpr size_t WS_YS = WS_ACT + 160 * MiB;
constexpr size_t WS_END = WS_YS + 160 * MiB;
constexpr int CW_CNT = 64;
constexpr int CW_BAR = 4096;

constexpr int RT16 = 0, RT32 = RT16 + 2 * 2048 * 2 * 16, RT8 = RT32 + 2 * 2048 * 2 * 32, RT_END = RT8 + 2 * 2048 * 2 * 8;

constexpr int RING_BYTES = 131072;
constexpr int MISC_OFF = RING_BYTES;
constexpr int LDS_BYTES = 147456;
constexpr int MW_TP = 64, MW_CP = 128, MW_TEXP = 192, MW_PTR = 512;

namespace pg8 {
constexpr int BM = 256, BK = 64, HALF = 128, HTB = HALF * BK * 2, STAGE_BYTES = 8 * HTB;
__host__ __device__ __forceinline__ int lds_byte(int r, int c) { const int st = (r >> 4) * 2 + (c >> 5), rr = r & 15, cc = c & 31, ob = rr * 64 + cc * 2; return st * 1024 + (ob ^ (((ob >> 9) & 1) << 5)); }
__host__ __device__ __forceinline__ void stage_rc(int b, int& R, int& C) { const int st = b / 1024, sb = b % 1024, swz = sb ^ (((sb >> 9) & 1) << 5); R = (st >> 1) * 16 + swz / 64; C = (st & 1) * 32 + (swz % 64) / 2; }
__host__ __device__ __forceinline__ int perm32(int rho) { const int n = rho >> 4, i = rho & 15; return 8 * (i >> 2) + 4 * n + (i & 3); }

struct Unit { const char* a; const char* b; int r0, c0, aux; };

template <class Epi, class Sched>
__device__ __forceinline__ void gemm_phase(LAS unsigned char* lds, const int tid, const int K, const Sched& S, const Epi& E) {
    const int wid = __builtin_amdgcn_readfirstlane(tid >> 6), lane = tid & 63, wr = wid >> 2, wc = wid & 3, fr = lane & 15, fq = lane >> 4;
    const int nt = K / BK;
    unsigned voffA[2], voffB[2];
#pragma unroll
    for (int i = 0; i < 2; ++i) { int R, C; stage_rc(tid * 16 + i * 8192, R, C); const int Rb = Epi::PERM ? ((R & ~31) + perm32(R & 31)) : R;
        voffA[i] = (unsigned)(R * K + C) * 2u; voffB[i] = (unsigned)(Rb * K + C) * 2u; }
    const size_t kstep = (size_t)(BK * 2);
    const size_t hstep = (size_t)HALF * K * 2;
    const unsigned ldsw = (unsigned)wid * 1024u;
    const int aoff = lds_byte(wr * 64 + fr, fq * 8), boff = lds_byte(wc * 32 + fr, fq * 8);
#define PG8_SA(b, h) (((b) * 2 + (h)) * HTB)
#define PG8_SB(b, h) ((4 + (b) * 2 + (h)) * HTB)
#define PG8_STAGE(bufoff, gbase, voff) do { _Pragma("unroll") for (int _i = 0; _i < 2; ++_i) \
        __builtin_amdgcn_global_load_lds((const unsigned*)((const char*)(gbase) + (voff)[_i]), (LAS unsigned*)(lds + (bufoff) + ldsw + _i * 8192), 16, 0, 0); } while (0)
#define PG8_LDA(dst, b, h) do { _Pragma("unroll") for (int m = 0; m < 4; ++m) _Pragma("unroll") for (int k = 0; k < 2; ++k) dst[m][k] = *(const LAS bf16x8*)(lds + PG8_SA(b, h) + aoff + m * 2048 + k * 1024); } while (0)
#define PG8_LDB(dst, b, h) do { _Pragma("unroll") for (int n = 0; n < 2; ++n) _Pragma("unroll") for (int k = 0; k < 2; ++k) dst[n][k] = *(const LAS bf16x8*)(lds + PG8_SB(b, h) + boff + n * 2048 + k * 1024); } while (0)
#define PG8_MMA(ai, bj, At, Bt) do { __builtin_amdgcn_s_setprio(1); _Pragma("unroll") for (int m = 0; m < 4; ++m) _Pragma("unroll") for (int n = 0; n < 2; ++n) _Pragma("unroll") for (int k = 0; k < 2; ++k) \
        acc[ai][bj][m][n] = __builtin_amdgcn_mfma_f32_16x16x32_bf16(Bt[n][k], At[m][k], acc[ai][bj][m][n], 0, 0, 0); __builtin_amdgcn_s_setprio(0); } while (0)
#define PG8_WAIT_V(n) asm volatile("s_waitcnt vmcnt(" #n ")" ::: "memory")
#define PG8_WAIT_L(n) asm volatile("s_waitcnt lgkmcnt(" #n ")" ::: "memory")
#define PG8_BAR __builtin_amdgcn_s_barrier()
#define PG8_SCHED __builtin_amdgcn_sched_barrier(0)
    Unit cur, nxt; int ui = 0;
    if (!S.next(0, cur)) return;
    f32x4 acc[2][2][4][2];
#pragma unroll
    for (int a = 0; a < 2; ++a)
#pragma unroll
        for (int b = 0; b < 2; ++b)
#pragma unroll
            for (int m = 0; m < 4; ++m)
#pragma unroll
                for (int n = 0; n < 2; ++n) acc[a][b][m][n] = (f32x4){0.f, 0.f, 0.f, 0.f};
    bf16x8 At[4][2], B0[2][2], B1[2][2];
    const char* cA = cur.a; const char* cB = cur.b;
    PG8_STAGE(PG8_SB(0, 0), cB, voffB); PG8_STAGE(PG8_SB(0, 1), cB + hstep, voffB); PG8_STAGE(PG8_SA(0, 0), cA, voffA); PG8_STAGE(PG8_SA(0, 1), cA + hstep, voffA);
    if (wr == 1) PG8_BAR;
    PG8_WAIT_V(2); PG8_BAR;
    PG8_STAGE(PG8_SB(1, 0), cB + kstep, voffB); PG8_STAGE(PG8_SA(1, 0), cA + kstep, voffA); PG8_STAGE(PG8_SB(1, 1), cB + hstep + kstep, voffB);
    PG8_WAIT_V(6); PG8_BAR;
    for (;;) {
        const bool has_next = S.next(ui + 1, nxt);
        const char* nA = has_next ? nxt.a : cA; const char* nB = has_next ? nxt.b : cB;
        for (int t = 0; t < nt; t += 2) {
            const bool last = (t == nt - 2);
            const char* a1 = cA + (size_t)(t + 1) * kstep;
            const char* a2 = last ? nA : cA + (size_t)(t + 2) * kstep; const char* b2 = last ? nB : cB + (size_t)(t + 2) * kstep;
            const char* a3 = a2 + kstep; const char* b3 = b2 + kstep;
            PG8_LDB(B0, 0, 0); PG8_LDB(B1, 0, 1); PG8_SCHED; PG8_LDA(At, 0, 0); PG8_STAGE(PG8_SA(1, 1), a1 + hstep, voffA);
            PG8_WAIT_V(8); PG8_WAIT_L(0); PG8_BAR; PG8_MMA(0, 0, At, B0); PG8_MMA(0, 1, At, B1); PG8_BAR; PG8_SCHED;
            PG8_LDA(At, 0, 1); PG8_STAGE(PG8_SB(0, 0), b2, voffB); PG8_STAGE(PG8_SB(0, 1), b2 + hstep, voffB); PG8_STAGE(PG8_SA(0, 0), a2, voffA);
            PG8_WAIT_V(8); PG8_WAIT_L(0); PG8_BAR; PG8_MMA(1, 0, At, B0); PG8_MMA(1, 1, At, B1); PG8_BAR; PG8_SCHED;
            PG8_LDB(B0, 1, 0); PG8_LDB(B1, 1, 1); PG8_SCHED; PG8_LDA(At, 1, 0); PG8_STAGE(PG8_SA(0, 1), a2 + hstep, voffA);
            PG8_WAIT_V(8); PG8_WAIT_L(0); PG8_BAR; PG8_MMA(0, 0, At, B0); PG8_MMA(0, 1, At, B1); PG8_BAR; PG8_SCHED;
            PG8_LDA(At, 1, 1); PG8_STAGE(PG8_SB(1, 0), b3, voffB); PG8_STAGE(PG8_SB(1, 1), b3 + hstep, voffB); PG8_STAGE(PG8_SA(1, 0), a3, voffA);
            PG8_WAIT_V(8); PG8_WAIT_L(0); PG8_BAR; PG8_MMA(1, 0, At, B0); PG8_MMA(1, 1, At, B1); PG8_BAR; PG8_SCHED;
        }
        if (wr == 0) PG8_BAR;
        E(acc, cur, wr, wc, fr, fq);
        if (!has_next) break;
#pragma unroll
        for (int a = 0; a < 2; ++a)
#pragma unroll
            for (int b = 0; b < 2; ++b)
#pragma unroll
                for (int m = 0; m < 4; ++m)
#pragma unroll
                    for (int n = 0; n < 2; ++n) acc[a][b][m][n] = (f32x4){0.f, 0.f, 0.f, 0.f};
        cur = nxt; cA = nA; cB = nB; ++ui;
        if (wr == 1) PG8_BAR;
    }
    PG8_WAIT_V(0);
    PG8_BAR;
#undef PG8_SA
#undef PG8_SB
#undef PG8_STAGE
#undef PG8_LDA
#undef PG8_LDB
#undef PG8_MMA
#undef PG8_WAIT_V
#undef PG8_WAIT_L
#undef PG8_BAR
#undef PG8_SCHED
}

struct EpiBf16 {
    static constexpr bool PERM = true;
    bf16_t* O; int ldc; const float* bias;
    DI void operator()(const f32x4 (&acc)[2][2][4][2], const Unit& u, int wr, int wc, int fr, int fq) const {
        const int row0 = u.r0 + wr * 64 + fr, col0 = u.c0 + wc * 32 + 8 * fq;
        f32x4 bv[2][2];
#pragma unroll
        for (int bj = 0; bj < 2; ++bj)
#pragma unroll
            for (int n = 0; n < 2; ++n) bv[bj][n] = bias ? *(const f32x4*)(bias + col0 + bj * HALF + 4 * n) : (f32x4){0.f, 0.f, 0.f, 0.f};
#pragma unroll
        for (int ai = 0; ai < 2; ++ai)
#pragma unroll
            for (int m = 0; m < 4; ++m) { bf16_t* rowp = O + (size_t)(row0 + ai * HALF + m * 16) * ldc + col0;
#pragma unroll
                for (int bj = 0; bj < 2; ++bj) { const f32x4 v0 = acc[ai][bj][m][0] + bv[bj][0], v1 = acc[ai][bj][m][1] + bv[bj][1];
                    u32x4 w; w.x = pk2(v0[0], v0[1]); w.y = pk2(v0[2], v0[3]); w.z = pk2(v1[0], v1[1]); w.w = pk2(v1[2], v1[3]);
                    *(u32x4*)(rowp + bj * HALF) = w; } }
    }
};
struct EpiF32 {
    static constexpr bool PERM = false;
    float* Y; int ldc; const float* bias;
    DI void operator()(const f32x4 (&acc)[2][2][4][2], const Unit& u, int wr, int wc, int fr, int fq) const {
        const int row0 = u.r0 + wr * 64 + fr, col0 = u.c0 + wc * 32 + 4 * fq;
        f32x4 bv[2][2];
#pragma unroll
        for (int bj = 0; bj < 2; ++bj)
#pragma unroll
            for (int n = 0; n < 2; ++n) bv[bj][n] = bias ? *(const f32x4*)(bias + col0 + bj * HALF + 16 * n) : (f32x4){0.f, 0.f, 0.f, 0.f};
#pragma unroll
        for (int ai = 0; ai < 2; ++ai)
#pragma unroll
            for (int m = 0; m < 4; ++m) { float* rowp = Y + (size_t)(row0 + ai * HALF + m * 16) * ldc + col0;
#pragma unroll
                for (int bj = 0; bj < 2; ++bj)
#pragma unroll
                    for (int n = 0; n < 2; ++n) *(f32x4*)(rowp + bj * HALF + 16 * n) = acc[ai][bj][m][n] + bv[bj][n]; }
    }
};
DI float swiglu1(float g, float lin) {
    g = fminf(g, 7.0f); lin = fminf(fmaxf(lin, -7.0f), 7.0f);
    const float s = __builtin_amdgcn_rcpf(1.0f + __builtin_amdgcn_exp2f(-1.702f * LOG2E * g));
    return g * s * (lin + 1.0f);
}
struct EpiSwiglu {
    static constexpr bool PERM = true;
    bf16_t* O; const float* bias;
    DI void operator()(const f32x4 (&acc)[2][2][4][2], const Unit& u, int wr, int wc, int fr, int fq) const {
        const int row0 = u.r0 + wr * 64 + fr, col0 = u.c0 + wc * 32 + 8 * fq;
        const float* bp = bias + (size_t)u.aux * (2 * FF) + col0;
        f32x4 bv[2][2];
#pragma unroll
        for (int bj = 0; bj < 2; ++bj)
#pragma unroll
            for (int n = 0; n < 2; ++n) bv[bj][n] = *(const f32x4*)(bp + bj * HALF + 4 * n);
#pragma unroll
        for (int ai = 0; ai < 2; ++ai)
#pragma unroll
            for (int m = 0; m < 4; ++m) { bf16_t* rowp = O + (size_t)(row0 + ai * HALF + m * 16) * FF + (col0 >> 1);
#pragma unroll
                for (int bj = 0; bj < 2; ++bj) { const f32x4 v0 = acc[ai][bj][m][0] + bv[bj][0], v1 = acc[ai][bj][m][1] + bv[bj][1];
                    u32x2 w; w.x = pk2(swiglu1(v0[0], v0[1]), swiglu1(v0[2], v0[3])); w.y = pk2(swiglu1(v1[0], v1[1]), swiglu1(v1[2], v1[3]));
                    *(u32x2*)(rowp + bj * (HALF / 2)) = w; } }
    }
};
struct EpiMoe2 {
    static constexpr bool PERM = true;
    bf16_t* O; const float* bias; const float* gs;
    DI void operator()(const f32x4 (&acc)[2][2][4][2], const Unit& u, int wr, int wc, int fr, int fq) const {
        const int row0 = u.r0 + wr * 64 + fr, col0 = u.c0 + wc * 32 + 8 * fq;
        const float* bp = bias + (size_t)u.aux * DM + col0;
        f32x4 bv[2][2];
#pragma unroll
        for (int bj = 0; bj < 2; ++bj)
#pragma unroll
            for (int n = 0; n < 2; ++n) bv[bj][n] = *(const f32x4*)(bp + bj * HALF + 4 * n);
#pragma unroll
        for (int ai = 0; ai < 2; ++ai)
#pragma unroll
            for (int m = 0; m < 4; ++m) { const int row = row0 + ai * HALF + m * 16; const float g = gs[row]; bf16_t* rowp = O + (size_t)row * DM + col0;
#pragma unroll
                for (int bj = 0; bj < 2; ++bj) { const f32x4 v0 = (acc[ai][bj][m][0] + bv[bj][0]) * g, v1 = (acc[ai][bj][m][1] + bv[bj][1]) * g;
                    u32x4 w; w.x = pk2(v0[0], v0[1]); w.y = pk2(v0[2], v0[3]); w.z = pk2(v1[0], v1[1]); w.w = pk2(v1[2], v1[3]);
                    *(u32x4*)(rowp + bj * HALF) = w; } }
    }
};
struct DenseOrder {
    const char* A; const char* B; int nN, nunits, G, c, r0; size_t step;
    DI bool next(int i, Unit& u) const {
        const int L = i * G + c; if (L >= nunits) return false;
        const int pm = L / nN, pn = L - pm * nN;
        u.a = A + (size_t)pm * step; u.b = B + (size_t)pn * step; u.r0 = r0 + pm * BM; u.c0 = pn * BM; u.aux = 0; return true;
    }
};
template <int LGN, int BROWS>
struct MoeOrder {
    const char* A; const char* B; const volatile LAS unsigned* misc; int G, c;
    DI bool next(int i, Unit& u) const {
        const int L = i * G + c; const int ntile = __builtin_amdgcn_readfirstlane((int)misc[MW_TP + 32]);
        if (L >= (ntile << LGN)) return false;
        const int T = L >> LGN, pn = L & ((1 << LGN) - 1); const int e = __builtin_amdgcn_readfirstlane((int)misc[MW_TEXP + T]);
        u.a = A + (size_t)T * (256 * 1024 * 2); u.b = B + (size_t)(e * BROWS + pn * 256) * (1024 * 2); u.r0 = T * BM; u.c0 = pn * BM; u.aux = e; return true;
    }
};
}

#define XB_TMO      128
#define XB_XCNT(j)  (256  + 64 * (j))
#define XB_XSUB(j)  (1280 + 64 * (j))
#define XB_XGEN(j)  (2304 + 64 * (j))
#define XB_TOP      3328
#define XB_TOPGEN   3392
#define XCD_BAR_WORDS 3456
#define XB_SPIN_CAP (1u << 18)
DI unsigned xb_ld(unsigned* p)              { return __hip_atomic_load(p, __ATOMIC_RELAXED, __HIP_MEMORY_SCOPE_AGENT); }
DI unsigned xb_add(unsigned* p, unsigned v) { return __hip_atomic_fetch_add(p, v, __ATOMIC_RELAXED, __HIP_MEMORY_SCOPE_AGENT); }
DI unsigned xb_xcc_id() { return (unsigned)__builtin_amdgcn_s_getreg((3 << 11) | 20) & 0xFu; }
#define XB_SPIN(cond, bar) do { unsigned _sp = 0; while (cond) { __builtin_amdgcn_s_sleep(1); \
    if ((++_sp & 255u) == 0u) { if (xb_ld(&(bar)[XB_TMO])) break; if (_sp > XB_SPIN_CAP) { atomicAdd(&(bar)[XB_TMO], 1u); break; } } } } while (0)
struct XcdBarrier { unsigned* bar; unsigned x; volatile LAS unsigned* st; };
DI XcdBarrier xcd_barrier_post(unsigned* bar, volatile LAS unsigned* st) {
    XcdBarrier b; b.bar = bar; b.x = xb_xcc_id(); b.st = st;
    if (threadIdx.x == 0) (void)xb_add(&bar[XB_XCNT(b.x)], 1u);
    return b;
}
DI void xcd_barrier_complete(unsigned* bar, unsigned x, unsigned& nloc, unsigned& nx) {
    const unsigned G = gridDim.x * gridDim.y * gridDim.z;
    unsigned sum, cnt, mine, sp = 0u;
    for (;;) {
        sum = 0u; cnt = 0u; mine = 0u;
#pragma unroll
        for (unsigned j = 0; j < 16; ++j) { const unsigned c = xb_ld(&bar[XB_XCNT(j)]); sum += c; cnt += (c > 0u) ? 1u : 0u; mine = (j == x) ? c : mine; }
        if (sum == G) break;
        __builtin_amdgcn_s_sleep(1);
        if ((++sp & 255u) == 0u) { if (xb_ld(&bar[XB_TMO])) break; if (sp > XB_SPIN_CAP) { atomicAdd(&bar[XB_TMO], 1u); break; } }
    }
    nloc = mine > 0u ? mine : 1u; nx = cnt > 0u ? cnt : 1u;
}
DI void xcd_barrier(const XcdBarrier& b) {
    asm volatile("s_waitcnt vmcnt(0)" ::: "memory");
    __syncthreads();
    if (threadIdx.x == 0) {
        unsigned* bar = b.bar;
        __builtin_amdgcn_s_waitcnt(0);
        unsigned nloc = b.st[0], nx = b.st[1];
        if (nloc == 0u) { xcd_barrier_complete(bar, b.x, nloc, nx); b.st[0] = nloc; b.st[1] = nx; }
        const unsigned old = xb_add(&bar[XB_XSUB(b.x)], 1u);
        const unsigned gen = old / nloc;
        if (old + 1u == (gen + 1u) * nloc) {
            __builtin_amdgcn_fence(__ATOMIC_RELEASE, "agent");
            asm volatile("s_waitcnt vmcnt(0)" ::: "memory");
            const unsigned og = xb_add(&bar[XB_TOP], 1u);
            const unsigned tg = og / nx;
            if (og + 1u == (tg + 1u) * nx) xb_add(&bar[XB_TOPGEN], 1u);
            else XB_SPIN(xb_ld(&bar[XB_TOPGEN]) == tg, bar);
            __builtin_amdgcn_fence(__ATOMIC_ACQUIRE, "agent");
            xb_add(&bar[XB_XGEN(b.x)], 1u);
            asm volatile("s_waitcnt vmcnt(0)" ::: "memory");
        } else {
            XB_SPIN(xb_ld(&bar[XB_XGEN(b.x)]) == gen, bar);
            __builtin_amdgcn_fence(__ATOMIC_ACQUIRE, "agent");
            asm volatile("s_waitcnt vmcnt(0)" ::: "memory");
        }
    }
    __syncthreads();
}

struct Args { const float* in[36]; float* out; unsigned char* ws; int ph_lo, ph_hi; };
enum { I_X = 0, I_C, I_CTX, I_CCTX, I_ADAW, I_ADAB, I_LN1G, I_LN1B, I_LN2G, I_LN2B, I_WIN_WQKV, I_WIN_BQKV, I_WIN_SINK, I_WIN_WO, I_WIN_BO,
       I_AXG_WQKV, I_AXG_QN, I_AXG_KN, I_AXG_WO, I_MLA_WQA, I_MLA_QN, I_MLA_WQB, I_MLA_WKVA, I_MLA_KVN, I_MLA_WKVB, I_MLA_WO,
       I_DIFF_WQKV, I_DIFF_LAM, I_DIFF_SUBLN, I_DIFF_WO, I_RW, I_RB, I_WIN, I_BIN, I_WOUT, I_BOUT };

struct Ctx {
    LAS unsigned char* lds; volatile LAS unsigned* misc; unsigned char* ws; int tid, lane, wave, vcu, G;
};
extern __shared__ __attribute__((aligned(16))) unsigned char lds_raw[];
DI Ctx make_ctx(unsigned char* ws, int wave_s) {
    int bx = blockIdx.x, G = gridDim.x;
    asm volatile("" : "+s"(bx), "+s"(G), "+s"(wave_s));
    unsigned z = 0u; asm volatile("" : "+v"(z));
    const int tid = wave_s * 64 + (int)__builtin_amdgcn_mbcnt_hi(~0u, __builtin_amdgcn_mbcnt_lo(~0u, z));
    Ctx C; C.lds = (LAS unsigned char*)lds_raw; C.misc = (volatile LAS unsigned*)(C.lds + MISC_OFF); C.ws = ws;
    C.tid = tid; C.lane = tid & 63; C.wave = wave_s;
    C.G = G; C.vcu = (G % 8 == 0) ? (bx % 8) * (G / 8) + bx / 8 : bx;
    return C;
}
DI const float* inp(const Ctx& C, int i) {
    const unsigned lo = __builtin_amdgcn_readfirstlane(C.misc[MW_PTR + 2 * i]), hi = __builtin_amdgcn_readfirstlane(C.misc[MW_PTR + 2 * i + 1]);
    return (const float*)(((unsigned long long)hi << 32) | lo);
}
DI int modidx(int row) { return row < NCTX ? 8 : ((row - NCTX) >> 11); }
DI const float* modp(const Ctx& C, int l, int m, int part) { return (const float*)(C.ws + WS_MOD) + ((size_t)(l * 9 + m) * 6 + part) * DM; }

DI void sincos_acc(float ang, float& s, float& c) {
    const double x = (double)ang; const int q = (int)__builtin_rint(x * 0.6366197723675814); const double rd = x - (double)q * 1.5707963267948966;
    const float r = (float)rd, r2 = r * r;
    const float sp = r + r * r2 * (-1.6666654611e-1f + r2 * (8.3321608736e-3f + r2 * (-1.9515295891e-4f)));
    const float cp = 1.0f - 0.5f * r2 + r2 * r2 * (4.166664568298827e-2f + r2 * (-1.388731625493765e-3f + r2 * 2.443315711809948e-5f));
    switch (q & 3) { case 0: s = sp; c = cp; break; case 1: s = cp; c = -sp; break; case 2: s = -sp; c = -cp; break; default: s = -cp; c = sp; break; }
}
DI void cvt_item(const float* src, int N, bf16_t* dst, int Kd, int row_off, int k0, int n0, int lane) {
    const int n = n0 + lane; const bool valid = n < N;
    const float* sp = src + (size_t)k0 * N + (valid ? n : 0);
    float v[64];
#pragma unroll
    for (int i = 0; i < 64; ++i) v[i] = sp[(size_t)i * N];
    if (valid) {
        bf16_t* dp = dst + (size_t)(row_off + n) * Kd + k0;
#pragma unroll
        for (int j = 0; j < 8; ++j) { u32x4 w; w.x = pk2(v[8 * j], v[8 * j + 1]); w.y = pk2(v[8 * j + 2], v[8 * j + 3]); w.z = pk2(v[8 * j + 4], v[8 * j + 5]); w.w = pk2(v[8 * j + 6], v[8 * j + 7]);
            *(u32x4*)(dp + 8 * j) = w; }
    }
}
DI bool cvt_mat(int& r, const float* src, int K, int N, bf16_t* dst, int row_off, int lane) {
    const int nb = (N + 63) >> 6, items = (K >> 6) * nb;
    if (r < items) { const int kb = r / nb, nbk = r - kb * nb; cvt_item(src, N, dst, K, row_off, kb * 64, nbk * 64, lane); return true; }
    r -= items; return false;
}
DI void phase_prologue(int wave_s, unsigned char* ws) {
    const Ctx C = make_ctx(ws, wave_s);
    if (C.vcu < 384) {
        LAS float* sv = (LAS float*)C.lds; LAS float* part = sv + 9 * 1024;
        for (int i = C.tid; i < 9 * 1024; i += 512) { const int m = i >> 10, k = i & 1023; const float c = m < 8 ? inp(C, I_C)[m * 1024 + k] : inp(C, I_CCTX)[k]; sv[i] = c / (1.0f + expf(-c)); }
        __syncthreads();
        for (int it = C.vcu; it < 384; it += C.G) {
            const int l = it / 96, cg = it - l * 96;
            const float* w = inp(C, I_ADAW) + (size_t)l * 1024 * 6144 + cg * 64 + C.lane;
            float acc[9];
#pragma unroll
            for (int m = 0; m < 9; ++m) acc[m] = 0.f;
#pragma unroll 8
            for (int kk = 0; kk < 128; ++kk) { const int k = C.wave * 128 + kk; const float wv = w[(size_t)k * 6144];
#pragma unroll
                for (int m = 0; m < 9; ++m) acc[m] += sv[m * 1024 + k] * wv; }
#pragma unroll
            for (int m = 0; m < 9; ++m) part[(C.wave * 9 + m) * 64 + C.lane] = acc[m];
            __syncthreads();
            for (int i = C.tid; i < 576; i += 512) { const int m = i >> 6, j = i & 63; float s = 0.f;
#pragma unroll
                for (int w8 = 0; w8 < 8; ++w8) s += part[(w8 * 9 + m) * 64 + j];
                const int col = cg * 64 + j; ((float*)(ws + WS_MOD))[(size_t)(l * 9 + m) * 6144 + col] = s + inp(C, I_ADAB)[l * 6144 + col]; }
            __syncthreads();
        }
    }
    {
        float* rt = (float*)(ws + WS_ROPE);
        const int total = 2048 * 2 * (16 + 32 + 8);
        for (int i = C.vcu * 512 + C.tid; i < total; i += C.G * 512) {
            int nf, base, idx = i;
            if (idx < 2048 * 2 * 16) { nf = 16; base = RT16; } else if ((idx -= 2048 * 2 * 16) < 2048 * 2 * 32) { nf = 32; base = RT32; } else { idx -= 2048 * 2 * 32; nf = 8; base = RT8; }
            const int f = idx % nf, half = (idx / nf) & 1, pos = idx / (2 * nf);
            const float pv = (float)(half == 0 ? (pos >> 6) : (pos & 63));
            const float inv = exp2f(-((float)f / (float)nf) * 13.287712379549449f);
            const float ang = pv * inv; float s, c; sincos_acc(ang, s, c);
            rt[base + idx] = c; rt[base + 2048 * 2 * nf + idx] = s;
        }
    }
    {
        bf16_t* wsm = (bf16_t*)(ws + WS_WSMALL);
        const int gw = C.vcu * 8 + C.wave, NGW = C.G * 8;
        constexpr int NI_IN = 128 * 512, NI_OUT = 128 * 256, NI_SMALL = 384 + 256 + 384 + 256 + 96 + 80 + 144 + 128 + 256 + 768 + 256;
        for (int it = gw; it < NI_IN + NI_OUT + NI_SMALL; it += NGW) {
            int r = it;
            if (r < NI_IN) { const int le = r >> 9, q = r & 511; cvt_item(inp(C, I_WIN) + (size_t)le * 1024 * 2048, 2048, (bf16_t*)(ws + WS_WIN) + (size_t)le * 2048 * 1024, 1024, 0, (q >> 5) * 64, (q & 31) * 64, C.lane); continue; }
            r -= NI_IN;
            if (r < NI_OUT) { const int le = r >> 8, q = r & 255; cvt_item(inp(C, I_WOUT) + (size_t)le * 1024 * 1024, 1024, (bf16_t*)(ws + WS_WOUT) + (size_t)le * 1024 * 1024, 1024, 0, (q >> 4) * 64, (q & 15) * 64, C.lane); continue; }
            r -= NI_OUT;
            if (cvt_mat(r, inp(C, I_WIN_WQKV), 1024, 1536, wsm + OFF_WQKV0 / 2, 0, C.lane)) continue;
            if (cvt_mat(r, inp(C, I_WIN_WO), 1024, 1024, wsm + OFF_WO0 / 2, 0, C.lane)) continue;
            if (cvt_mat(r, inp(C, I_AXG_WQKV), 1024, 1536, wsm + OFF_WQKV1 / 2, 0, C.lane)) continue;
            if (cvt_mat(r, inp(C, I_AXG_WO), 1024, 1024, wsm + OFF_WO1 / 2, 0, C.lane)) continue;
            if (cvt_mat(r, inp(C, I_MLA_WQA), 1024, 384, wsm + OFF_WA / 2, 0, C.lane)) continue;
            if (cvt_mat(r, inp(C, I_MLA_WKVA), 1024, 288, wsm + OFF_WA / 2, 384, C.lane)) continue;
            if (cvt_mat(r, inp(C, I_MLA_WQB), 384, 1536, wsm + OFF_WQB / 2, 0, C.lane)) continue;
            if (cvt_mat(r, inp(C, I_MLA_WKVB), 256, 2048, wsm + OFF_WKVB / 2, 0, C.lane)) continue;
            if (cvt_mat(r, inp(C, I_MLA_WO), 1024, 1024, wsm + OFF_WO2 / 2, 0, C.lane)) continue;
            if (cvt_mat(r, inp(C, I_DIFF_WQKV), 1024, 3072, wsm + OFF_WQKV3 / 2, 0, C.lane)) continue;
            cvt_mat(r, inp(C, I_DIFF_WO), 1024, 1024, wsm + OFF_WO3 / 2, 0, C.lane);
        }
        for (int i = C.vcu * 512 + C.tid; i < 96 * 1024 / 8; i += C.G * 512) *(u32x4*)(wsm + OFF_WA / 2 + (size_t)672 * 1024 + (size_t)i * 8) = (u32x4){0u, 0u, 0u, 0u};
    }
}

DI void ld_row(const float* p, int lane, f32x4 (&v)[4]) {
#pragma unroll
    for (int j = 0; j < 4; ++j) v[j] = *(const f32x4*)(p + j * 256 + lane * 4);
}
DI void st_row(float* p, int lane, const f32x4 (&v)[4]) {
#pragma unroll
    for (int j = 0; j < 4; ++j) *(f32x4*)(p + j * 256 + lane * 4) = v[j];
}
DI void st_row_bf(bf16_t* p, int lane, const f32x4 (&v)[4]) {
#pragma unroll
    for (int j = 0; j < 4; ++j) { u32x2 w; w.x = pk2(v[j][0], v[j][1]); w.y = pk2(v[j][2], v[j][3]); *(u32x2*)(p + j * 256 + lane * 4) = w; }
}
DI void layernorm_row(f32x4 (&v)[4], const float* g, const float* b, int lane) {
    float s = 0.f;
#pragma unroll
    for (int j = 0; j < 4; ++j) s += (v[j][0] + v[j][1]) + (v[j][2] + v[j][3]);
    const float mean = wave_sum(s, lane) * (1.0f / DM); float q = 0.f;
#pragma unroll
    for (int j = 0; j < 4; ++j) { v[j] = v[j] - mean; q += (v[j][0] * v[j][0] + v[j][1] * v[j][1]) + (v[j][2] * v[j][2] + v[j][3] * v[j][3]); }
    const float rstd = 1.0f / sqrtf(wave_sum(q, lane) * (1.0f / DM) + LN_EPS);
    f32x4 gg[4], bb[4]; ld_row(g, lane, gg); ld_row(b, lane, bb);
#pragma unroll
    for (int j = 0; j < 4; ++j) v[j] = (v[j] * rstd) * gg[j] + bb[j];
}
DI void modulate_row(const f32x4 (&x)[4], const float* sh, const float* sc, int lane, f32x4 (&h)[4]) {
    f32x4 a[4], b[4]; ld_row(sc, lane, a); ld_row(sh, lane, b);
#pragma unroll
    for (int j = 0; j < 4; ++j) h[j] = x[j] * (1.0f + a[j]) + b[j];
}

DI void phase_modh0(int wave_s, unsigned char* ws_) {
    const Ctx C = make_ctx(ws_, wave_s);
    float* X = (float*)(C.ws + WS_X); bf16_t* H = (bf16_t*)(C.ws + WS_H);
    for (int row = C.vcu * 8 + C.wave; row < NT; row += C.G * 8) {
        const float* src = row < NCTX ? inp(C, I_CTX) + (size_t)row * DM : inp(C, I_X) + (size_t)(row - NCTX) * DM;
        f32x4 v[4], h[4]; ld_row(src, C.lane, v); st_row(X + (size_t)row * DM, C.lane, v);
        const int m = modidx(row); modulate_row(v, modp(C, 0, m, 0), modp(C, 0, m, 1), C.lane, h);
        st_row_bf(H + (size_t)row * DM, C.lane, h);
    }
}

template <int NF> DI void rope_heads(bf16_t* p, int nheads, int stride, const float* rt, int rtbase, int pos, int lane) {
    constexpr int CPH = 2 * (NF / 8);
    const float* ct = rt + rtbase + (size_t)pos * 2 * NF; const float* st = ct + 2048 * 2 * NF;
    for (int c = lane; c < nheads * CPH; c += 64) {
        const int hh = c / CPH, rem = c - hh * CPH, half = rem / (NF / 8), sub = rem - half * (NF / 8);
        bf16_t* x1p = p + hh * stride + half * 2 * NF + sub * 8; bf16_t* x2p = x1p + NF;
        const u32x4 a = *(const u32x4*)x1p, b = *(const u32x4*)x2p;
        const f32x4 c0 = *(const f32x4*)(ct + half * NF + sub * 8), c1 = *(const f32x4*)(ct + half * NF + sub * 8 + 4);
        const f32x4 s0 = *(const f32x4*)(st + half * NF + sub * 8), s1 = *(const f32x4*)(st + half * NF + sub * 8 + 4);
        float x1[8] = {bf_lo(a.x), bf_hi(a.x), bf_lo(a.y), bf_hi(a.y), bf_lo(a.z), bf_hi(a.z), bf_lo(a.w), bf_hi(a.w)};
        float x2[8] = {bf_lo(b.x), bf_hi(b.x), bf_lo(b.y), bf_hi(b.y), bf_lo(b.z), bf_hi(b.z), bf_lo(b.w), bf_hi(b.w)};
        float cc[8] = {c0[0], c0[1], c0[2], c0[3], c1[0], c1[1], c1[2], c1[3]}, ss[8] = {s0[0], s0[1], s0[2], s0[3], s1[0], s1[1], s1[2], s1[3]};
        float y1[8], y2[8];
#pragma unroll
        for (int i = 0; i < 8; ++i) { y1[i] = x1[i] * cc[i] - x2[i] * ss[i]; y2[i] = x1[i] * ss[i] + x2[i] * cc[i]; }
        u32x4 o1, o2; o1.x = pk2(y1[0], y1[1]); o1.y = pk2(y1[2], y1[3]); o1.z = pk2(y1[4], y1[5]); o1.w = pk2(y1[6], y1[7]);
        o2.x = pk2(y2[0], y2[1]); o2.y = pk2(y2[2], y2[3]); o2.z = pk2(y2[4], y2[5]); o2.w = pk2(y2[6], y2[7]);
        *(u32x4*)x1p = o1; *(u32x4*)x2p = o2;
    }
}
DI void vt_items(const Ctx& C, const bf16_t* src, int pitch, int col0, int hstride, int HV, int DV, bf16_t* Vt) {
    const int dvb_n = DV >> 6, items = NB * HV * dvb_n * 36;
    for (int it = C.vcu * 8 + C.wave; it < items; it += C.G * 8) {
        const int kbk = it % 36; int r = it / 36; const int dvb = r % dvb_n; r /= dvb_n; const int hv = r % HV, b = r / HV;
        const int key0 = kbk * 64;
        const int row0 = key0 < CTXL ? b * CTXL + key0 : NCTX + b * SEQ + (key0 - CTXL);
        const bf16_t* sp = src + (size_t)row0 * pitch + col0 + hv * hstride + dvb * 64 + C.lane;
        bf16_t v[64];
#pragma unroll
        for (int i = 0; i < 64; ++i) v[i] = sp[(size_t)i * pitch];
        bf16_t* dp = Vt + ((size_t)(b * HV + hv) * DV + dvb * 64 + C.lane) * NKEY + key0;
#pragma unroll
        for (int j = 0; j < 8; ++j) { u32x4 w; w.x = v[8 * j] | ((unsigned)v[8 * j + 1] << 16); w.y = v[8 * j + 2] | ((unsigned)v[8 * j + 3] << 16);
            w.z = v[8 * j + 4] | ((unsigned)v[8 * j + 5] << 16); w.w = v[8 * j + 6] | ((unsigned)v[8 * j + 7] << 16); *(u32x4*)(dp + 8 * j) = w; }
    }
}
DI int latent_pos(int row) { return (row - NCTX) & (SEQ - 1); }

DI void phase_post(int wave_s, unsigned char* ws, int l) {
    const Ctx C = make_ctx(ws, wave_s); const float* rt = (const float*)(ws + WS_ROPE);
    bf16_t* RAW = (bf16_t*)(ws + WS_RAW); bf16_t* Vt = (bf16_t*)(ws + WS_VT);
    const int gw = C.vcu * 8 + C.wave, NGW = C.G * 8;
    if (l == 0) {
        for (int row = NCTX + gw; row < NT; row += NGW) rope_heads<16>(RAW + (size_t)row * 1536, 20, 64, rt, RT16, latent_pos(row), C.lane);
        vt_items(C, RAW, 1536, 1280, 64, 4, 64, Vt);
    } else if (l == 1) {
        const float* qn = inp(C, I_AXG_QN); const float* kn = inp(C, I_AXG_KN);
        const int half = C.lane >> 5, i = C.lane & 31, d1 = half * 64 + i, d2 = d1 + 32;
        for (int row = gw; row < NT; row += NGW) {
            bf16_t* p = RAW + (size_t)row * 1536; const bool lat = row >= NCTX;
            float cs = 1.f, sn = 0.f;
            if (lat) { const int pos = latent_pos(row); cs = rt[RT32 + (pos * 2 + half) * 32 + i]; sn = rt[RT32 + 2048 * 2 * 32 + (pos * 2 + half) * 32 + i]; }
            for (int hh = 0; hh < 10; ++hh) {
                const float* g = hh < 8 ? qn : kn;
                float x1 = bf2f(p[hh * 128 + d1]), x2 = bf2f(p[hh * 128 + d2]);
                const float ss = wave_sum(x1 * x1 + x2 * x2, C.lane); const float r = 1.0f / sqrtf(ss * (1.0f / 128.0f) + NORM_EPS);
                x1 = x1 * r * g[d1]; x2 = x2 * r * g[d2];
                p[hh * 128 + d1] = f2bf(x1 * cs - x2 * sn); p[hh * 128 + d2] = f2bf(x1 * sn + x2 * cs);
            }
        }
        vt_items(C, RAW, 1536, 1280, 128, 2, 128, Vt);
    } else if (l == 2) {
        bf16_t* CQ = (bf16_t*)(ws + WS_CQ); bf16_t* CKV = (bf16_t*)(ws + WS_CKV); bf16_t* KPE = (bf16_t*)(ws + WS_KPE);
        const float* qn = inp(C, I_MLA_QN); const float* kvn = inp(C, I_MLA_KVN);
        for (int row = gw; row < NT; row += NGW) {
            const bf16_t* p = RAW + (size_t)row * 768;
            float q[6], ssq = 0.f;
#pragma unroll
            for (int j = 0; j < 6; ++j) { q[j] = bf2f(p[j * 64 + C.lane]); ssq += q[j] * q[j]; }
            const float rq = 1.0f / sqrtf(wave_sum(ssq, C.lane) * (1.0f / 384.0f) + NORM_EPS);
#pragma unroll
            for (int j = 0; j < 6; ++j) CQ[(size_t)row * 384 + j * 64 + C.lane] = f2bf(q[j] * rq * qn[j * 64 + C.lane]);
            float kv[4], ssk = 0.f;
#pragma unroll
            for (int j = 0; j < 4; ++j) { kv[j] = bf2f(p[384 + j * 64 + C.lane]); ssk += kv[j] * kv[j]; }
            const float rk = 1.0f / sqrtf(wave_sum(ssk, C.lane) * (1.0f / 256.0f) + NORM_EPS);
#pragma unroll
            for (int j = 0; j < 4; ++j) CKV[(size_t)row * 256 + j * 64 + C.lane] = f2bf(kv[j] * rk * kvn[j * 64 + C.lane]);
            if (C.lane < 16) {
                const int half = C.lane >> 3, f = C.lane & 7; float x1 = bf2f(p[640 + half * 16 + f]), x2 = bf2f(p[640 + half * 16 + 8 + f]);
                float cs = 1.f, sn = 0.f;
                if (row >= NCTX) { const int pos = latent_pos(row); cs = rt[RT8 + (pos * 2 + half) * 8 + f]; sn = rt[RT8 + 2048 * 2 * 8 + (pos * 2 + half) * 8 + f]; }
                KPE[(size_t)row * 32 + half * 16 + f] = f2bf(x1 * cs - x2 * sn); KPE[(size_t)row * 32 + half * 16 + 8 + f] = f2bf(x1 * sn + x2 * cs);
            }
        }
    } else {
        for (int row = NCTX + gw; row < NT; row += NGW) rope_heads<16>(RAW + (size_t)row * 3072, 32, 64, rt, RT16, latent_pos(row), C.lane);
        vt_items(C, RAW, 3072, 2048, 128, 8, 128, Vt);
    }
}
DI void phase_postb(int wave_s, unsigned char* ws) {
    const Ctx C = make_ctx(ws, wave_s); const float* rt = (const float*)(ws + WS_ROPE);
    bf16_t* Q2 = (bf16_t*)(ws + WS_Q2); const bf16_t* KV2 = (const bf16_t*)(ws + WS_KV2); const bf16_t* KPE = (const bf16_t*)(ws + WS_KPE); bf16_t* KF = (bf16_t*)(ws + WS_KF);
    const int gw = C.vcu * 8 + C.wave, NGW = C.G * 8;
    for (int row = gw; row < NT; row += NGW) {
        if (row >= NCTX) rope_heads<8>(Q2 + (size_t)row * 1536 + 64, 16, 96, rt, RT8, latent_pos(row), C.lane);
        for (int c = C.lane; c < 192; c += 64) { const int h = c / 12, j = c - h * 12;
            const u32x4 v = j < 8 ? *(const u32x4*)(KV2 + (size_t)row * 2048 + h * 128 + j * 8) : *(const u32x4*)(KPE + (size_t)row * 32 + (j - 8) * 8);
            *(u32x4*)(KF + (size_t)row * 1536 + h * 96 + j * 8) = v; }
    }
    vt_items(C, KV2, 2048, 64, 128, 16, 64, (bf16_t*)(ws + WS_VT));
}

struct AttnP { const bf16_t* Q; int qp; const bf16_t* K; int kp; const bf16_t* Vt; bf16_t* O; int G; int HV; float cscale; const float* sink; float lam; float osc; const float* subln; };
DI int crow(int reg, int h) { return (reg & 3) + 8 * (reg >> 2) + 4 * h; }

template <int DQK, int DV, bool DIFF, bool WIN>
DI void attn_unit(const Ctx& C, const AttnP& P, int b, int hsel, int qt, bool ctxq) {
    constexpr int KH = DIFF ? 2 : 1, KS = DQK * 2 + 16, VS = 136, KBYTES = KH * 64 * KS, BUFB = KBYTES + DV * VS;
    constexpr int KCH = DQK / 8, NKC = KH * 64 * KCH, NKL = (NKC + 511) / 512, NVC = DV * 8, NVL = NVC / 512;
    constexpr int QROWS = DIFF ? 128 : 256, NKS = DQK / 16, NDV = DV / 32;
    static_assert(2 * BUFB <= RING_BYTES, "attention LDS");
    const int tid = C.tid, lane = C.lane, wave = C.wave, r = lane & 31, h = lane >> 5;
    const int wg = DIFF ? (wave >> 2) : 0, wrow = (DIFF ? (wave & 3) : wave) * 32;
    const int hq = DIFF ? 2 * hsel + wg : hsel, hk0 = DIFF ? 2 * hsel : hsel / P.G, hv = DIFF ? hsel : hsel / P.G;
    const int qrow0 = ctxq ? b * CTXL : NCTX + b * SEQ + qt * QROWS;
    int t_lo = 0, t_hi = 0;
    if (!ctxq) { if (WIN) { t_lo = 4 * qt - 2; if (t_lo < 0) t_lo = 0; t_hi = 4 * qt + 6; if (t_hi > 32) t_hi = 32; } else { t_lo = 0; t_hi = 32; } }
    const int ntile = 4 + (t_hi - t_lo);
    LAS unsigned char* lds = C.lds;
    bf16x8 qf[NKS];
    { const bf16_t* qptr = P.Q + (size_t)(qrow0 + wrow + r) * P.qp + hq * DQK + 8 * h;
#pragma unroll
      for (int ks = 0; ks < NKS; ++ks) qf[ks] = *(const bf16x8*)(qptr + ks * 16); }
    u32x4 kreg[NKL], vreg[NVL];
    const bf16_t* vbase = P.Vt + (size_t)(b * P.HV + hv) * DV * NKEY;
#define ATT_LOAD(j) do { const int _j = (j); const int krow0 = _j < 4 ? b * CTXL + _j * 64 : NCTX + b * SEQ + (t_lo + _j - 4) * 64; const int vkey0 = _j < 4 ? _j * 64 : CTXL + (t_lo + _j - 4) * 64; \
        _Pragma("unroll") for (int i = 0; i < NKL; ++i) { const int c = tid + i * 512; if (NKC % 512 == 0 || c < NKC) { const int kh = c / (64 * KCH), rem = c - kh * (64 * KCH), key = rem / KCH, dc = rem - key * KCH; \
            kreg[i] = *(const u32x4*)(P.K + (size_t)(krow0 + key) * P.kp + (hk0 + kh) * DQK + dc * 8); } } \
        _Pragma("unroll") for (int i = 0; i < NVL; ++i) { const int c = tid + i * 512; const int dv = c >> 3, kc = c & 7; vreg[i] = *(const u32x4*)(vbase + (size_t)dv * NKEY + vkey0 + kc * 8); } } while (0)
#define ATT_WRITE(buf) do { LAS unsigned char* _b = lds + (buf) * BUFB; \
        _Pragma("unroll") for (int i = 0; i < NKL; ++i) { const int c = tid + i * 512; if (NKC % 512 == 0 || c < NKC) { const int kh = c / (64 * KCH), rem = c - kh * (64 * KCH), key = rem / KCH, dc = rem - key * KCH; \
            *(LAS u32x4*)(_b + kh * 64 * KS + key * KS + dc * 16) = kreg[i]; } } \
        _Pragma("unroll") for (int i = 0; i < NVL; ++i) { const int c = tid + i * 512; const int dv = c >> 3, kc = c & 7; LAS unsigned char* d = _b + KBYTES + dv * VS + kc * 16; \
            *(LAS u32x2*)d = (u32x2){vreg[i].x, vreg[i].y}; *(LAS u32x2*)(d + 8) = (u32x2){vreg[i].z, vreg[i].w}; } } while (0)
    f32x16 o[NDV];
#pragma unroll
    for (int d = 0; d < NDV; ++d)
#pragma unroll
        for (int i = 0; i < 16; ++i) o[d][i] = 0.f;
    float m_run = -INFINITY, l_run = 0.f;
    const int qpos = qt * QROWS + wrow + r;
    __syncthreads();
    ATT_LOAD(0); ATT_WRITE(0);
    __syncthreads();
    for (int j = 0; j < ntile; ++j) {
        const int cur = j & 1;
        const LAS unsigned char* kb_ = lds + cur * BUFB + wg * 64 * KS + r * KS + 16 * h;
        const LAS unsigned char* vb_ = lds + cur * BUFB + KBYTES + r * VS + 8 * h;
        f32x16 s0, s1;
#pragma unroll
        for (int i = 0; i < 16; ++i) { s0[i] = 0.f; s1[i] = 0.f; }
#pragma unroll
        for (int ks = 0; ks < NKS; ++ks) {
            const bf16x8 a0 = *(const LAS bf16x8*)(kb_ + ks * 32), a1 = *(const LAS bf16x8*)(kb_ + 32 * KS + ks * 32);
            s0 = __builtin_amdgcn_mfma_f32_32x32x16_bf16(a0, qf[ks], s0, 0, 0, 0);
            s1 = __builtin_amdgcn_mfma_f32_32x32x16_bf16(a1, qf[ks], s1, 0, 0, 0);
        }
        float mx = -INFINITY;
#pragma unroll
        for (int i = 0; i < 16; ++i) { s0[i] *= P.cscale; s1[i] *= P.cscale; }
        if (WIN) { if (!ctxq && j >= 4) { const int kp0 = (t_lo + j - 4) * 64;
#pragma unroll
            for (int i = 0; i < 16; ++i) { const int k0 = kp0 + crow(i, h), d0 = qpos - k0, d1 = d0 - 32;
                if (d0 > 128 || d0 < -128) s0[i] = -INFINITY; if (d1 > 128 || d1 < -128) s1[i] = -INFINITY; } } }
#pragma unroll
        for (int i = 0; i < 16; ++i) mx = fmaxf(mx, fmaxf(s0[i], s1[i]));
        mx = fmaxf(mx, shx(mx, 32, lane));
        const float m_new = fmaxf(m_run, mx);
        const float alpha = __builtin_amdgcn_exp2f(m_run - m_new);
        float rs = 0.f;
#pragma unroll
        for (int i = 0; i < 16; ++i) { s0[i] = __builtin_amdgcn_exp2f(s0[i] - m_new); s1[i] = __builtin_amdgcn_exp2f(s1[i] - m_new); rs += s0[i] + s1[i]; }
        rs += shx(rs, 32, lane);
        l_run = l_run * alpha + rs; m_run = m_new;
        if (!__all(alpha == 1.0f)) {
#pragma unroll
            for (int d = 0; d < NDV; ++d)
#pragma unroll
                for (int i = 0; i < 16; ++i) o[d][i] *= alpha;
        }
        if (j + 1 < ntile) ATT_LOAD(j + 1);
        bf16x8 pf[2][2];
#pragma unroll
        for (int s = 0; s < 2; ++s) {
            u32x4 w0, w1;
            w0.x = pk2(s0[8 * s + 0], s0[8 * s + 1]); w0.y = pk2(s0[8 * s + 2], s0[8 * s + 3]); w0.z = pk2(s0[8 * s + 4], s0[8 * s + 5]); w0.w = pk2(s0[8 * s + 6], s0[8 * s + 7]);
            w1.x = pk2(s1[8 * s + 0], s1[8 * s + 1]); w1.y = pk2(s1[8 * s + 2], s1[8 * s + 3]); w1.z = pk2(s1[8 * s + 4], s1[8 * s + 5]); w1.w = pk2(s1[8 * s + 6], s1[8 * s + 7]);
            pf[0][s] = __builtin_bit_cast(bf16x8, w0); pf[1][s] = __builtin_bit_cast(bf16x8, w1);
        }
#pragma unroll
        for (int d = 0; d < NDV; ++d)
#pragma unroll
            for (int kb = 0; kb < 2; ++kb)
#pragma unroll
                for (int s = 0; s < 2; ++s) {
                    const LAS unsigned char* vp = vb_ + d * 32 * VS + kb * 64 + s * 32;
                    const u32x2 lo = *(const LAS u32x2*)vp, hi = *(const LAS u32x2*)(vp + 16);
                    const u32x4 vv = {lo.x, lo.y, hi.x, hi.y};
                    o[d] = __builtin_amdgcn_mfma_f32_32x32x16_bf16(__builtin_bit_cast(bf16x8, vv), pf[kb][s], o[d], 0, 0, 0);
                }
        if (j + 1 < ntile) ATT_WRITE(cur ^ 1);
        __syncthreads();
    }
#undef ATT_LOAD
#undef ATT_WRITE
    float lfin = l_run, fsc = 1.0f;
    if (WIN) { const float sk = P.sink[hq] * LOG2E; const float m2 = fmaxf(m_run, sk); fsc = __builtin_amdgcn_exp2f(m_run - m2); lfin = l_run * fsc + __builtin_amdgcn_exp2f(sk - m2); }
    const float inv = fsc / lfin;
    bf16_t* orow = P.O + (size_t)(qrow0 + wrow + r) * DM;
    if (!DIFF) {
#pragma unroll
        for (int d = 0; d < NDV; ++d)
#pragma unroll
            for (int g = 0; g < 4; ++g) { u32x2 w; w.x = pk2(o[d][4 * g] * inv, o[d][4 * g + 1] * inv); w.y = pk2(o[d][4 * g + 2] * inv, o[d][4 * g + 3] * inv);
                *(u32x2*)(orow + hq * DV + d * 32 + 8 * g + 4 * h) = w; }
    } else {
        LAS float* o2 = (LAS float*)lds;
        if (wg == 1) {
#pragma unroll
            for (int d = 0; d < NDV; ++d)
#pragma unroll
                for (int g = 0; g < 4; ++g) *(LAS f32x4*)(o2 + (wrow + r) * 132 + d * 32 + 8 * g + 4 * h) = (f32x4){o[d][4 * g] * inv, o[d][4 * g + 1] * inv, o[d][4 * g + 2] * inv, o[d][4 * g + 3] * inv};
        }
        __syncthreads();
        if (wg == 0) {
            float ssq = 0.f;
#pragma unroll
            for (int d = 0; d < NDV; ++d)
#pragma unroll
                for (int g = 0; g < 4; ++g) { const f32x4 t = *(const LAS f32x4*)(o2 + (wrow + r) * 132 + d * 32 + 8 * g + 4 * h);
#pragma unroll
                    for (int i = 0; i < 4; ++i) { const float v = o[d][4 * g + i] * inv - P.lam * t[i]; o[d][4 * g + i] = v; ssq += v * v; } }
            ssq += shx(ssq, 32, lane);
            const float rn = P.osc / sqrtf(ssq * (1.0f / DV) + NORM_EPS);
#pragma unroll
            for (int d = 0; d < NDV; ++d)
#pragma unroll
                for (int g = 0; g < 4; ++g) { const int dv = d * 32 + 8 * g + 4 * h; const f32x4 sg = *(const f32x4*)(P.subln + dv);
                    u32x2 w; w.x = pk2(o[d][4 * g] * rn * sg[0], o[d][4 * g + 1] * rn * sg[1]); w.y = pk2(o[d][4 * g + 2] * rn * sg[2], o[d][4 * g + 3] * rn * sg[3]);
                    *(u32x2*)(orow + hsel * DV + dv) = w; }
        }
    }
}


DI AttnP attn_base(unsigned char* ws) { AttnP P; P.Vt = (const bf16_t*)(ws + WS_VT); P.O = (bf16_t*)(ws + WS_O); P.sink = nullptr; P.lam = 0.f; P.osc = 1.f; P.subln = nullptr; return P; }
DI void ph_attn0(int wave_s, unsigned char* ws) {
    const Ctx C = make_ctx(ws, wave_s); const float* sink = inp(C, I_WIN_SINK); AttnP P = attn_base(ws); const bf16_t* RAW = (const bf16_t*)(ws + WS_RAW);
    P.Q = RAW; P.qp = 1536; P.K = RAW + 1024; P.kp = 1536; P.G = 4; P.HV = 4; P.cscale = 0.125f * LOG2E; P.sink = sink;
    for (int u = C.vcu; u < 1024 + 128; u += C.G) {
        if (u < 1024) { const int b = u >> 7, rem = u & 127; attn_unit<64, 64, false, true>(C, P, b, rem >> 3, rem & 7, false); }
        else { const int v = u - 1024; attn_unit<64, 64, false, true>(C, P, v >> 4, v & 15, 0, true); }
    }
}
DI void ph_attn1(int wave_s, unsigned char* ws) {
    const Ctx C = make_ctx(ws, wave_s); AttnP P = attn_base(ws); const bf16_t* RAW = (const bf16_t*)(ws + WS_RAW);
    P.Q = RAW; P.qp = 1536; P.K = RAW + 1024; P.kp = 1536; P.G = 4; P.HV = 2; P.cscale = 0.08838834764831845f * LOG2E;
    for (int u = C.vcu; u < 512 + 64; u += C.G) {
        if (u < 512) { const int b = u >> 6, rem = u & 63; attn_unit<128, 128, false, false>(C, P, b, rem >> 3, rem & 7, false); }
        else { const int v = u - 512; attn_unit<128, 128, false, false>(C, P, v >> 3, v & 7, 0, true); }
    }
}
DI void ph_attn2(int wave_s, unsigned char* ws) {
    const Ctx C = make_ctx(ws, wave_s); AttnP P = attn_base(ws);
    P.Q = (const bf16_t*)(ws + WS_Q2); P.qp = 1536; P.K = (const bf16_t*)(ws + WS_KF); P.kp = 1536; P.G = 1; P.HV = 16; P.cscale = 0.10206207261596577f * LOG2E;
    for (int u = C.vcu; u < 1024 + 128; u += C.G) {
        if (u < 1024) { const int b = u >> 7, rem = u & 127; attn_unit<96, 64, false, false>(C, P, b, rem >> 3, rem & 7, false); }
        else { const int v = u - 1024; attn_unit<96, 64, false, false>(C, P, v >> 4, v & 15, 0, true); }
    }
}
DI void ph_attn3(int wave_s, unsigned char* ws) {
    const Ctx C = make_ctx(ws, wave_s); const float* lp = inp(C, I_DIFF_LAM); const float* subln = inp(C, I_DIFF_SUBLN); AttnP P = attn_base(ws); const bf16_t* RAW = (const bf16_t*)(ws + WS_RAW);
    P.Q = RAW; P.qp = 3072; P.K = RAW + 1024; P.kp = 3072; P.G = 1; P.HV = 8; P.cscale = 0.125f * LOG2E; P.subln = subln;
    const float linit = 0.8f - 0.6f * expf(-0.3f * 3.0f);
    const float s1 = wave_sum(lp[C.lane] * lp[64 + C.lane], C.lane), s2 = wave_sum(lp[128 + C.lane] * lp[192 + C.lane], C.lane);
    P.lam = expf(s1) - expf(s2) + linit; P.osc = 1.0f - linit;
    for (int u = C.vcu; u < 1024; u += C.G) { const int b = u >> 7, rem = u & 127; attn_unit<64, 128, true, false>(C, P, b, rem >> 4, rem & 15, false); }
}

DI void moe_tables(const Ctx& C, int l) {
    const unsigned* cnt = (const unsigned*)(C.ws + WS_CTL) + CW_CNT + l * 32;
    __syncthreads();
    if (C.tid == 0) {
        unsigned t = 0, c = 0;
        for (int e = 0; e < NEXP; ++e) { const unsigned n = __hip_atomic_load(cnt + e, __ATOMIC_RELAXED, __HIP_MEMORY_SCOPE_AGENT); C.misc[MW_TP + e] = t; C.misc[MW_CP + e] = c; const unsigned nt = (n + 255u) >> 8;
            for (unsigned i = 0; i < nt; ++i) C.misc[MW_TEXP + t + i] = (unsigned)e; t += nt; c += n; }
        C.misc[MW_TP + 32] = t; C.misc[MW_CP + 32] = c;
    }
    __syncthreads();
}

DI void phase_ln1(int wave_s, unsigned char* ws, int l) {
    const Ctx C = make_ctx(ws, wave_s); float* X = (float*)(ws + WS_X); const float* Y = (const float*)(ws + WS_Y); bf16_t* H = (bf16_t*)(ws + WS_H);
    LAS float* hs = (LAS float*)C.lds;
    LAS float* part = hs + 8 * 1024;
    LAS float* logits = part + 16 * 8 * 32;
    LAS int* lsel = (LAS int*)(logits + 256);
    LAS int* lslot = lsel + 288;
    const int rbase = l == 3 ? NCTX : 0, nchunks = (NT - rbase) / 8; int nmine = 0;
    const float* rw = inp(C, I_RW) + (size_t)l * DM * NEXP; const float* rb = inp(C, I_RB) + l * NEXP;
    float* gate = (float*)(ws + WS_GATE);
    for (int cidx = C.vcu; cidx < nchunks && nmine < 9; cidx += C.G, ++nmine) {
        const int ch = nmine; const int row = rbase + cidx * 8 + C.wave; const int m = modidx(row);
        {
            f32x4 x[4], y[4], g1[4], h[4]; ld_row(X + (size_t)row * DM, C.lane, x); ld_row(Y + (size_t)row * DM, C.lane, y); ld_row(modp(C, l, m, 2), C.lane, g1);
#pragma unroll
            for (int j = 0; j < 4; ++j) x[j] = x[j] * DN_ALPHA + g1[j] * y[j];
            layernorm_row(x, inp(C, I_LN1G) + l * DM, inp(C, I_LN1B) + l * DM, C.lane);
            st_row(X + (size_t)row * DM, C.lane, x);
            modulate_row(x, modp(C, l, m, 3), modp(C, l, m, 4), C.lane, h);
            st_row_bf(H + (size_t)row * DM, C.lane, h);
#pragma unroll
            for (int j = 0; j < 4; ++j) *(LAS f32x4*)(hs + C.wave * 1024 + j * 256 + C.lane * 4) = h[j];
        }
        __syncthreads();
        {
            const int e = C.tid & 31, kq = C.tid >> 5; float acc[8];
#pragma unroll
            for (int r = 0; r < 8; ++r) acc[r] = 0.f;
            for (int dd = 0; dd < 64; dd += 4) { const int d = kq * 64 + dd;
                const float w0 = rw[(d + 0) * 32 + e], w1 = rw[(d + 1) * 32 + e], w2 = rw[(d + 2) * 32 + e], w3 = rw[(d + 3) * 32 + e];
#pragma unroll
                for (int r = 0; r < 8; ++r) { const f32x4 hv = *(const LAS f32x4*)(hs + r * 1024 + d); acc[r] += (hv[0] * w0 + hv[1] * w1) + (hv[2] * w2 + hv[3] * w3); } }
#pragma unroll
            for (int r = 0; r < 8; ++r) part[(kq * 8 + r) * 32 + e] = acc[r];
        }
        __syncthreads();
        if (C.tid < 256) { const int r = C.tid >> 5, e = C.tid & 31; float s = 0.f;
#pragma unroll
            for (int kq = 0; kq < 16; ++kq) s += part[(kq * 8 + r) * 32 + e];
            logits[r * 32 + e] = s + rb[e]; }
        __syncthreads();
        if (C.tid < 8) {
            const int r = C.tid; const int grow = rbase + cidx * 8 + r;
            float v0 = -INFINITY, v1 = -INFINITY, v2 = -INFINITY, v3 = -INFINITY; int i0 = 0, i1 = 0, i2 = 0, i3 = 0;
            for (int e = 0; e < 32; ++e) { const float x = logits[r * 32 + e];
                if (x > v3) { if (x > v2) { v3 = v2; i3 = i2; if (x > v1) { v2 = v1; i2 = i1; if (x > v0) { v1 = v0; i1 = i0; v0 = x; i0 = e; } else { v1 = x; i1 = e; } } else { v2 = x; i2 = e; } } else { v3 = x; i3 = e; } } }
            const float e1 = expf(v1 - v0), e2 = expf(v2 - v0), e3 = expf(v3 - v0), inv = 1.0f / (1.0f + e1 + e2 + e3);
            const int li = (ch * 8 + r) * 4;
            lsel[li] = i0; lsel[li + 1] = i1; lsel[li + 2] = i2; lsel[li + 3] = i3;
            lslot[li] = grow * 4; lslot[li + 1] = grow * 4 + 1; lslot[li + 2] = grow * 4 + 2; lslot[li + 3] = grow * 4 + 3;
            *(f32x4*)(gate + (size_t)grow * 4) = (f32x4){inv, e1 * inv, e2 * inv, e3 * inv};
        }
        __syncthreads();
    }
    if (C.tid < 32) {
        const int e = C.tid, nsel = nmine * 32; int n = 0;
        for (int i = 0; i < nsel; ++i) n += (lsel[i] == e) ? 1 : 0;
        if (n) {
            unsigned* cnt = (unsigned*)(ws + WS_CTL) + CW_CNT + l * 32 + e;
            const unsigned base = __hip_atomic_fetch_add(cnt, (unsigned)n, __ATOMIC_RELAXED, __HIP_MEMORY_SCOPE_AGENT);
            int* list = (int*)(ws + WS_LIST) + (size_t)e * CAP + base; int j = 0;
            for (int i = 0; i < nsel; ++i) if (lsel[i] == e) { list[j] = lslot[i]; ++j; }
        }
    }
    __syncthreads();
}

DI void phase_perm(int wave_s, unsigned char* ws, int l) {
    const Ctx C = make_ctx(ws, wave_s); moe_tables(C, l);
    const int total = (int)C.misc[MW_CP + 32];
    const int* list = (const int*)(ws + WS_LIST); const bf16_t* H = (const bf16_t*)(ws + WS_H); bf16_t* HS = (bf16_t*)(ws + WS_HS);
    int* pos = (int*)(ws + WS_POS); float* gs = (float*)(ws + WS_GS); const float* gate = (const float*)(ws + WS_GATE);
    for (int g = C.vcu * 8 + C.wave; g < total; g += C.G * 8) {
        int e = 0;
        for (int k = 1; k < NEXP; ++k) e += ((int)C.misc[MW_CP + k] <= g) ? 1 : 0;
        const int p = g - (int)C.misc[MW_CP + e]; const int srow = (int)C.misc[MW_TP + e] * 256 + p;
        const int slot = list[(size_t)e * CAP + p]; const int tok = slot >> 2;
        const u32x4* sp = (const u32x4*)(H + (size_t)tok * DM); u32x4* dp = (u32x4*)(HS + (size_t)srow * DM);
        const u32x4 v0 = sp[C.lane], v1 = sp[64 + C.lane]; dp[C.lane] = v0; dp[64 + C.lane] = v1;
        if (C.lane == 0) { pos[slot] = srow; gs[srow] = gate[slot]; }
    }
}

DI void phase_ln2(int wave_s, unsigned char* ws, int l) {
    const Ctx C = make_ctx(ws, wave_s); float* X = (float*)(ws + WS_X); bf16_t* H = (bf16_t*)(ws + WS_H); const bf16_t* YS = (const bf16_t*)(ws + WS_YS); const int* pos = (const int*)(ws + WS_POS);
    const int r0 = l == 3 ? NCTX : 0;
    for (int row = r0 + C.vcu * 8 + C.wave; row < NT; row += C.G * 8) {
        const int m = modidx(row);
        f32x4 x[4], g2[4], ys[4]; ld_row(X + (size_t)row * DM, C.lane, x); ld_row(modp(C, l, m, 5), C.lane, g2);
#pragma unroll
        for (int j = 0; j < 4; ++j) ys[j] = (f32x4){0.f, 0.f, 0.f, 0.f};
        const u32x4 pp = *(const u32x4*)(pos + (size_t)row * 4);
        const unsigned pr[4] = {pp.x, pp.y, pp.z, pp.w};
#pragma unroll
        for (int k = 0; k < 4; ++k) { const bf16_t* yp = YS + (size_t)pr[k] * DM;
#pragma unroll
            for (int j = 0; j < 4; ++j) { const u32x2 w = *(const u32x2*)(yp + j * 256 + C.lane * 4); ys[j] += (f32x4){bf_lo(w.x), bf_hi(w.x), bf_lo(w.y), bf_hi(w.y)}; } }
#pragma unroll
        for (int j = 0; j < 4; ++j) x[j] = x[j] * DN_ALPHA + g2[j] * ys[j];
        layernorm_row(x, inp(C, I_LN2G) + l * DM, inp(C, I_LN2B) + l * DM, C.lane);
        if (l == 3) { st_row((float*)inp(C, 36) + (size_t)(row - NCTX) * DM, C.lane, x); }
        else { st_row(X + (size_t)row * DM, C.lane, x); f32x4 h[4]; modulate_row(x, modp(C, l + 1, m, 0), modp(C, l + 1, m, 1), C.lane, h); st_row_bf(H + (size_t)row * DM, C.lane, h); }
    }
}

DI void ph_gemm_bf16(int wave_s, unsigned char* ws, const bf16_t* A, const bf16_t* Bt, int M, int N, int K, bf16_t* out, int ldc, int bias_idx) {
    const Ctx C = make_ctx(ws, wave_s); const float* bias = bias_idx >= 0 ? inp(C, bias_idx) : nullptr;
    pg8::DenseOrder S; S.A = (const char*)A; S.B = (const char*)Bt; S.nN = N / 256; S.nunits = (M / 256) * S.nN; S.G = C.G; S.c = C.vcu; S.r0 = 0; S.step = (size_t)256 * K * 2;
    pg8::EpiBf16 E{out, ldc, bias};
    pg8::gemm_phase<pg8::EpiBf16, pg8::DenseOrder>(C.lds, C.tid, K, S, E);
}
DI void ph_gemm_wo(int wave_s, unsigned char* ws, const bf16_t* W, int r0, int bias_idx) {
    const Ctx C = make_ctx(ws, wave_s); const float* bias = bias_idx >= 0 ? inp(C, bias_idx) : nullptr;
    pg8::DenseOrder S; S.A = (const char*)((const bf16_t*)(ws + WS_O) + (size_t)r0 * DM); S.B = (const char*)W; S.nN = 4; S.nunits = ((NT - r0) / 256) * 4; S.G = C.G; S.c = C.vcu; S.r0 = r0; S.step = (size_t)256 * 1024 * 2;
    pg8::EpiF32 E{(float*)(ws + WS_Y), DM, bias};
    pg8::gemm_phase<pg8::EpiF32, pg8::DenseOrder>(C.lds, C.tid, 1024, S, E);
}
DI void ph_moe1(int wave_s, unsigned char* ws, int l) {
    const Ctx C = make_ctx(ws, wave_s); const float* b_in = inp(C, I_BIN);
    moe_tables(C, l);
    pg8::MoeOrder<3, 2048> S; S.A = (const char*)(ws + WS_HS); S.B = (const char*)(ws + WS_WIN) + (size_t)l * 32 * 2048 * 1024 * 2; S.misc = C.misc; S.G = C.G; S.c = C.vcu;
    pg8::EpiSwiglu E{(bf16_t*)(ws + WS_ACT), b_in + (size_t)l * 32 * 2048};
    pg8::gemm_phase<pg8::EpiSwiglu, pg8::MoeOrder<3, 2048>>(C.lds, C.tid, 1024, S, E);
}
DI void ph_moe2(int wave_s, unsigned char* ws, int l) {
    const Ctx C = make_ctx(ws, wave_s); const float* b_out = inp(C, I_BOUT);
    moe_tables(C, l);
    pg8::MoeOrder<2, 1024> S; S.A = (const char*)(ws + WS_ACT); S.B = (const char*)(ws + WS_WOUT) + (size_t)l * 32 * 1024 * 1024 * 2; S.misc = C.misc; S.G = C.G; S.c = C.vcu;
    pg8::EpiMoe2 E{(bf16_t*)(ws + WS_YS), b_out + (size_t)l * 32 * 1024, (const float*)(ws + WS_GS)};
    pg8::gemm_phase<pg8::EpiMoe2, pg8::MoeOrder<2, 1024>>(C.lds, C.tid, 1024, S, E);
}

constexpr int NPHASE = 2 + 11 * DEPTH;

__global__ void __launch_bounds__(512, 2) dit_fwd(Args args) {
    {
        LAS unsigned* mz = (LAS unsigned*)((LAS unsigned char*)lds_raw + MISC_OFF);
        for (int u = threadIdx.x; u < (LDS_BYTES - MISC_OFF) / 4; u += 512) mz[u] = 0u;
        __syncthreads();
        if (threadIdx.x == 0) {
#pragma unroll
            for (int i = 0; i < 36; ++i) { const unsigned long long p = (unsigned long long)args.in[i]; mz[MW_PTR + 2 * i] = (unsigned)p; mz[MW_PTR + 2 * i + 1] = (unsigned)(p >> 32); }
            const unsigned long long p = (unsigned long long)args.out; mz[MW_PTR + 72] = (unsigned)p; mz[MW_PTR + 73] = (unsigned)(p >> 32);
        }
        __syncthreads();
    }
    const int wave_s = __builtin_amdgcn_readfirstlane((int)threadIdx.x >> 6);
    const int lo = args.ph_lo, hi = args.ph_hi;
    unsigned char* ws = args.ws;
    XcdBarrier bar; bar.bar = (unsigned*)(ws + WS_CTL) + CW_BAR; bar.x = 0; bar.st = nullptr;
    if (hi - lo > 1) bar = xcd_barrier_post((unsigned*)(ws + WS_CTL) + CW_BAR, (volatile LAS unsigned*)((LAS unsigned char*)lds_raw + MISC_OFF) + 8);
#define IN(k) (lo <= (k) && (k) < hi)
#define SEAM(k) do { if ((k) + 1 < hi) xcd_barrier(bar); } while (0)
    bf16_t* wsm = (bf16_t*)(ws + WS_WSMALL);
    if (IN(0)) { phase_prologue(wave_s, ws); SEAM(0); }
    if (IN(1)) { phase_modh0(wave_s, ws); SEAM(1); }
    for (int l = 0; l < DEPTH; ++l) {
        const int pb = 2 + 11 * l;
        if (IN(pb + 0)) {
            const bf16_t* W = wsm + (l == 0 ? OFF_WQKV0 : l == 1 ? OFF_WQKV1 : l == 2 ? OFF_WA : OFF_WQKV3) / 2;
            const int N = l == 2 ? 768 : (l == 3 ? 3072 : 1536);
            ph_gemm_bf16(wave_s, ws, (const bf16_t*)(ws + WS_H), W, NT, N, 1024, (bf16_t*)(ws + WS_RAW), N, l == 0 ? (int)I_WIN_BQKV : -1);
            SEAM(pb + 0);
        }
        if (IN(pb + 1)) { phase_post(wave_s, ws, l); SEAM(pb + 1); }
        if (l == 2) {
            if (IN(pb + 2)) {
                for (int j = 0; j < 2; ++j)
                    ph_gemm_bf16(wave_s, ws, (const bf16_t*)(ws + (j == 0 ? WS_CQ : WS_CKV)), wsm + (j == 0 ? OFF_WQB : OFF_WKVB) / 2, NT, j == 0 ? 1536 : 2048, j == 0 ? 384 : 256,
                                 (bf16_t*)(ws + (j == 0 ? WS_Q2 : WS_KV2)), j == 0 ? 1536 : 2048, -1);
                SEAM(pb + 2);
            }
            if (IN(pb + 3)) { phase_postb(wave_s, ws); SEAM(pb + 3); }
        }
        if (IN(pb + 4)) {
            if (l == 0) ph_attn0(wave_s, ws); else if (l == 1) ph_attn1(wave_s, ws); else if (l == 2) ph_attn2(wave_s, ws); else ph_attn3(wave_s, ws);
            SEAM(pb + 4);
        }
        if (IN(pb + 5)) {
            const bf16_t* W = wsm + (l == 0 ? OFF_WO0 : l == 1 ? OFF_WO1 : l == 2 ? OFF_WO2 : OFF_WO3) / 2;
            ph_gemm_wo(wave_s, ws, W, l == 3 ? NCTX : 0, l == 0 ? (int)I_WIN_BO : -1);
            SEAM(pb + 5);
        }
        if (IN(pb + 6)) { phase_ln1(wave_s, ws, l); SEAM(pb + 6); }
        if (IN(pb + 7)) { phase_perm(wave_s, ws, l); SEAM(pb + 7); }
        if (IN(pb + 8)) { ph_moe1(wave_s, ws, l); SEAM(pb + 8); }
        if (IN(pb + 9)) { ph_moe2(wave_s, ws, l); SEAM(pb + 9); }
        if (IN(pb + 10)) { phase_ln2(wave_s, ws, l); SEAM(pb + 10); }
    }
#undef IN
#undef SEAM
}

extern "C" void kernel_launch(void* const* d_in, const int* in_sizes, int n_in, void* d_out, int out_size, void* d_ws, size_t ws_size, hipStream_t stream) {
    static int grid = 0;
    if (grid == 0) {
        if (n_in != 36 || out_size != NB * SEQ * DM || ws_size < WS_END) { fprintf(stderr, "kernel_launch: unexpected shapes (n_in %d out %d ws %zu need %zu)\n", n_in, out_size, ws_size, (size_t)WS_END); grid = -1; return; }
        int dev = 0, cus = 0, per_cu = 0;
        if (hipGetDevice(&dev) != hipSuccess || hipDeviceGetAttribute(&cus, hipDeviceAttributeMultiprocessorCount, dev) != hipSuccess) { grid = -1; return; }
        if (hipFuncSetAttribute((const void*)dit_fwd, hipFuncAttributeMaxDynamicSharedMemorySize, LDS_BYTES) != hipSuccess) { fprintf(stderr, "kernel_launch: hipFuncSetAttribute failed\n"); grid = -1; return; }
        if (hipOccupancyMaxActiveBlocksPerMultiprocessor(&per_cu, (const void*)dit_fwd, 512, LDS_BYTES) != hipSuccess || per_cu < 1) fprintf(stderr, "kernel_launch: occupancy query says %d\n", per_cu);
        (void)hipGetLastError();
        grid = cus;
    }
    if (grid < 0) return;
    (void)hipMemsetAsync((char*)d_ws + WS_CTL, 0, CTL_BYTES, stream);
    Args a{};
    for (int i = 0; i < 36; ++i) a.in[i] = (const float*)d_in[i];
    a.out = (float*)d_out; a.ws = (unsigned char*)d_ws;
#if MK_PER_PHASE
    for (int ph = 0; ph < NPHASE; ++ph) {
        const int l = ph < 2 ? 0 : (ph - 2) / 11, s = ph < 2 ? 0 : (ph - 2) % 11;
        if (ph >= 2 && (s == 2 || s == 3) && l != 2) continue;
        a.ph_lo = ph; a.ph_hi = ph + 1;
        hipLaunchKernelGGL(dit_fwd, dim3(grid), dim3(512), LDS_BYTES, stream, a);
    }
#else
    a.ph_lo = 0; a.ph_hi = NPHASE;
    hipLaunchKernelGGL(dit_fwd, dim3(grid), dim3(512), LDS_BYTES, stream, a);
#endif
    const hipError_t le = hipPeekAtLastError();
    if (le != hipSuccess) fprintf(stderr, "kernel_launch: launch failed: %s\n", hipGetErrorName(le));
}
```

```cpp
#include <hip/hip_runtime.h>
#include <cstdio>
#include <cstdint>

#ifndef MK_PER_PHASE
#define MK_PER_PHASE 0
#endif

#define DI __device__ __forceinline__
#define GAS __attribute__((address_space(1)))
#define LAS __attribute__((address_space(3)))
typedef unsigned short bf16_t;
typedef short bf16x8 __attribute__((ext_vector_type(8)));
typedef float f32x2 __attribute__((ext_vector_type(2)));
typedef float f32x4 __attribute__((ext_vector_type(4)));
typedef float f32x16 __attribute__((ext_vector_type(16)));
typedef unsigned u32x2 __attribute__((ext_vector_type(2)));
typedef unsigned u32x4 __attribute__((ext_vector_type(4)));
typedef __bf16 bfv2 __attribute__((ext_vector_type(2)));

DI unsigned pk2(float lo, float hi) { f32x2 v = {lo, hi}; return __builtin_bit_cast(unsigned, __builtin_convertvector(v, bfv2)); }
DI float bf_lo(unsigned w) { return __uint_as_float(w << 16); }
DI float bf_hi(unsigned w) { return __uint_as_float(w & 0xffff0000u); }
DI float bf2f(bf16_t h) { return __uint_as_float((unsigned)h << 16); }
DI bf16_t f2bf(float f) { return (bf16_t)(pk2(f, 0.f) & 0xffffu); }
DI float shx(float v, int m, int lane) { return __int_as_float(__builtin_amdgcn_ds_bpermute((lane ^ m) << 2, __float_as_int(v))); }
DI float wave_sum(float v, int lane) {
#pragma unroll
    for (int o = 1; o < 64; o <<= 1) v += shx(v, o, lane);
    return v;
}

constexpr int NB = 8, SEQ = 2048, CTXL = 256, DM = 1024, DEPTH = 4;
constexpr int NCTX = NB * CTXL;
constexpr int NT = NCTX + NB * SEQ;
constexpr int NKEY = CTXL + SEQ;
constexpr int NEXP = 32, FF = 1024, CAP = NT;
constexpr int MAXT = 320;
constexpr float DN_ALPHA = 1.681792830507429f;
constexpr float LN_EPS = 1e-5f, NORM_EPS = 1e-6f;
constexpr float LOG2E = 1.4426950408889634f;

constexpr size_t MiB = 1u << 20;
constexpr size_t WS_CTL = 0, CTL_BYTES = 1 * MiB;
constexpr size_t WS_MOD = 1 * MiB;
constexpr size_t WS_ROPE = 2 * MiB;
constexpr size_t WS_WSMALL = 4 * MiB;
constexpr size_t OFF_WQKV0 = 0, OFF_WO0 = 3 * MiB, OFF_WQKV1 = 5 * MiB, OFF_WO1 = 8 * MiB, OFF_WA = 10 * MiB, OFF_WQB = 12 * MiB,
                 OFF_WKVB = 14 * MiB, OFF_WO2 = 15 * MiB, OFF_WQKV3 = 17 * MiB, OFF_WO3 = 23 * MiB;
constexpr size_t WS_WIN = 32 * MiB;
constexpr size_t WS_WOUT = WS_WIN + 512 * MiB;
constexpr size_t WS_X = WS_WOUT + 256 * MiB;
constexpr size_t WS_H = WS_X + 72 * MiB;
constexpr size_t WS_RAW = WS_H + 36 * MiB;
constexpr size_t WS_CQ = WS_RAW + 108 * MiB;
constexpr size_t WS_CKV = WS_CQ + 14 * MiB;
constexpr size_t WS_KPE = WS_CKV + 9 * MiB;
constexpr size_t WS_Q2 = WS_KPE + 2 * MiB;
constexpr size_t WS_KV2 = WS_Q2 + 54 * MiB;
constexpr size_t WS_KF = WS_KV2 + 72 * MiB;
constexpr size_t WS_VT = WS_KF + 54 * MiB;
constexpr size_t WS_O = WS_VT + 36 * MiB;
constexpr size_t WS_Y = WS_O + 36 * MiB;
constexpr size_t WS_LIST = WS_Y + 72 * MiB;
constexpr size_t WS_GATE = WS_LIST + 3 * MiB;
constexpr size_t WS_POS = WS_GATE + 1 * MiB;
constexpr size_t WS_GS = WS_POS + 1 * MiB;
constexpr size_t WS_HS = WS_GS + 1 * MiB;
constexpr size_t WS_ACT = WS_HS + 160 * MiB;
constexpr size_t WS_YS = WS_ACT + 160 * MiB;
constexpr size_t WS_END = WS_YS + 160 * MiB;
constexpr int CW_CNT = 64;
constexpr int CW_BAR = 4096;

constexpr int RT16 = 0, RT32 = RT16 + 2 * 2048 * 2 * 16, RT8 = RT32 + 2 * 2048 * 2 * 32, RT_END = RT8 + 2 * 2048 * 2 * 8;

constexpr int RING_BYTES = 131072;
constexpr int MISC_OFF = RING_BYTES;
constexpr int LDS_BYTES = 147456;
constexpr int MW_TP = 64, MW_CP = 128, MW_TEXP = 192, MW_PTR = 512;

namespace pg8 {
constexpr int BM = 256, BK = 64, HALF = 128, HTB = HALF * BK * 2, STAGE_BYTES = 8 * HTB;
__host__ __device__ __forceinline__ int lds_byte(int r, int c) { const int st = (r >> 4) * 2 + (c >> 5), rr = r & 15, cc = c & 31, ob = rr * 64 + cc * 2; return st * 1024 + (ob ^ (((ob >> 9) & 1) << 5)); }
__host__ __device__ __forceinline__ void stage_rc(int b, int& R, int& C) { const int st = b / 1024, sb = b % 1024, swz = sb ^ (((sb >> 9) & 1) << 5); R = (st >> 1) * 16 + swz / 64; C = (st & 1) * 32 + (swz % 64) / 2; }
__host__ __device__ __forceinline__ int perm32(int rho) { const int n = rho >> 4, i = rho & 15; return 8 * (i >> 2) + 4 * n + (i & 3); }

struct Unit { const char* a; const char* b; int r0, c0, aux; };

template <class Epi, class Sched>
__device__ __forceinline__ void gemm_phase(LAS unsigned char* lds, const int tid, const int K, const Sched& S, const Epi& E) {
    const int wid = __builtin_amdgcn_readfirstlane(tid >> 6), lane = tid & 63, wr = wid >> 2, wc = wid & 3, fr = lane & 15, fq = lane >> 4;
    const int nt = K / BK;
    unsigned voffA[2], voffB[2];
#pragma unroll
    for (int i = 0; i < 2; ++i) { int R, C; stage_rc(tid * 16 + i * 8192, R, C); const int Rb = Epi::PERM ? ((R & ~31) + perm32(R & 31)) : R;
        voffA[i] = (unsigned)(R * K + C) * 2u; voffB[i] = (unsigned)(Rb * K + C) * 2u; }
    const size_t kstep = (size_t)(BK * 2);
    const size_t hstep = (size_t)HALF * K * 2;
    const unsigned ldsw = (unsigned)wid * 1024u;
    const int aoff = lds_byte(wr * 64 + fr, fq * 8), boff = lds_byte(wc * 32 + fr, fq * 8);
#define PG8_SA(b, h) (((b) * 2 + (h)) * HTB)
#define PG8_SB(b, h) ((4 + (b) * 2 + (h)) * HTB)
#define PG8_STAGE(bufoff, gbase, voff) do { _Pragma("unroll") for (int _i = 0; _i < 2; ++_i) \
        __builtin_amdgcn_global_load_lds((const unsigned*)((const char*)(gbase) + (voff)[_i]), (LAS unsigned*)(lds + (bufoff) + ldsw + _i * 8192), 16, 0, 0); } while (0)
#define PG8_LDA(dst, b, h) do { _Pragma("unroll") for (int m = 0; m < 4; ++m) _Pragma("unroll") for (int k = 0; k < 2; ++k) dst[m][k] = *(const LAS bf16x8*)(lds + PG8_SA(b, h) + aoff + m * 2048 + k * 1024); } while (0)
#define PG8_LDB(dst, b, h) do { _Pragma("unroll") for (int n = 0; n < 2; ++n) _Pragma("unroll") for (int k = 0; k < 2; ++k) dst[n][k] = *(const LAS bf16x8*)(lds + PG8_SB(b, h) + boff + n * 2048 + k * 1024); } while (0)
#define PG8_MMA(ai, bj, At, Bt) do { __builtin_amdgcn_s_setprio(1); _Pragma("unroll") for (int m = 0; m < 4; ++m) _Pragma("unroll") for (int n = 0; n < 2; ++n) _Pragma("unroll") for (int k = 0; k < 2; ++k) \
        acc[ai][bj][m][n] = __builtin_amdgcn_mfma_f32_16x16x32_bf16(Bt[n][k], At[m][k], acc[ai][bj][m][n], 0, 0, 0); __builtin_amdgcn_s_setprio(0); } while (0)
#define PG8_WAIT_V(n) asm volatile("s_waitcnt vmcnt(" #n ")" ::: "memory")
#define PG8_WAIT_L(n) asm volatile("s_waitcnt lgkmcnt(" #n ")" ::: "memory")
#define PG8_BAR __builtin_amdgcn_s_barrier()
#define PG8_SCHED __builtin_amdgcn_sched_barrier(0)
    Unit cur, nxt; int ui = 0;
    if (!S.next(0, cur)) return;
    f32x4 acc[2][2][4][2];
#pragma unroll
    for (int a = 0; a < 2; ++a)
#pragma unroll
        for (int b = 0; b < 2; ++b)
#pragma unroll
            for (int m = 0; m < 4; ++m)
#pragma unroll
                for (int n = 0; n < 2; ++n) acc[a][b][m][n] = (f32x4){0.f, 0.f, 0.f, 0.f};
    bf16x8 At[4][2], B0[2][2], B1[2][2];
    const char* cA = cur.a; const char* cB = cur.b;
    PG8_STAGE(PG8_SB(0, 0), cB, voffB); PG8_STAGE(PG8_SB(0, 1), cB + hstep, voffB); PG8_STAGE(PG8_SA(0, 0), cA, voffA); PG8_STAGE(PG8_SA(0, 1), cA + hstep, voffA);
    if (wr == 1) PG8_BAR;
    PG8_WAIT_V(2); PG8_BAR;
    PG8_STAGE(PG8_SB(1, 0), cB + kstep, voffB); PG8_STAGE(PG8_SA(1, 0), cA + kstep, voffA); PG8_STAGE(PG8_SB(1, 1), cB + hstep + kstep, voffB);
    PG8_WAIT_V(6); PG8_BAR;
    for (;;) {
        const bool has_next = S.next(ui + 1, nxt);
        const char* nA = has_next ? nxt.a : cA; const char* nB = has_next ? nxt.b : cB;
        for (int t = 0; t < nt; t += 2) {
            const bool last = (t == nt - 2);
            const char* a1 = cA + (size_t)(t + 1) * kstep;
            const char* a2 = last ? nA : cA + (size_t)(t + 2) * kstep; const char* b2 = last ? nB : cB + (size_t)(t + 2) * kstep;
            const char* a3 = a2 + kstep; const char* b3 = b2 + kstep;
            PG8_LDB(B0, 0, 0); PG8_LDB(B1, 0, 1); PG8_SCHED; PG8_LDA(At, 0, 0); PG8_STAGE(PG8_SA(1, 1), a1 + hstep, voffA);
            PG8_WAIT_V(8); PG8_WAIT_L(0); PG8_BAR; PG8_MMA(0, 0, At, B0); PG8_MMA(0, 1, At, B1); PG8_BAR; PG8_SCHED;
            PG8_LDA(At, 0, 1); PG8_STAGE(PG8_SB(0, 0), b2, voffB); PG8_STAGE(PG8_SB(0, 1), b2 + hstep, voffB); PG8_STAGE(PG8_SA(0, 0), a2, voffA);
            PG8_WAIT_V(8); PG8_WAIT_L(0); PG8_BAR; PG8_MMA(1, 0, At, B0); PG8_MMA(1, 1, At, B1); PG8_BAR; PG8_SCHED;
            PG8_LDB(B0, 1, 0); PG8_LDB(B1, 1, 1); PG8_SCHED; PG8_LDA(At, 1, 0); PG8_STAGE(PG8_SA(0, 1), a2 + hstep, voffA);
            PG8_WAIT_V(8); PG8_WAIT_L(0); PG8_BAR; PG8_MMA(0, 0, At, B0); PG8_MMA(0, 1, At, B1); PG8_BAR; PG8_SCHED;
            PG8_LDA(At, 1, 1); PG8_STAGE(PG8_SB(1, 0), b3, voffB); PG8_STAGE(PG8_SB(1, 1), b3 + hstep, voffB); PG8_STAGE(PG8_SA(1, 0), a3, voffA);
            PG8_WAIT_V(8); PG8_WAIT_L(0); PG8_BAR; PG8_MMA(1, 0, At, B0); PG8_MMA(1, 1, At, B1); PG8_BAR; PG8_SCHED;
        }
        if (wr == 0) PG8_BAR;
        E(acc, cur, wr, wc, fr, fq);
        if (!has_next) break;
#pragma unroll
        for (int a = 0; a < 2; ++a)
#pragma unroll
            for (int b = 0; b < 2; ++b)
#pragma unroll
                for (int m = 0; m < 4; ++m)
#pragma unroll
                    for (int n = 0; n < 2; ++n) acc[a][b][m][n] = (f32x4){0.f, 0.f, 0.f, 0.f};
        cur = nxt; cA = nA; cB = nB; ++ui;
        if (wr == 1) PG8_BAR;
    }
    PG8_WAIT_V(0);
    PG8_BAR;
#undef PG8_SA
#undef PG8_SB
#undef PG8_STAGE
#undef PG8_LDA
#undef PG8_LDB
#undef PG8_MMA
#undef PG8_WAIT_V
#undef PG8_WAIT_L
#undef PG8_BAR
#undef PG8_SCHED
}

struct EpiBf16 {
    static constexpr bool PERM = true;
    bf16_t* O; int ldc; const float* bias;
    DI void operator()(const f32x4 (&acc)[2][2][4][2], const Unit& u, int wr, int wc, int fr, int fq) const {
        const int row0 = u.r0 + wr * 64 + fr, col0 = u.c0 + wc * 32 + 8 * fq;
        f32x4 bv[2][2];
#pragma unroll
        for (int bj = 0; bj < 2; ++bj)
#pragma unroll
            for (int n = 0; n < 2; ++n) bv[bj][n] = bias ? *(const f32x4*)(bias + col0 + bj * HALF + 4 * n) : (f32x4){0.f, 0.f, 0.f, 0.f};
#pragma unroll
        for (int ai = 0; ai < 2; ++ai)
#pragma unroll
            for (int m = 0; m < 4; ++m) { bf16_t* rowp = O + (size_t)(row0 + ai * HALF + m * 16) * ldc + col0;
#pragma unroll
                for (int bj = 0; bj < 2; ++bj) { const f32x4 v0 = acc[ai][bj][m][0] + bv[bj][0], v1 = acc[ai][bj][m][1] + bv[bj][1];
                    u32x4 w; w.x = pk2(v0[0], v0[1]); w.y = pk2(v0[2], v0[3]); w.z = pk2(v1[0], v1[1]); w.w = pk2(v1[2], v1[3]);
                    *(u32x4*)(rowp + bj * HALF) = w; } }
    }
};
struct EpiF32 {
    static constexpr bool PERM = false;
    float* Y; int ldc; const float* bias;
    DI void operator()(const f32x4 (&acc)[2][2][4][2], const Unit& u, int wr, int wc, int fr, int fq) const {
        const int row0 = u.r0 + wr * 64 + fr, col0 = u.c0 + wc * 32 + 4 * fq;
        f32x4 bv[2][2];
#pragma unroll
        for (int bj = 0; bj < 2; ++bj)
#pragma unroll
            for (int n = 0; n < 2; ++n) bv[bj][n] = bias ? *(const f32x4*)(bias + col0 + bj * HALF + 16 * n) : (f32x4){0.f, 0.f, 0.f, 0.f};
#pragma unroll
        for (int ai = 0; ai < 2; ++ai)
#pragma unroll
            for (int m = 0; m < 4; ++m) { float* rowp = Y + (size_t)(row0 + ai * HALF + m * 16) * ldc + col0;
#pragma unroll
                for (int bj = 0; bj < 2; ++bj)
#pragma unroll
                    for (int n = 0; n < 2; ++n) *(f32x4*)(rowp + bj * HALF + 16 * n) = acc[ai][bj][m][n] + bv[bj][n]; }
    }
};
DI float swiglu1(float g, float lin) {
    g = fminf(g, 7.0f); lin = fminf(fmaxf(lin, -7.0f), 7.0f);
    const float s = __builtin_amdgcn_rcpf(1.0f + __builtin_amdgcn_exp2f(-1.702f * LOG2E * g));
    return g * s * (lin + 1.0f);
}
struct EpiSwiglu {
    static constexpr bool PERM = true;
    bf16_t* O; const float* bias;
    DI void operator()(const f32x4 (&acc)[2][2][4][2], const Unit& u, int wr, int wc, int fr, int fq) const {
        const int row0 = u.r0 + wr * 64 + fr, col0 = u.c0 + wc * 32 + 8 * fq;
        const float* bp = bias + (size_t)u.aux * (2 * FF) + col0;
        f32x4 bv[2][2];
#pragma unroll
        for (int bj = 0; bj < 2; ++bj)
#pragma unroll
            for (int n = 0; n < 2; ++n) bv[bj][n] = *(const f32x4*)(bp + bj * HALF + 4 * n);
#pragma unroll
        for (int ai = 0; ai < 2; ++ai)
#pragma unroll
            for (int m = 0; m < 4; ++m) { bf16_t* rowp = O + (size_t)(row0 + ai * HALF + m * 16) * FF + (col0 >> 1);
#pragma unroll
                for (int bj = 0; bj < 2; ++bj) { const f32x4 v0 = acc[ai][bj][m][0] + bv[bj][0], v1 = acc[ai][bj][m][1] + bv[bj][1];
                    u32x2 w; w.x = pk2(swiglu1(v0[0], v0[1]), swiglu1(v0[2], v0[3])); w.y = pk2(swiglu1(v1[0], v1[1]), swiglu1(v1[2], v1[3]));
                    *(u32x2*)(rowp + bj * (HALF / 2)) = w; } }
    }
};
struct EpiMoe2 {
    static constexpr bool PERM = true;
    bf16_t* O; const float* bias; const float* gs;
    DI void operator()(const f32x4 (&acc)[2][2][4][2], const Unit& u, int wr, int wc, int fr, int fq) const {
        const int row0 = u.r0 + wr * 64 + fr, col0 = u.c0 + wc * 32 + 8 * fq;
        const float* bp = bias + (size_t)u.aux * DM + col0;
        f32x4 bv[2][2];
#pragma unroll
        for (int bj = 0; bj < 2; ++bj)
#pragma unroll
            for (int n = 0; n < 2; ++n) bv[bj][n] = *(const f32x4*)(bp + bj * HALF + 4 * n);
#pragma unroll
        for (int ai = 0; ai < 2; ++ai)
#pragma unroll
            for (int m = 0; m < 4; ++m) { const int row = row0 + ai * HALF + m * 16; const float g = gs[row]; bf16_t* rowp = O + (size_t)row * DM + col0;
#pragma unroll
                for (int bj = 0; bj < 2; ++bj) { const f32x4 v0 = (acc[ai][bj][m][0] + bv[bj][0]) * g, v1 = (acc[ai][bj][m][1] + bv[bj][1]) * g;
                    u32x4 w; w.x = pk2(v0[0], v0[1]); w.y = pk2(v0[2], v0[3]); w.z = pk2(v1[0], v1[1]); w.w = pk2(v1[2], v1[3]);
                    *(u32x4*)(rowp + bj * HALF) = w; } }
    }
};
struct DenseOrder {
    const char* A; const char* B; int nN, nunits, G, c, r0; size_t step;
    DI bool next(int i, Unit& u) const {
        const int L = i * G + c; if (L >= nunits) return false;
        const int pm = L / nN, pn = L - pm * nN;
        u.a = A + (size_t)pm * step; u.b = B + (size_t)pn * step; u.r0 = r0 + pm * BM; u.c0 = pn * BM; u.aux = 0; return true;
    }
};
template <int LGN, int BROWS>
struct MoeOrder {
    const char* A; const char* B; const volatile LAS unsigned* misc; int G, c;
    DI bool next(int i, Unit& u) const {
        const int L = i * G + c; const int ntile = __builtin_amdgcn_readfirstlane((int)misc[MW_TP + 32]);
        if (L >= (ntile << LGN)) return false;
        const int T = L >> LGN, pn = L & ((1 << LGN) - 1); const int e = __builtin_amdgcn_readfirstlane((int)misc[MW_TEXP + T]);
        u.a = A + (size_t)T * (256 * 1024 * 2); u.b = B + (size_t)(e * BROWS + pn * 256) * (1024 * 2); u.r0 = T * BM; u.c0 = pn * BM; u.aux = e; return true;
    }
};
}

#define XB_TMO      128
#define XB_XCNT(j)  (256  + 64 * (j))
#define XB_XSUB(j)  (1280 + 64 * (j))
#define XB_XGEN(j)  (2304 + 64 * (j))
#define XB_TOP      3328
#define XB_TOPGEN   3392
#define XCD_BAR_WORDS 3456
#define XB_SPIN_CAP (1u << 18)
DI unsigned xb_ld(unsigned* p)              { return __hip_atomic_load(p, __ATOMIC_RELAXED, __HIP_MEMORY_SCOPE_AGENT); }
DI unsigned xb_add(unsigned* p, unsigned v) { return __hip_atomic_fetch_add(p, v, __ATOMIC_RELAXED, __HIP_MEMORY_SCOPE_AGENT); }
DI unsigned xb_xcc_id() { return (unsigned)__builtin_amdgcn_s_getreg((3 << 11) | 20) & 0xFu; }
#define XB_SPIN(cond, bar) do { unsigned _sp = 0; while (cond) { __builtin_amdgcn_s_sleep(1); \
    if ((++_sp & 255u) == 0u) { if (xb_ld(&(bar)[XB_TMO])) break; if (_sp > XB_SPIN_CAP) { atomicAdd(&(bar)[XB_TMO], 1u); break; } } } } while (0)
struct XcdBarrier { unsigned* bar; unsigned x; volatile LAS unsigned* st; };
DI XcdBarrier xcd_barrier_post(unsigned* bar, volatile LAS unsigned* st) {
    XcdBarrier b; b.bar = bar; b.x = xb_xcc_id(); b.st = st;
    if (threadIdx.x == 0) (void)xb_add(&bar[XB_XCNT(b.x)], 1u);
    return b;
}
DI void xcd_barrier_complete(unsigned* bar, unsigned x, unsigned& nloc, unsigned& nx) {
    const unsigned G = gridDim.x * gridDim.y * gridDim.z;
    unsigned sum, cnt, mine, sp = 0u;
    for (;;) {
        sum = 0u; cnt = 0u; mine = 0u;
#pragma unroll
        for (unsigned j = 0; j < 16; ++j) { const unsigned c = xb_ld(&bar[XB_XCNT(j)]); sum += c; cnt += (c > 0u) ? 1u : 0u; mine = (j == x) ? c : mine; }
        if (sum == G) break;
        __builtin_amdgcn_s_sleep(1);
        if ((++sp & 255u) == 0u) { if (xb_ld(&bar[XB_TMO])) break; if (sp > XB_SPIN_CAP) { atomicAdd(&bar[XB_TMO], 1u); break; } }
    }
    nloc = mine > 0u ? mine : 1u; nx = cnt > 0u ? cnt : 1u;
}
DI void xcd_barrier(const XcdBarrier& b) {
    asm volatile("s_waitcnt vmcnt(0)" ::: "memory");
    __syncthreads();
    if (threadIdx.x == 0) {
        unsigned* bar = b.bar;
        __builtin_amdgcn_s_waitcnt(0);
        unsigned nloc = b.st[0], nx = b.st[1];
        if (nloc == 0u) { xcd_barrier_complete(bar, b.x, nloc, nx); b.st[0] = nloc; b.st[1] = nx; }
        const unsigned old = xb_add(&bar[XB_XSUB(b.x)], 1u);
        const unsigned gen = old / nloc;
        if (old + 1u == (gen + 1u) * nloc) {
            __builtin_amdgcn_fence(__ATOMIC_RELEASE, "agent");
            asm volatile("s_waitcnt vmcnt(0)" ::: "memory");
            const unsigned og = xb_add(&bar[XB_TOP], 1u);
            const unsigned tg = og / nx;
            if (og + 1u == (tg + 1u) * nx) xb_add(&bar[XB_TOPGEN], 1u);
            else XB_SPIN(xb_ld(&bar[XB_TOPGEN]) == tg, bar);
            __builtin_amdgcn_fence(__ATOMIC_ACQUIRE, "agent");
            xb_add(&bar[XB_XGEN(b.x)], 1u);
            asm volatile("s_waitcnt vmcnt(0)" ::: "memory");
        } else {
            XB_SPIN(xb_ld(&bar[XB_XGEN(b.x)]) == gen, bar);
            __builtin_amdgcn_fence(__ATOMIC_ACQUIRE, "agent");
            asm volatile("s_waitcnt vmcnt(0)" ::: "memory");
        }
    }
    __syncthreads();
}

struct Args { const float* in[36]; float* out; unsigned char* ws; int ph_lo, ph_hi; };
enum { I_X = 0, I_C, I_CTX, I_CCTX, I_ADAW, I_ADAB, I_LN1G, I_LN1B, I_LN2G, I_LN2B, I_WIN_WQKV, I_WIN_BQKV, I_WIN_SINK, I_WIN_WO, I_WIN_BO,
       I_AXG_WQKV, I_AXG_QN, I_AXG_KN, I_AXG_WO, I_MLA_WQA, I_MLA_QN, I_MLA_WQB, I_MLA_WKVA, I_MLA_KVN, I_MLA_WKVB, I_MLA_WO,
       I_DIFF_WQKV, I_DIFF_LAM, I_DIFF_SUBLN, I_DIFF_WO, I_RW, I_RB, I_WIN, I_BIN, I_WOUT, I_BOUT };

struct Ctx {
    LAS unsigned char* lds; volatile LAS unsigned* misc; unsigned char* ws; int tid, lane, wave, vcu, G;
};
extern __shared__ __attribute__((aligned(16))) unsigned char lds_raw[];
DI Ctx make_ctx(unsigned char* ws, int wave_s) {
    int bx = blockIdx.x, G = gridDim.x;
    asm volatile("" : "+s"(bx), "+s"(G), "+s"(wave_s));
    unsigned z = 0u; asm volatile("" : "+v"(z));
    const int tid = wave_s * 64 + (int)__builtin_amdgcn_mbcnt_hi(~0u, __builtin_amdgcn_mbcnt_lo(~0u, z));
    Ctx C; C.lds = (LAS unsigned char*)lds_raw; C.misc = (volatile LAS unsigned*)(C.lds + MISC_OFF); C.ws = ws;
    C.tid = tid; C.lane = tid & 63; C.wave = wave_s;
    C.G = G; C.vcu = (G % 8 == 0) ? (bx % 8) * (G / 8) + bx / 8 : bx;
    return C;
}
DI const float* inp(const Ctx& C, int i) {
    const unsigned lo = __builtin_amdgcn_readfirstlane(C.misc[MW_PTR + 2 * i]), hi = __builtin_amdgcn_readfirstlane(C.misc[MW_PTR + 2 * i + 1]);
    return (const float*)(((unsigned long long)hi << 32) | lo);
}
DI int modidx(int row) { return row < NCTX ? 8 : ((row - NCTX) >> 11); }
DI const float* modp(const Ctx& C, int l, int m, int part) { return (const float*)(C.ws + WS_MOD) + ((size_t)(l * 9 + m) * 6 + part) * DM; }

DI void sincos_acc(float ang, float& s, float& c) {
    const double x = (double)ang; const int q = (int)__builtin_rint(x * 0.6366197723675814); const double rd = x - (double)q * 1.5707963267948966;
    const float r = (float)rd, r2 = r * r;
    const float sp = r + r * r2 * (-1.6666654611e-1f + r2 * (8.3321608736e-3f + r2 * (-1.9515295891e-4f)));
    const float cp = 1.0f - 0.5f * r2 + r2 * r2 * (4.166664568298827e-2f + r2 * (-1.388731625493765e-3f + r2 * 2.443315711809948e-5f));
    switch (q & 3) { case 0: s = sp; c = cp; break; case 1: s = cp; c = -sp; break; case 2: s = -sp; c = -cp; break; default: s = -cp; c = sp; break; }
}
DI void cvt_item(const float* src, int N, bf16_t* dst, int Kd, int row_off, int k0, int n0, int lane) {
    const int n = n0 + lane; const bool valid = n < N;
    const float* sp = src + (size_t)k0 * N + (valid ? n : 0);
    float v[64];
#pragma unroll
    for (int i = 0; i < 64; ++i) v[i] = sp[(size_t)i * N];
    if (valid) {
        bf16_t* dp = dst + (size_t)(row_off + n) * Kd + k0;
#pragma unroll
        for (int j = 0; j < 8; ++j) { u32x4 w; w.x = pk2(v[8 * j], v[8 * j + 1]); w.y = pk2(v[8 * j + 2], v[8 * j + 3]); w.z = pk2(v[8 * j + 4], v[8 * j + 5]); w.w = pk2(v[8 * j + 6], v[8 * j + 7]);
            *(u32x4*)(dp + 8 * j) = w; }
    }
}
DI bool cvt_mat(int& r, const float* src, int K, int N, bf16_t* dst, int row_off, int lane) {
    const int nb = (N + 63) >> 6, items = (K >> 6) * nb;
    if (r < items) { const int kb = r / nb, nbk = r - kb * nb; cvt_item(src, N, dst, K, row_off, kb * 64, nbk * 64, lane); return true; }
    r -= items; return false;
}
DI void phase_prologue(int wave_s, unsigned char* ws) {
    const Ctx C = make_ctx(ws, wave_s);
    if (C.vcu < 384) {
        LAS float* sv = (LAS float*)C.lds; LAS float* part = sv + 9 * 1024;
        for (int i = C.tid; i < 9 * 1024; i += 512) { const int m = i >> 10, k = i & 1023; const float c = m < 8 ? inp(C, I_C)[m * 1024 + k] : inp(C, I_CCTX)[k]; sv[i] = c / (1.0f + expf(-c)); }
        __syncthreads();
        for (int it = C.vcu; it < 384; it += C.G) {
            const int l = it / 96, cg = it - l * 96;
            const float* w = inp(C, I_ADAW) + (size_t)l * 1024 * 6144 + cg * 64 + C.lane;
            float acc[9];
#pragma unroll
            for (int m = 0; m < 9; ++m) acc[m] = 0.f;
#pragma unroll 8
            for (int kk = 0; kk < 128; ++kk) { const int k = C.wave * 128 + kk; const float wv = w[(size_t)k * 6144];
#pragma unroll
                for (int m = 0; m < 9; ++m) acc[m] += sv[m * 1024 + k] * wv; }
#pragma unroll
            for (int m = 0; m < 9; ++m) part[(C.wave * 9 + m) * 64 + C.lane] = acc[m];
            __syncthreads();
            for (int i = C.tid; i < 576; i += 512) { const int m = i >> 6, j = i & 63; float s = 0.f;
#pragma unroll
                for (int w8 = 0; w8 < 8; ++w8) s += part[(w8 * 9 + m) * 64 + j];
                const int col = cg * 64 + j; ((float*)(ws + WS_MOD))[(size_t)(l * 9 + m) * 6144 + col] = s + inp(C, I_ADAB)[l * 6144 + col]; }
            __syncthreads();
        }
    }
    {
        float* rt = (float*)(ws + WS_ROPE);
        const int total = 2048 * 2 * (16 + 32 + 8);
        for (int i = C.vcu * 512 + C.tid; i < total; i += C.G * 512) {
            int nf, base, idx = i;
            if (idx < 2048 * 2 * 16) { nf = 16; base = RT16; } else if ((idx -= 2048 * 2 * 16) < 2048 * 2 * 32) { nf = 32; base = RT32; } else { idx -= 2048 * 2 * 32; nf = 8; base = RT8; }
            const int f = idx % nf, half = (idx / nf) & 1, pos = idx / (2 * nf);
            const float pv = (float)(half == 0 ? (pos >> 6) : (pos & 63));
            const float inv = exp2f(-((float)f / (float)nf) * 13.287712379549449f);
            const float ang = pv * inv; float s, c; sincos_acc(ang, s, c);
            rt[base + idx] = c; rt[base + 2048 * 2 * nf + idx] = s;
        }
    }
    {
        bf16_t* wsm = (bf16_t*)(ws + WS_WSMALL);
        const int gw = C.vcu * 8 + C.wave, NGW = C.G * 8;
        constexpr int NI_IN = 128 * 512, NI_OUT = 128 * 256, NI_SMALL = 384 + 256 + 384 + 256 + 96 + 80 + 144 + 128 + 256 + 768 + 256;
        for (int it = gw; it < NI_IN + NI_OUT + NI_SMALL; it += NGW) {
            int r = it;
            if (r < NI_IN) { const int le = r >> 9, q = r & 511; cvt_item(inp(C, I_WIN) + (size_t)le * 1024 * 2048, 2048, (bf16_t*)(ws + WS_WIN) + (size_t)le * 2048 * 1024, 1024, 0, (q >> 5) * 64, (q & 31) * 64, C.lane); continue; }
            r -= NI_IN;
            if (r < NI_OUT) { const int le = r >> 8, q = r & 255; cvt_item(inp(C, I_WOUT) + (size_t)le * 1024 * 1024, 1024, (bf16_t*)(ws + WS_WOUT) + (size_t)le * 1024 * 1024, 1024, 0, (q >> 4) * 64, (q & 15) * 64, C.lane); continue; }
            r -= NI_OUT;
            if (cvt_mat(r, inp(C, I_WIN_WQKV), 1024, 1536, wsm + OFF_WQKV0 / 2, 0, C.lane)) continue;
            if (cvt_mat(r, inp(C, I_WIN_WO), 1024, 1024, wsm + OFF_WO0 / 2, 0, C.lane)) continue;
            if (cvt_mat(r, inp(C, I_AXG_WQKV), 1024, 1536, wsm + OFF_WQKV1 / 2, 0, C.lane)) continue;
            if (cvt_mat(r, inp(C, I_AXG_WO), 1024, 1024, wsm + OFF_WO1 / 2, 0, C.lane)) continue;
            if (cvt_mat(r, inp(C, I_MLA_WQA), 1024, 384, wsm + OFF_WA / 2, 0, C.lane)) continue;
            if (cvt_mat(r, inp(C, I_MLA_WKVA), 1024, 288, wsm + OFF_WA / 2, 384, C.lane)) continue;
            if (cvt_mat(r, inp(C, I_MLA_WQB), 384, 1536, wsm + OFF_WQB / 2, 0, C.lane)) continue;
            if (cvt_mat(r, inp(C, I_MLA_WKVB), 256, 2048, wsm + OFF_WKVB / 2, 0, C.lane)) continue;
            if (cvt_mat(r, inp(C, I_MLA_WO), 1024, 1024, wsm + OFF_WO2 / 2, 0, C.lane)) continue;
            if (cvt_mat(r, inp(C, I_DIFF_WQKV), 1024, 3072, wsm + OFF_WQKV3 / 2, 0, C.lane)) continue;
            cvt_mat(r, inp(C, I_DIFF_WO), 1024, 1024, wsm + OFF_WO3 / 2, 0, C.lane);
        }
        for (int i = C.vcu * 512 + C.tid; i < 96 * 1024 / 8; i += C.G * 512) *(u32x4*)(wsm + OFF_WA / 2 + (size_t)672 * 1024 + (size_t)i * 8) = (u32x4){0u, 0u, 0u, 0u};
    }
}

DI void ld_row(const float* p, int lane, f32x4 (&v)[4]) {
#pragma unroll
    for (int j = 0; j < 4; ++j) v[j] = *(const f32x4*)(p + j * 256 + lane * 4);
}
DI void st_row(float* p, int lane, const f32x4 (&v)[4]) {
#pragma unroll
    for (int j = 0; j < 4; ++j) *(f32x4*)(p + j * 256 + lane * 4) = v[j];
}
DI void st_row_bf(bf16_t* p, int lane, const f32x4 (&v)[4]) {
#pragma unroll
    for (int j = 0; j < 4; ++j) { u32x2 w; w.x = pk2(v[j][0], v[j][1]); w.y = pk2(v[j][2], v[j][3]); *(u32x2*)(p + j * 256 + lane * 4) = w; }
}
DI void layernorm_row(f32x4 (&v)[4], const float* g, const float* b, int lane) {
    float s = 0.f;
#pragma unroll
    for (int j = 0; j < 4; ++j) s += (v[j][0] + v[j][1]) + (v[j][2] + v[j][3]);
    const float mean = wave_sum(s, lane) * (1.0f / DM); float q = 0.f;
#pragma unroll
    for (int j = 0; j < 4; ++j) { v[j] = v[j] - mean; q += (v[j][0] * v[j][0] + v[j][1] * v[j][1]) + (v[j][2] * v[j][2] + v[j][3] * v[j][3]); }
    const float rstd = 1.0f / sqrtf(wave_sum(q, lane) * (1.0f / DM) + LN_EPS);
    f32x4 gg[4], bb[4]; ld_row(g, lane, gg); ld_row(b, lane, bb);
#pragma unroll
    for (int j = 0; j < 4; ++j) v[j] = (v[j] * rstd) * gg[j] + bb[j];
}
DI void modulate_row(const f32x4 (&x)[4], const float* sh, const float* sc, int lane, f32x4 (&h)[4]) {
    f32x4 a[4], b[4]; ld_row(sc, lane, a); ld_row(sh, lane, b);
#pragma unroll
    for (int j = 0; j < 4; ++j) h[j] = x[j] * (1.0f + a[j]) + b[j];
}

DI void phase_modh0(int wave_s, unsigned char* ws_) {
    const Ctx C = make_ctx(ws_, wave_s);
    float* X = (float*)(C.ws + WS_X); bf16_t* H = (bf16_t*)(C.ws + WS_H);
    for (int row = C.vcu * 8 + C.wave; row < NT; row += C.G * 8) {
        const float* src = row < NCTX ? inp(C, I_CTX) + (size_t)row * DM : inp(C, I_X) + (size_t)(row - NCTX) * DM;
        f32x4 v[4], h[4]; ld_row(src, C.lane, v); st_row(X + (size_t)row * DM, C.lane, v);
        const int m = modidx(row); modulate_row(v, modp(C, 0, m, 0), modp(C, 0, m, 1), C.lane, h);
        st_row_bf(H + (size_t)row * DM, C.lane, h);
    }
}

template <int NF> DI void rope_heads(bf16_t* p, int nheads, int stride, const float* rt, int rtbase, int pos, int lane) {
    constexpr int CPH = 2 * (NF / 8);
    const float* ct = rt + rtbase + (size_t)pos * 2 * NF; const float* st = ct + 2048 * 2 * NF;
    for (int c = lane; c < nheads * CPH; c += 64) {
        const int hh = c / CPH, rem = c - hh * CPH, half = rem / (NF / 8), sub = rem - half * (NF / 8);
        bf16_t* x1p = p + hh * stride + half * 2 * NF + sub * 8; bf16_t* x2p = x1p + NF;
        const u32x4 a = *(const u32x4*)x1p, b = *(const u32x4*)x2p;
        const f32x4 c0 = *(const f32x4*)(ct + half * NF + sub * 8), c1 = *(const f32x4*)(ct + half * NF + sub * 8 + 4);
        const f32x4 s0 = *(const f32x4*)(st + half * NF + sub * 8), s1 = *(const f32x4*)(st + half * NF + sub * 8 + 4);
        float x1[8] = {bf_lo(a.x), bf_hi(a.x), bf_lo(a.y), bf_hi(a.y), bf_lo(a.z), bf_hi(a.z), bf_lo(a.w), bf_hi(a.w)};
        float x2[8] = {bf_lo(b.x), bf_hi(b.x), bf_lo(b.y), bf_hi(b.y), bf_lo(b.z), bf_hi(b.z), bf_lo(b.w), bf_hi(b.w)};
        float cc[8] = {c0[0], c0[1], c0[2], c0[3], c1[0], c1[1], c1[2], c1[3]}, ss[8] = {s0[0], s0[1], s0[2], s0[3], s1[0], s1[1], s1[2], s1[3]};
        float y1[8], y2[8];
#pragma unroll
        for (int i = 0; i < 8; ++i) { y1[i] = x1[i] * cc[i] - x2[i] * ss[i]; y2[i] = x1[i] * ss[i] + x2[i] * cc[i]; }
        u32x4 o1, o2; o1.x = pk2(y1[0], y1[1]); o1.y = pk2(y1[2], y1[3]); o1.z = pk2(y1[4], y1[5]); o1.w = pk2(y1[6], y1[7]);
        o2.x = pk2(y2[0], y2[1]); o2.y = pk2(y2[2], y2[3]); o2.z = pk2(y2[4], y2[5]); o2.w = pk2(y2[6], y2[7]);
        *(u32x4*)x1p = o1; *(u32x4*)x2p = o2;
    }
}
DI void vt_items(const Ctx& C, const bf16_t* src, int pitch, int col0, int hstride, int HV, int DV, bf16_t* Vt) {
    const int dvb_n = DV >> 6, items = NB * HV * dvb_n * 36;
    for (int it = C.vcu * 8 + C.wave; it < items; it += C.G * 8) {
        const int kbk = it % 36; int r = it / 36; const int dvb = r % dvb_n; r /= dvb_n; const int hv = r % HV, b = r / HV;
        const int key0 = kbk * 64;
        const int row0 = key0 < CTXL ? b * CTXL + key0 : NCTX + b * SEQ + (key0 - CTXL);
        const bf16_t* sp = src + (size_t)row0 * pitch + col0 + hv * hstride + dvb * 64 + C.lane;
        bf16_t v[64];
#pragma unroll
        for (int i = 0; i < 64; ++i) v[i] = sp[(size_t)i * pitch];
        bf16_t* dp = Vt + ((size_t)(b * HV + hv) * DV + dvb * 64 + C.lane) * NKEY + key0;
#pragma unroll
        for (int j = 0; j < 8; ++j) { u32x4 w; w.x = v[8 * j] | ((unsigned)v[8 * j + 1] << 16); w.y = v[8 * j + 2] | ((unsigned)v[8 * j + 3] << 16);
            w.z = v[8 * j + 4] | ((unsigned)v[8 * j + 5] << 16); w.w = v[8 * j + 6] | ((unsigned)v[8 * j + 7] << 16); *(u32x4*)(dp + 8 * j) = w; }
    }
}
DI int latent_pos(int row) { return (row - NCTX) & (SEQ - 1); }

DI void phase_post(int wave_s, unsigned char* ws, int l) {
    const Ctx C = make_ctx(ws, wave_s); const float* rt = (const float*)(ws + WS_ROPE);
    bf16_t* RAW = (bf16_t*)(ws + WS_RAW); bf16_t* Vt = (bf16_t*)(ws + WS_VT);
    const int gw = C.vcu * 8 + C.wave, NGW = C.G * 8;
    if (l == 0) {
        for (int row = NCTX + gw; row < NT; row += NGW) rope_heads<16>(RAW + (size_t)row * 1536, 20, 64, rt, RT16, latent_pos(row), C.lane);
        vt_items(C, RAW, 1536, 1280, 64, 4, 64, Vt);
    } else if (l == 1) {
        const float* qn = inp(C, I_AXG_QN); const float* kn = inp(C, I_AXG_KN);
        const int half = C.lane >> 5, i = C.lane & 31, d1 = half * 64 + i, d2 = d1 + 32;
        for (int row = gw; row < NT; row += NGW) {
            bf16_t* p = RAW + (size_t)row * 1536; const bool lat = row >= NCTX;
            float cs = 1.f, sn = 0.f;
            if (lat) { const int pos = latent_pos(row); cs = rt[RT32 + (pos * 2 + half) * 32 + i]; sn = rt[RT32 + 2048 * 2 * 32 + (pos * 2 + half) * 32 + i]; }
            for (int hh = 0; hh < 10; ++hh) {
                const float* g = hh < 8 ? qn : kn;
                float x1 = bf2f(p[hh * 128 + d1]), x2 = bf2f(p[hh * 128 + d2]);
                const float ss = wave_sum(x1 * x1 + x2 * x2, C.lane); const float r = 1.0f / sqrtf(ss * (1.0f / 128.0f) + NORM_EPS);
                x1 = x1 * r * g[d1]; x2 = x2 * r * g[d2];
                p[hh * 128 + d1] = f2bf(x1 * cs - x2 * sn); p[hh * 128 + d2] = f2bf(x1 * sn + x2 * cs);
            }
        }
        vt_items(C, RAW, 1536, 1280, 128, 2, 128, Vt);
    } else if (l == 2) {
        bf16_t* CQ = (bf16_t*)(ws + WS_CQ); bf16_t* CKV = (bf16_t*)(ws + WS_CKV); bf16_t* KPE = (bf16_t*)(ws + WS_KPE);
        const float* qn = inp(C, I_MLA_QN); const float* kvn = inp(C, I_MLA_KVN);
        for (int row = gw; row < NT; row += NGW) {
            const bf16_t* p = RAW + (size_t)row * 768;
            float q[6], ssq = 0.f;
#pragma unroll
            for (int j = 0; j < 6; ++j) { q[j] = bf2f(p[j * 64 + C.lane]); ssq += q[j] * q[j]; }
            const float rq = 1.0f / sqrtf(wave_sum(ssq, C.lane) * (1.0f / 384.0f) + NORM_EPS);
#pragma unroll
            for (int j = 0; j < 6; ++j) CQ[(size_t)row * 384 + j * 64 + C.lane] = f2bf(q[j] * rq * qn[j * 64 + C.lane]);
            float kv[4], ssk = 0.f;
#pragma unroll
            for (int j = 0; j < 4; ++j) { kv[j] = bf2f(p[384 + j * 64 + C.lane]); ssk += kv[j] * kv[j]; }
            const float rk = 1.0f / sqrtf(wave_sum(ssk, C.lane) * (1.0f / 256.0f) + NORM_EPS);
#pragma unroll
            for (int j = 0; j < 4; ++j) CKV[(size_t)row * 256 + j * 64 + C.lane] = f2bf(kv[j] * rk * kvn[j * 64 + C.lane]);
            if (C.lane < 16) {
                const int half = C.lane >> 3, f = C.lane & 7; float x1 = bf2f(p[640 + half * 16 + f]), x2 = bf2f(p[640 + half * 16 + 8 + f]);
                float cs = 1.f, sn = 0.f;
                if (row >= NCTX) { const int pos = latent_pos(row); cs = rt[RT8 + (pos * 2 + half) * 8 + f]; sn = rt[RT8 + 2048 * 2 * 8 + (pos * 2 + half) * 8 + f]; }
                KPE[(size_t)row * 32 + half * 16 + f] = f2bf(x1 * cs - x2 * sn); KPE[(size_t)row * 32 + half * 16 + 8 + f] = f2bf(x1 * sn + x2 * cs);
            }
        }
    } else {
        for (int row = NCTX + gw; row < NT; row += NGW) rope_heads<16>(RAW + (size_t)row * 3072, 32, 64, rt, RT16, latent_pos(row), C.lane);
        vt_items(C, RAW, 3072, 2048, 128, 8, 128, Vt);
    }
}
DI void phase_postb(int wave_s, unsigned char* ws) {
    const Ctx C = make_ctx(ws, wave_s); const float* rt = (const float*)(ws + WS_ROPE);
    bf16_t* Q2 = (bf16_t*)(ws + WS_Q2); const bf16_t* KV2 = (const bf16_t*)(ws + WS_KV2); const bf16_t* KPE = (const bf16_t*)(ws + WS_KPE); bf16_t* KF = (bf16_t*)(ws + WS_KF);
    const int gw = C.vcu * 8 + C.wave, NGW = C.G * 8;
    for (int row = gw; row < NT; row += NGW) {
        if (row >= NCTX) rope_heads<8>(Q2 + (size_t)row * 1536 + 64, 16, 96, rt, RT8, latent_pos(row), C.lane);
        for (int c = C.lane; c < 192; c += 64) { const int h = c / 12, j = c - h * 12;
            const u32x4 v = j < 8 ? *(const u32x4*)(KV2 + (size_t)row * 2048 + h * 128 + j * 8) : *(const u32x4*)(KPE + (size_t)row * 32 + (j - 8) * 8);
            *(u32x4*)(KF + (size_t)row * 1536 + h * 96 + j * 8) = v; }
    }
    vt_items(C, KV2, 2048, 64, 128, 16, 64, (bf16_t*)(ws + WS_VT));
}

struct AttnP { const bf16_t* Q; int qp; const bf16_t* K; int kp; const bf16_t* Vt; bf16_t* O; int G; int HV; float cscale; const float* sink; float lam; float osc; const float* subln; };
DI int crow(int reg, int h) { return (reg & 3) + 8 * (reg >> 2) + 4 * h; }

template <int DQK, int DV, bool DIFF, bool WIN>
DI void attn_unit(const Ctx& C, const AttnP& P, int b, int hsel, int qt, bool ctxq) {
    constexpr int KH = DIFF ? 2 : 1, KS = DQK * 2 + 16, VS = 136, KBYTES = KH * 64 * KS, BUFB = KBYTES + DV * VS;
    constexpr int KCH = DQK / 8, NKC = KH * 64 * KCH, NKL = (NKC + 511) / 512, NVC = DV * 8, NVL = NVC / 512;
    constexpr int QROWS = DIFF ? 128 : 256, NKS = DQK / 16, NDV = DV / 32;
    static_assert(2 * BUFB <= RING_BYTES, "attention LDS");
    const int tid = C.tid, lane = C.lane, wave = C.wave, r = lane & 31, h = lane >> 5;
    const int wg = DIFF ? (wave >> 2) : 0, wrow = (DIFF ? (wave & 3) : wave) * 32;
    const int hq = DIFF ? 2 * hsel + wg : hsel, hk0 = DIFF ? 2 * hsel : hsel / P.G, hv = DIFF ? hsel : hsel / P.G;
    const int qrow0 = ctxq ? b * CTXL : NCTX + b * SEQ + qt * QROWS;
    int t_lo = 0, t_hi = 0;
    if (!ctxq) { if (WIN) { t_lo = 4 * qt - 2; if (t_lo < 0) t_lo = 0; t_hi = 4 * qt + 6; if (t_hi > 32) t_hi = 32; } else { t_lo = 0; t_hi = 32; } }
    const int ntile = 4 + (t_hi - t_lo);
    LAS unsigned char* lds = C.lds;
    bf16x8 qf[NKS];
    { const bf16_t* qptr = P.Q + (size_t)(qrow0 + wrow + r) * P.qp + hq * DQK + 8 * h;
#pragma unroll
      for (int ks = 0; ks < NKS; ++ks) qf[ks] = *(const bf16x8*)(qptr + ks * 16); }
    u32x4 kreg[NKL], vreg[NVL];
    const bf16_t* vbase = P.Vt + (size_t)(b * P.HV + hv) * DV * NKEY;
#define ATT_LOAD(j) do { const int _j = (j); const int krow0 = _j < 4 ? b * CTXL + _j * 64 : NCTX + b * SEQ + (t_lo + _j - 4) * 64; const int vkey0 = _j < 4 ? _j * 64 : CTXL + (t_lo + _j - 4) * 64; \
        _Pragma("unroll") for (int i = 0; i < NKL; ++i) { const int c = tid + i * 512; if (NKC % 512 == 0 || c < NKC) { const int kh = c / (64 * KCH), rem = c - kh * (64 * KCH), key = rem / KCH, dc = rem - key * KCH; \
            kreg[i] = *(const u32x4*)(P.K + (size_t)(krow0 + key) * P.kp + (hk0 + kh) * DQK + dc * 8); } } \
        _Pragma("unroll") for (int i = 0; i < NVL; ++i) { const int c = tid + i * 512; const int dv = c >> 3, kc = c & 7; vreg[i] = *(const u32x4*)(vbase + (size_t)dv * NKEY + vkey0 + kc * 8); } } while (0)
#define ATT_WRITE(buf) do { LAS unsigned char* _b = lds + (buf) * BUFB; \
        _Pragma("unroll") for (int i = 0; i < NKL; ++i) { const int c = tid + i * 512; if (NKC % 512 == 0 || c < NKC) { const int kh = c / (64 * KCH), rem = c - kh * (64 * KCH), key = rem / KCH, dc = rem - key * KCH; \
            *(LAS u32x4*)(_b + kh * 64 * KS + key * KS + dc * 16) = kreg[i]; } } \
        _Pragma("unroll") for (int i = 0; i < NVL; ++i) { const int c = tid + i * 512; const int dv = c >> 3, kc = c & 7; LAS unsigned char* d = _b + KBYTES + dv * VS + kc * 16; \
            *(LAS u32x2*)d = (u32x2){vreg[i].x, vreg[i].y}; *(LAS u32x2*)(d + 8) = (u32x2){vreg[i].z, vreg[i].w}; } } while (0)
    f32x16 o[NDV];
#pragma unroll
    for (int d = 0; d < NDV; ++d)
#pragma unroll
        for (int i = 0; i < 16; ++i) o[d][i] = 0.f;
    float m_run = -INFINITY, l_run = 0.f;
    const int qpos = qt * QROWS + wrow + r;
    __syncthreads();
    ATT_LOAD(0); ATT_WRITE(0);
    __syncthreads();
    for (int j = 0; j < ntile; ++j) {
        const int cur = j & 1;
        const LAS unsigned char* kb_ = lds + cur * BUFB + wg * 64 * KS + r * KS + 16 * h;
        const LAS unsigned char* vb_ = lds + cur * BUFB + KBYTES + r * VS + 8 * h;
        f32x16 s0, s1;
#pragma unroll
        for (int i = 0; i < 16; ++i) { s0[i] = 0.f; s1[i] = 0.f; }
#pragma unroll
        for (int ks = 0; ks < NKS; ++ks) {
            const bf16x8 a0 = *(const LAS bf16x8*)(kb_ + ks * 32), a1 = *(const LAS bf16x8*)(kb_ + 32 * KS + ks * 32);
            s0 = __builtin_amdgcn_mfma_f32_32x32x16_bf16(a0, qf[ks], s0, 0, 0, 0);
            s1 = __builtin_amdgcn_mfma_f32_32x32x16_bf16(a1, qf[ks], s1, 0, 0, 0);
        }
        float mx = -INFINITY;
#pragma unroll
        for (int i = 0; i < 16; ++i) { s0[i] *= P.cscale; s1[i] *= P.cscale; }
        if (WIN) { if (!ctxq && j >= 4) { const int kp0 = (t_lo + j - 4) * 64;
#pragma unroll
            for (int i = 0; i < 16; ++i) { const int k0 = kp0 + crow(i, h), d0 = qpos - k0, d1 = d0 - 32;
                if (d0 > 128 || d0 < -128) s0[i] = -INFINITY; if (d1 > 128 || d1 < -128) s1[i] = -INFINITY; } } }
#pragma unroll
        for (int i = 0; i < 16; ++i) mx = fmaxf(mx, fmaxf(s0[i], s1[i]));
        mx = fmaxf(mx, shx(mx, 32, lane));
        const float m_new = fmaxf(m_run, mx);
        const float alpha = __builtin_amdgcn_exp2f(m_run - m_new);
        float rs = 0.f;
#pragma unroll
        for (int i = 0; i < 16; ++i) { s0[i] = __builtin_amdgcn_exp2f(s0[i] - m_new); s1[i] = __builtin_amdgcn_exp2f(s1[i] - m_new); rs += s0[i] + s1[i]; }
        rs += shx(rs, 32, lane);
        l_run = l_run * alpha + rs; m_run = m_new;
        if (!__all(alpha == 1.0f)) {
#pragma unroll
            for (int d = 0; d < NDV; ++d)
#pragma unroll
                for (int i = 0; i < 16; ++i) o[d][i] *= alpha;
        }
        if (j + 1 < ntile) ATT_LOAD(j + 1);
        bf16x8 pf[2][2];
#pragma unroll
        for (int s = 0; s < 2; ++s) {
            u32x4 w0, w1;
            w0.x = pk2(s0[8 * s + 0], s0[8 * s + 1]); w0.y = pk2(s0[8 * s + 2], s0[8 * s + 3]); w0.z = pk2(s0[8 * s + 4], s0[8 * s + 5]); w0.w = pk2(s0[8 * s + 6], s0[8 * s + 7]);
            w1.x = pk2(s1[8 * s + 0], s1[8 * s + 1]); w1.y = pk2(s1[8 * s + 2], s1[8 * s + 3]); w1.z = pk2(s1[8 * s + 4], s1[8 * s + 5]); w1.w = pk2(s1[8 * s + 6], s1[8 * s + 7]);
            pf[0][s] = __builtin_bit_cast(bf16x8, w0); pf[1][s] = __builtin_bit_cast(bf16x8, w1);
        }
#pragma unroll
        for (int d = 0; d < NDV; ++d)
#pragma unroll
            for (int kb = 0; kb < 2; ++kb)
#pragma unroll
                for (int s = 0; s < 2; ++s) {
                    const LAS unsigned char* vp = vb_ + d * 32 * VS + kb * 64 + s * 32;
                    const u32x2 lo = *(const LAS u32x2*)vp, hi = *(const LAS u32x2*)(vp + 16);
                    const u32x4 vv = {lo.x, lo.y, hi.x, hi.y};
                    o[d] = __builtin_amdgcn_mfma_f32_32x32x16_bf16(__builtin_bit_cast(bf16x8, vv), pf[kb][s], o[d], 0, 0, 0);
                }
        if (j + 1 < ntile) ATT_WRITE(cur ^ 1);
        __syncthreads();
    }
#undef ATT_LOAD
#undef ATT_WRITE
    float lfin = l_run, fsc = 1.0f;
    if (WIN) { const float sk = P.sink[hq] * LOG2E; const float m2 = fmaxf(m_run, sk); fsc = __builtin_amdgcn_exp2f(m_run - m2); lfin = l_run * fsc + __builtin_amdgcn_exp2f(sk - m2); }
    const float inv = fsc / lfin;
    bf16_t* orow = P.O + (size_t)(qrow0 + wrow + r) * DM;
    if (!DIFF) {
#pragma unroll
        for (int d = 0; d < NDV; ++d)
#pragma unroll
            for (int g = 0; g < 4; ++g) { u32x2 w; w.x = pk2(o[d][4 * g] * inv, o[d][4 * g + 1] * inv); w.y = pk2(o[d][4 * g + 2] * inv, o[d][4 * g + 3] * inv);
                *(u32x2*)(orow + hq * DV + d * 32 + 8 * g + 4 * h) = w; }
    } else {
        LAS float* o2 = (LAS float*)lds;
        if (wg == 1) {
#pragma unroll
            for (int d = 0; d < NDV; ++d)
#pragma unroll
                for (int g = 0; g < 4; ++g) *(LAS f32x4*)(o2 + (wrow + r) * 132 + d * 32 + 8 * g + 4 * h) = (f32x4){o[d][4 * g] * inv, o[d][4 * g + 1] * inv, o[d][4 * g + 2] * inv, o[d][4 * g + 3] * inv};
        }
        __syncthreads();
        if (wg == 0) {
            float ssq = 0.f;
#pragma unroll
            for (int d = 0; d < NDV; ++d)
#pragma unroll
                for (int g = 0; g < 4; ++g) { const f32x4 t = *(const LAS f32x4*)(o2 + (wrow + r) * 132 + d * 32 + 8 * g + 4 * h);
#pragma unroll
                    for (int i = 0; i < 4; ++i) { const float v = o[d][4 * g + i] * inv - P.lam * t[i]; o[d][4 * g + i] = v; ssq += v * v; } }
            ssq += shx(ssq, 32, lane);
            const float rn = P.osc / sqrtf(ssq * (1.0f / DV) + NORM_EPS);
#pragma unroll
            for (int d = 0; d < NDV; ++d)
#pragma unroll
                for (int g = 0; g < 4; ++g) { const int dv = d * 32 + 8 * g + 4 * h; const f32x4 sg = *(const f32x4*)(P.subln + dv);
                    u32x2 w; w.x = pk2(o[d][4 * g] * rn * sg[0], o[d][4 * g + 1] * rn * sg[1]); w.y = pk2(o[d][4 * g + 2] * rn * sg[2], o[d][4 * g + 3] * rn * sg[3]);
                    *(u32x2*)(orow + hsel * DV + dv) = w; }
        }
    }
}


DI AttnP attn_base(unsigned char* ws) { AttnP P; P.Vt = (const bf16_t*)(ws + WS_VT); P.O = (bf16_t*)(ws + WS_O); P.sink = nullptr; P.lam = 0.f; P.osc = 1.f; P.subln = nullptr; return P; }
DI void ph_attn0(int wave_s, unsigned char* ws) {
    const Ctx C = make_ctx(ws, wave_s); const float* sink = inp(C, I_WIN_SINK); AttnP P = attn_base(ws); const bf16_t* RAW = (const bf16_t*)(ws + WS_RAW);
    P.Q = RAW; P.qp = 1536; P.K = RAW + 1024; P.kp = 1536; P.G = 4; P.HV = 4; P.cscale = 0.125f * LOG2E; P.sink = sink;
    for (int u = C.vcu; u < 1024 + 128; u += C.G) {
        if (u < 1024) { const int b = u >> 7, rem = u & 127; attn_unit<64, 64, false, true>(C, P, b, rem >> 3, rem & 7, false); }
        else { const int v = u - 1024; attn_unit<64, 64, false, true>(C, P, v >> 4, v & 15, 0, true); }
    }
}
DI void ph_attn1(int wave_s, unsigned char* ws) {
    const Ctx C = make_ctx(ws, wave_s); AttnP P = attn_base(ws); const bf16_t* RAW = (const bf16_t*)(ws + WS_RAW);
    P.Q = RAW; P.qp = 1536; P.K = RAW + 1024; P.kp = 1536; P.G = 4; P.HV = 2; P.cscale = 0.08838834764831845f * LOG2E;
    for (int u = C.vcu; u < 512 + 64; u += C.G) {
        if (u < 512) { const int b = u >> 6, rem = u & 63; attn_unit<128, 128, false, false>(C, P, b, rem >> 3, rem & 7, false); }
        else { const int v = u - 512; attn_unit<128, 128, false, false>(C, P, v >> 3, v & 7, 0, true); }
    }
}
DI void ph_attn2(int wave_s, unsigned char* ws) {
    const Ctx C = make_ctx(ws, wave_s); AttnP P = attn_base(ws);
    P.Q = (const bf16_t*)(ws + WS_Q2); P.qp = 1536; P.K = (const bf16_t*)(ws + WS_KF); P.kp = 1536; P.G = 1; P.HV = 16; P.cscale = 0.10206207261596577f * LOG2E;
    for (int u = C.vcu; u < 1024 + 128; u += C.G) {
        if (u < 1024) { const int b = u >> 7, rem = u & 127; attn_unit<96, 64, false, false>(C, P, b, rem >> 3, rem & 7, false); }
        else { const int v = u - 1024; attn_unit<96, 64, false, false>(C, P, v >> 4, v & 15, 0, true); }
    }
}
DI void ph_attn3(int wave_s, unsigned char* ws) {
    const Ctx C = make_ctx(ws, wave_s); const float* lp = inp(C, I_DIFF_LAM); const float* subln = inp(C, I_DIFF_SUBLN); AttnP P = attn_base(ws); const bf16_t* RAW = (const bf16_t*)(ws + WS_RAW);
    P.Q = RAW; P.qp = 3072; P.K = RAW + 1024; P.kp = 3072; P.G = 1; P.HV = 8; P.cscale = 0.125f * LOG2E; P.subln = subln;
    const float linit = 0.8f - 0.6f * expf(-0.3f * 3.0f);
    const float s1 = wave_sum(lp[C.lane] * lp[64 + C.lane], C.lane), s2 = wave_sum(lp[128 + C.lane] * lp[192 + C.lane], C.lane);
    P.lam = expf(s1) - expf(s2) + linit; P.osc = 1.0f - linit;
    for (int u = C.vcu; u < 1024; u += C.G) { const int b = u >> 7, rem = u & 127; attn_unit<64, 128, true, false>(C, P, b, rem >> 4, rem & 15, false); }
}

DI void moe_tables(const Ctx& C, int l) {
    const unsigned* cnt = (const unsigned*)(C.ws + WS_CTL) + CW_CNT + l * 32;
    __syncthreads();
    if (C.tid == 0) {
        unsigned t = 0, c = 0;
        for (int e = 0; e < NEXP; ++e) { const unsigned n = __hip_atomic_load(cnt + e, __ATOMIC_RELAXED, __HIP_MEMORY_SCOPE_AGENT); C.misc[MW_TP + e] = t; C.misc[MW_CP + e] = c; const unsigned nt = (n + 255u) >> 8;
            for (unsigned i = 0; i < nt; ++i) C.misc[MW_TEXP + t + i] = (unsigned)e; t += nt; c += n; }
        C.misc[MW_TP + 32] = t; C.misc[MW_CP + 32] = c;
    }
    __syncthreads();
}

DI void phase_ln1(int wave_s, unsigned char* ws, int l) {
    const Ctx C = make_ctx(ws, wave_s); float* X = (float*)(ws + WS_X); const float* Y = (const float*)(ws + WS_Y); bf16_t* H = (bf16_t*)(ws + WS_H);
    LAS float* hs = (LAS float*)C.lds;
    LAS float* part = hs + 8 * 1024;
    LAS float* logits = part + 16 * 8 * 32;
    LAS int* lsel = (LAS int*)(logits + 256);
    LAS int* lslot = lsel + 288;
    const int rbase = l == 3 ? NCTX : 0, nchunks = (NT - rbase) / 8; int nmine = 0;
    const float* rw = inp(C, I_RW) + (size_t)l * DM * NEXP; const float* rb = inp(C, I_RB) + l * NEXP;
    float* gate = (float*)(ws + WS_GATE);
    for (int cidx = C.vcu; cidx < nchunks && nmine < 9; cidx += C.G, ++nmine) {
        const int ch = nmine; const int row = rbase + cidx * 8 + C.wave; const int m = modidx(row);
        {
            f32x4 x[4], y[4], g1[4], h[4]; ld_row(X + (size_t)row * DM, C.lane, x); ld_row(Y + (size_t)row * DM, C.lane, y); ld_row(modp(C, l, m, 2), C.lane, g1);
#pragma unroll
            for (int j = 0; j < 4; ++j) x[j] = x[j] * DN_ALPHA + g1[j] * y[j];
            layernorm_row(x, inp(C, I_LN1G) + l * DM, inp(C, I_LN1B) + l * DM, C.lane);
            st_row(X + (size_t)row * DM, C.lane, x);
            modulate_row(x, modp(C, l, m, 3), modp(C, l, m, 4), C.lane, h);
            st_row_bf(H + (size_t)row * DM, C.lane, h);
#pragma unroll
            for (int j = 0; j < 4; ++j) *(LAS f32x4*)(hs + C.wave * 1024 + j * 256 + C.lane * 4) = h[j];
        }
        __syncthreads();
        {
            const int e = C.tid & 31, kq = C.tid >> 5; float acc[8];
#pragma unroll
            for (int r = 0; r < 8; ++r) acc[r] = 0.f;
            for (int dd = 0; dd < 64; dd += 4) { const int d = kq * 64 + dd;
                const float w0 = rw[(d + 0) * 32 + e], w1 = rw[(d + 1) * 32 + e], w2 = rw[(d + 2) * 32 + e], w3 = rw[(d + 3) * 32 + e];
#pragma unroll
                for (int r = 0; r < 8; ++r) { const f32x4 hv = *(const LAS f32x4*)(hs + r * 1024 + d); acc[r] += (hv[0] * w0 + hv[1] * w1) + (hv[2] * w2 + hv[3] * w3); } }
#pragma unroll
            for (int r = 0; r < 8; ++r) part[(kq * 8 + r) * 32 + e] = acc[r];
        }
        __syncthreads();
        if (C.tid < 256) { const int r = C.tid >> 5, e = C.tid & 31; float s = 0.f;
#pragma unroll
            for (int kq = 0; kq < 16; ++kq) s += part[(kq * 8 + r) * 32 + e];
            logits[r * 32 + e] = s + rb[e]; }
        __syncthreads();
        if (C.tid < 8) {
            const int r = C.tid; const int grow = rbase + cidx * 8 + r;
            float v0 = -INFINITY, v1 = -INFINITY, v2 = -INFINITY, v3 = -INFINITY; int i0 = 0, i1 = 0, i2 = 0, i3 = 0;
            for (int e = 0; e < 32; ++e) { const float x = logits[r * 32 + e];
                if (x > v3) { if (x > v2) { v3 = v2; i3 = i2; if (x > v1) { v2 = v1; i2 = i1; if (x > v0) { v1 = v0; i1 = i0; v0 = x; i0 = e; } else { v1 = x; i1 = e; } } else { v2 = x; i2 = e; } } else { v3 = x; i3 = e; } } }
            const float e1 = expf(v1 - v0), e2 = expf(v2 - v0), e3 = expf(v3 - v0), inv = 1.0f / (1.0f + e1 + e2 + e3);
            const int li = (ch * 8 + r) * 4;
            lsel[li] = i0; lsel[li + 1] = i1; lsel[li + 2] = i2; lsel[li + 3] = i3;
            lslot[li] = grow * 4; lslot[li + 1] = grow * 4 + 1; lslot[li + 2] = grow * 4 + 2; lslot[li + 3] = grow * 4 + 3;
            *(f32x4*)(gate + (size_t)grow * 4) = (f32x4){inv, e1 * inv, e2 * inv, e3 * inv};
        }
        __syncthreads();
    }
    if (C.tid < 32) {
        const int e = C.tid, nsel = nmine * 32; int n = 0;
        for (int i = 0; i < nsel; ++i) n += (lsel[i] == e) ? 1 : 0;
        if (n) {
            unsigned* cnt = (unsigned*)(ws + WS_CTL) + CW_CNT + l * 32 + e;
            const unsigned base = __hip_atomic_fetch_add(cnt, (unsigned)n, __ATOMIC_RELAXED, __HIP_MEMORY_SCOPE_AGENT);
            int* list = (int*)(ws + WS_LIST) + (size_t)e * CAP + base; int j = 0;
            for (int i = 0; i < nsel; ++i) if (lsel[i] == e) { list[j] = lslot[i]; ++j; }
        }
    }
    __syncthreads();
}

DI void phase_perm(int wave_s, unsigned char* ws, int l) {
    const Ctx C = make_ctx(ws, wave_s); moe_tables(C, l);
    const int total = (int)C.misc[MW_CP + 32];
    const int* list = (const int*)(ws + WS_LIST); const bf16_t* H = (const bf16_t*)(ws + WS_H); bf16_t* HS = (bf16_t*)(ws + WS_HS);
    int* pos = (int*)(ws + WS_POS); float* gs = (float*)(ws + WS_GS); const float* gate = (const float*)(ws + WS_GATE);
    for (int g = C.vcu * 8 + C.wave; g < total; g += C.G * 8) {
        int e = 0;
        for (int k = 1; k < NEXP; ++k) e += ((int)C.misc[MW_CP + k] <= g) ? 1 : 0;
        const int p = g - (int)C.misc[MW_CP + e]; const int srow = (int)C.misc[MW_TP + e] * 256 + p;
        const int slot = list[(size_t)e * CAP + p]; const int tok = slot >> 2;
        const u32x4* sp = (const u32x4*)(H + (size_t)tok * DM); u32x4* dp = (u32x4*)(HS + (size_t)srow * DM);
        const u32x4 v0 = sp[C.lane], v1 = sp[64 + C.lane]; dp[C.lane] = v0; dp[64 + C.lane] = v1;
        if (C.lane == 0) { pos[slot] = srow; gs[srow] = gate[slot]; }
    }
}

DI void phase_ln2(int wave_s, unsigned char* ws, int l) {
    const Ctx C = make_ctx(ws, wave_s); float* X = (float*)(ws + WS_X); bf16_t* H = (bf16_t*)(ws + WS_H); const bf16_t* YS = (const bf16_t*)(ws + WS_YS); const int* pos = (const int*)(ws + WS_POS);
    const int r0 = l == 3 ? NCTX : 0;
    for (int row = r0 + C.vcu * 8 + C.wave; row < NT; row += C.G * 8) {
        const int m = modidx(row);
        f32x4 x[4], g2[4], ys[4]; ld_row(X + (size_t)row * DM, C.lane, x); ld_row(modp(C, l, m, 5), C.lane, g2);
#pragma unroll
        for (int j = 0; j < 4; ++j) ys[j] = (f32x4){0.f, 0.f, 0.f, 0.f};
        const u32x4 pp = *(const u32x4*)(pos + (size_t)row * 4);
        const unsigned pr[4] = {pp.x, pp.y, pp.z, pp.w};
#pragma unroll
        for (int k = 0; k < 4; ++k) { const bf16_t* yp = YS + (size_t)pr[k] * DM;
#pragma unroll
            for (int j = 0; j < 4; ++j) { const u32x2 w = *(const u32x2*)(yp + j * 256 + C.lane * 4); ys[j] += (f32x4){bf_lo(w.x), bf_hi(w.x), bf_lo(w.y), bf_hi(w.y)}; } }
#pragma unroll
        for (int j = 0; j < 4; ++j) x[j] = x[j] * DN_ALPHA + g2[j] * ys[j];
        layernorm_row(x, inp(C, I_LN2G) + l * DM, inp(C, I_LN2B) + l * DM, C.lane);
        if (l == 3) { st_row((float*)inp(C, 36) + (size_t)(row - NCTX) * DM, C.lane, x); }
        else { st_row(X + (size_t)row * DM, C.lane, x); f32x4 h[4]; modulate_row(x, modp(C, l + 1, m, 0), modp(C, l + 1, m, 1), C.lane, h); st_row_bf(H + (size_t)row * DM, C.lane, h); }
    }
}

DI void ph_gemm_bf16(int wave_s, unsigned char* ws, const bf16_t* A, const bf16_t* Bt, int M, int N, int K, bf16_t* out, int ldc, int bias_idx) {
    const Ctx C = make_ctx(ws, wave_s); const float* bias = bias_idx >= 0 ? inp(C, bias_idx) : nullptr;
    pg8::DenseOrder S; S.A = (const char*)A; S.B = (const char*)Bt; S.nN = N / 256; S.nunits = (M / 256) * S.nN; S.G = C.G; S.c = C.vcu; S.r0 = 0; S.step = (size_t)256 * K * 2;
    pg8::EpiBf16 E{out, ldc, bias};
    pg8::gemm_phase<pg8::EpiBf16, pg8::DenseOrder>(C.lds, C.tid, K, S, E);
}
DI void ph_gemm_wo(int wave_s, unsigned char* ws, const bf16_t* W, int r0, int bias_idx) {
    const Ctx C = make_ctx(ws, wave_s); const float* bias = bias_idx >= 0 ? inp(C, bias_idx) : nullptr;
    pg8::DenseOrder S; S.A = (const char*)((const bf16_t*)(ws + WS_O) + (size_t)r0 * DM); S.B = (const char*)W; S.nN = 4; S.nunits = ((NT - r0) / 256) * 4; S.G = C.G; S.c = C.vcu; S.r0 = r0; S.step = (size_t)256 * 1024 * 2;
    pg8::EpiF32 E{(float*)(ws + WS_Y), DM, bias};
    pg8::gemm_phase<pg8::EpiF32, pg8::DenseOrder>(C.lds, C.tid, 1024, S, E);
}
DI void ph_moe1(int wave_s, unsigned char* ws, int l) {
    const Ctx C = make_ctx(ws, wave_s); const float* b_in = inp(C, I_BIN);
    moe_tables(C, l);
    pg8::MoeOrder<3, 2048> S; S.A = (const char*)(ws + WS_HS); S.B = (const char*)(ws + WS_WIN) + (size_t)l * 32 * 2048 * 1024 * 2; S.misc = C.misc; S.G = C.G; S.c = C.vcu;
    pg8::EpiSwiglu E{(bf16_t*)(ws + WS_ACT), b_in + (size_t)l * 32 * 2048};
    pg8::gemm_phase<pg8::EpiSwiglu, pg8::MoeOrder<3, 2048>>(C.lds, C.tid, 1024, S, E);
}
DI void ph_moe2(int wave_s, unsigned char* ws, int l) {
    const Ctx C = make_ctx(ws, wave_s); const float* b_out = inp(C, I_BOUT);
    moe_tables(C, l);
    pg8::MoeOrder<2, 1024> S; S.A = (const char*)(ws + WS_ACT); S.B = (const char*)(ws + WS_WOUT) + (size_t)l * 32 * 1024 * 1024 * 2; S.misc = C.misc; S.G = C.G; S.c = C.vcu;
    pg8::EpiMoe2 E{(bf16_t*)(ws + WS_YS), b_out + (size_t)l * 32 * 1024, (const float*)(ws + WS_GS)};
    pg8::gemm_phase<pg8::EpiMoe2, pg8::MoeOrder<2, 1024>>(C.lds, C.tid, 1024, S, E);
}

constexpr int NPHASE = 2 + 11 * DEPTH;

__global__ void __launch_bounds__(512, 2) dit_fwd(Args args) {
    {
        LAS unsigned* mz = (LAS unsigned*)((LAS unsigned char*)lds_raw + MISC_OFF);
        for (int u = threadIdx.x; u < (LDS_BYTES - MISC_OFF) / 4; u += 512) mz[u] = 0u;
        __syncthreads();
        if (threadIdx.x == 0) {
#pragma unroll
            for (int i = 0; i < 36; ++i) { const unsigned long long p = (unsigned long long)args.in[i]; mz[MW_PTR + 2 * i] = (unsigned)p; mz[MW_PTR + 2 * i + 1] = (unsigned)(p >> 32); }
            const unsigned long long p = (unsigned long long)args.out; mz[MW_PTR + 72] = (unsigned)p; mz[MW_PTR + 73] = (unsigned)(p >> 32);
        }
        __syncthreads();
    }
    const int wave_s = __builtin_amdgcn_readfirstlane((int)threadIdx.x >> 6);
    const int lo = args.ph_lo, hi = args.ph_hi;
    unsigned char* ws = args.ws;
    XcdBarrier bar; bar.bar = (unsigned*)(ws + WS_CTL) + CW_BAR; bar.x = 0; bar.st = nullptr;
    if (hi - lo > 1) bar = xcd_barrier_post((unsigned*)(ws + WS_CTL) + CW_BAR, (volatile LAS unsigned*)((LAS unsigned char*)lds_raw + MISC_OFF) + 8);
#define IN(k) (lo <= (k) && (k) < hi)
#define SEAM(k) do { if ((k) + 1 < hi) xcd_barrier(bar); } while (0)
    bf16_t* wsm = (bf16_t*)(ws + WS_WSMALL);
    if (IN(0)) { phase_prologue(wave_s, ws); SEAM(0); }
    if (IN(1)) { phase_modh0(wave_s, ws); SEAM(1); }
    for (int l = 0; l < DEPTH; ++l) {
        const int pb = 2 + 11 * l;
        if (IN(pb + 0)) {
            const bf16_t* W = wsm + (l == 0 ? OFF_WQKV0 : l == 1 ? OFF_WQKV1 : l == 2 ? OFF_WA : OFF_WQKV3) / 2;
            const int N = l == 2 ? 768 : (l == 3 ? 3072 : 1536);
            ph_gemm_bf16(wave_s, ws, (const bf16_t*)(ws + WS_H), W, NT, N, 1024, (bf16_t*)(ws + WS_RAW), N, l == 0 ? (int)I_WIN_BQKV : -1);
            SEAM(pb + 0);
        }
        if (IN(pb + 1)) { phase_post(wave_s, ws, l); SEAM(pb + 1); }
        if (l == 2) {
            if (IN(pb + 2)) {
                for (int j = 0; j < 2; ++j)
                    ph_gemm_bf16(wave_s, ws, (const bf16_t*)(ws + (j == 0 ? WS_CQ : WS_CKV)), wsm + (j == 0 ? OFF_WQB : OFF_WKVB) / 2, NT, j == 0 ? 1536 : 2048, j == 0 ? 384 : 256,
                                 (bf16_t*)(ws + (j == 0 ? WS_Q2 : WS_KV2)), j == 0 ? 1536 : 2048, -1);
                SEAM(pb + 2);
            }
            if (IN(pb + 3)) { phase_postb(wave_s, ws); SEAM(pb + 3); }
        }
        if (IN(pb + 4)) {
            if (l == 0) ph_attn0(wave_s, ws); else if (l == 1) ph_attn1(wave_s, ws); else if (l == 2) ph_attn2(wave_s, ws); else ph_attn3(wave_s, ws);
            SEAM(pb + 4);
        }
        if (IN(pb + 5)) {
            const bf16_t* W = wsm + (l == 0 ? OFF_WO0 : l == 1 ? OFF_WO1 : l == 2 ? OFF_WO2 : OFF_WO3) / 2;
            ph_gemm_wo(wave_s, ws, W, l == 3 ? NCTX : 0, l == 0 ? (int)I_WIN_BO : -1);
            SEAM(pb + 5);
        }
        if (IN(pb + 6)) { phase_ln1(wave_s, ws, l); SEAM(pb + 6); }
        if (IN(pb + 7)) { phase_perm(wave_s, ws, l); SEAM(pb + 7); }
        if (IN(pb + 8)) { ph_moe1(wave_s, ws, l); SEAM(pb + 8); }
        if (IN(pb + 9)) { ph_moe2(wave_s, ws, l); SEAM(pb + 9); }
        if (IN(pb + 10)) { phase_ln2(wave_s, ws, l); SEAM(pb + 10); }
    }
#undef IN
#undef SEAM
}

extern "C" void kernel_launch(void* const* d_in, const int* in_sizes, int n_in, void* d_out, int out_size, void* d_ws, size_t ws_size, hipStream_t stream) {
    static int grid = 0;
    if (grid == 0) {
        if (n_in != 36 || out_size != NB * SEQ * DM || ws_size < WS_END) { fprintf(stderr, "kernel_launch: unexpected shapes (n_in %d out %d ws %zu need %zu)\n", n_in, out_size, ws_size, (size_t)WS_END); grid = -1; return; }
        int dev = 0, cus = 0, per_cu = 0;
        if (hipGetDevice(&dev) != hipSuccess || hipDeviceGetAttribute(&cus, hipDeviceAttributeMultiprocessorCount, dev) != hipSuccess) { grid = -1; return; }
        if (hipFuncSetAttribute((const void*)dit_fwd, hipFuncAttributeMaxDynamicSharedMemorySize, LDS_BYTES) != hipSuccess) { fprintf(stderr, "kernel_launch: hipFuncSetAttribute failed\n"); grid = -1; return; }
        if (hipOccupancyMaxActiveBlocksPerMultiprocessor(&per_cu, (const void*)dit_fwd, 512, LDS_BYTES) != hipSuccess || per_cu < 1) fprintf(stderr, "kernel_launch: occupancy query says %d\n", per_cu);
        (void)hipGetLastError();
        grid = cus;
    }
    if (grid < 0) return;
    (void)hipMemsetAsync((char*)d_ws + WS_CTL, 0, CTL_BYTES, stream);
    Args a{};
    for (int i = 0; i < 36; ++i) a.in[i] = (const float*)d_in[i];
    a.out = (float*)d_out; a.ws = (unsigned char*)d_ws;
#if MK_PER_PHASE
    for (int ph = 0; ph < NPHASE; ++ph) {
        const int l = ph < 2 ? 0 : (ph - 2) / 11, s = ph < 2 ? 0 : (ph - 2) % 11;
        if (ph >= 2 && (s == 2 || s == 3) && l != 2) continue;
        a.ph_lo = ph; a.ph_hi = ph + 1;
        hipLaunchKernelGGL(dit_fwd, dim3(grid), dim3(512), LDS_BYTES, stream, a);
    }
#else
    a.ph_lo = 0; a.ph_hi = NPHASE;
    hipLaunchKernelGGL(dit_fwd, dim3(grid), dim3(512), LDS_BYTES, stream, a);
#endif
    const hipError_t le = hipPeekAtLastError();
    if (le != hipSuccess) fprintf(stderr, "kernel_launch: launch failed: %s\n", hipGetErrorName(le));
}
```

```cpp
#include <hip/hip_runtime.h>
#include <cstdio>
#include <cstdint>

#ifndef MK_PER_PHASE
#define MK_PER_PHASE 0
#endif

#ifndef PROBE_DOUBLE
#define PROBE_DOUBLE 0
#endif
#define PREP(bit) for (int rep_ = 0; rep_ < 1 + ((PROBE_DOUBLE >> (bit)) & 1); ++rep_)
#define DI __device__ __forceinline__
#define GAS __attribute__((address_space(1)))
#define LAS __attribute__((address_space(3)))
typedef unsigned short bf16_t;
typedef short bf16x8 __attribute__((ext_vector_type(8)));
typedef float f32x2 __attribute__((ext_vector_type(2)));
typedef float f32x4 __attribute__((ext_vector_type(4)));
typedef float f32x16 __attribute__((ext_vector_type(16)));
typedef unsigned u32x2 __attribute__((ext_vector_type(2)));
typedef unsigned u32x4 __attribute__((ext_vector_type(4)));
typedef __bf16 bfv2 __attribute__((ext_vector_type(2)));

DI unsigned pk2(float lo, float hi) { f32x2 v = {lo, hi}; return __builtin_bit_cast(unsigned, __builtin_convertvector(v, bfv2)); }
DI float bf_lo(unsigned w) { return __uint_as_float(w << 16); }
DI float bf_hi(unsigned w) { return __uint_as_float(w & 0xffff0000u); }
DI float bf2f(bf16_t h) { return __uint_as_float((unsigned)h << 16); }
DI bf16_t f2bf(float f) { return (bf16_t)(pk2(f, 0.f) & 0xffffu); }
DI float shx(float v, int m, int lane) { return __int_as_float(__builtin_amdgcn_ds_bpermute((lane ^ m) << 2, __float_as_int(v))); }
DI float wave_sum(float v, int lane) {
#pragma unroll
    for (int o = 1; o < 64; o <<= 1) v += shx(v, o, lane);
    return v;
}

constexpr int NB = 8, SEQ = 2048, CTXL = 256, DM = 1024, DEPTH = 4;
constexpr int NCTX = NB * CTXL;
constexpr int NT = NCTX + NB * SEQ;
constexpr int NKEY = CTXL + SEQ;
constexpr int NEXP = 32, FF = 1024, CAP = NT;
constexpr int MAXT = 320;
constexpr float DN_ALPHA = 1.681792830507429f;
constexpr float LN_EPS = 1e-5f, NORM_EPS = 1e-6f;
constexpr float LOG2E = 1.4426950408889634f;

constexpr size_t MiB = 1u << 20;
constexpr size_t WS_CTL = 0, CTL_BYTES = 1 * MiB;
constexpr size_t WS_MOD = 1 * MiB;
constexpr size_t WS_ROPE = 2 * MiB;
constexpr size_t WS_WSMALL = 4 * MiB;
constexpr size_t OFF_WQKV0 = 0, OFF_WO0 = 3 * MiB, OFF_WQKV1 = 5 * MiB, OFF_WO1 = 8 * MiB, OFF_WA = 10 * MiB, OFF_WQB = 12 * MiB,
                 OFF_WKVB = 14 * MiB, OFF_WO2 = 15 * MiB, OFF_WQKV3 = 17 * MiB, OFF_WO3 = 23 * MiB;
constexpr size_t WS_WIN = 32 * MiB;
constexpr size_t WS_WOUT = WS_WIN + 512 * MiB;
constexpr size_t WS_X = WS_WOUT + 256 * MiB;
constexpr size_t WS_H = WS_X + 72 * MiB;
constexpr size_t WS_RAW = WS_H + 36 * MiB;
constexpr size_t WS_CQ = WS_RAW + 108 * MiB;
constexpr size_t WS_CKV = WS_CQ + 14 * MiB;
constexpr size_t WS_KPE = WS_CKV + 9 * MiB;
constexpr size_t WS_Q2 = WS_KPE + 2 * MiB;
constexpr size_t WS_KV2 = WS_Q2 + 54 * MiB;
constexpr size_t WS_KF = WS_KV2 + 72 * MiB;
constexpr size_t WS_VT = WS_KF + 54 * MiB;
constexpr size_t WS_O = WS_VT + 36 * MiB;
constexpr size_t WS_Y = WS_O + 36 * MiB;
constexpr size_t WS_LIST = WS_Y + 72 * MiB;
constexpr size_t WS_GATE = WS_LIST + 3 * MiB;
constexpr size_t WS_POS = WS_GATE + 1 * MiB;
constexpr size_t WS_GS = WS_POS + 1 * MiB;
constexpr size_t WS_HS = WS_GS + 1 * MiB;
constexpr size_t WS_ACT = WS_HS + 160 * MiB;
constexpr size_t WS_YS = WS_ACT + 160 * MiB;
constexpr size_t WS_HLO = WS_YS + 160 * MiB;
constexpr size_t WS_RWT = WS_HLO + 36 * MiB;
constexpr size_t WS_END = WS_RWT + 1 * MiB;
constexpr int CW_CNT = 64;
constexpr int CW_BAR = 4096;

constexpr int RT16 = 0, RT32 = RT16 + 2 * 2048 * 2 * 16, RT8 = RT32 + 2 * 2048 * 2 * 32, RT_END = RT8 + 2 * 2048 * 2 * 8;

constexpr int RING_BYTES = 131072;
constexpr int MISC_OFF = RING_BYTES;
constexpr int LDS_BYTES = 147456;
constexpr int MW_TP = 64, MW_CP = 128, MW_TEXP = 192, MW_PTR = 512, MW_CN = 600, MW_IDX = 1024;

namespace pg8 {
constexpr int BM = 256, BK = 64, HALF = 128, HTB = HALF * BK * 2, STAGE_BYTES = 8 * HTB;
__host__ __device__ __forceinline__ int lds_byte(int r, int c) { const int st = (r >> 4) * 2 + (c >> 5), rr = r & 15, cc = c & 31, ob = rr * 64 + cc * 2; return st * 1024 + (ob ^ (((ob >> 9) & 1) << 5)); }
__host__ __device__ __forceinline__ void stage_rc(int b, int& R, int& C) { const int st = b / 1024, sb = b % 1024, swz = sb ^ (((sb >> 9) & 1) << 5); R = (st >> 1) * 16 + swz / 64; C = (st & 1) * 32 + (swz % 64) / 2; }
__host__ __device__ __forceinline__ int perm32(int rho) { const int n = rho >> 4, i = rho & 15; return 8 * (i >> 2) + 4 * n + (i & 3); }

struct Unit { unsigned ao, bo; int r0, c0, aux; unsigned io; int nvalid; };
typedef __amdgpu_buffer_rsrc_t rsrc_t;
DI rsrc_t make_rsrc(const void* base) { return __builtin_amdgcn_make_buffer_rsrc((void*)base, 0, 0x7fffffff, 0x00020000); }

template <bool GATHER, class Epi, class Sched>
__device__ __forceinline__ void gemm_phase(LAS unsigned char* lds, LAS int* idxbuf, const int* list, const int tid, const int K, const rsrc_t rsA, const rsrc_t rsB, const Sched& S, const Epi& E) {
    const int wid = __builtin_amdgcn_readfirstlane(tid >> 6), lane = tid & 63, wr = wid >> 2, wc = wid & 3, fr = lane & 15, fq = lane >> 4;
    const int nt = K / BK;
    unsigned voffA[2], voffB[2], offc[2][2];
#pragma unroll
    for (int i = 0; i < 2; ++i) { int R, C; stage_rc(tid * 16 + i * 8192, R, C); const int Rb = Epi::PERM ? ((R & ~31) + perm32(R & 31)) : R;
        voffA[i] = (unsigned)(R * K + C) * 2u; voffB[i] = (unsigned)(Rb * K + C) * 2u; offc[0][i] = 0u; offc[1][i] = 0u; }
    const unsigned hstep = (unsigned)(HALF * K * 2);
    const unsigned ldsw = (unsigned)wid * 1024u;
    const int aoff = lds_byte(wr * 64 + fr, fq * 8), boff = lds_byte(wc * 32 + fr, fq * 8);
#define PG8_SA(b, h) (((b) * 2 + (h)) * HTB)
#define PG8_SB(b, h) ((4 + (b) * 2 + (h)) * HTB)
#define PG8_STAGE(rs, bufoff, soff, voff) do { _Pragma("unroll") for (int _i = 0; _i < 2; ++_i) \
        __builtin_amdgcn_raw_ptr_buffer_load_lds((rs), (LAS void*)(lds + (bufoff) + ldsw + _i * 8192), 16, (voff)[_i], (soff), 0, 0); } while (0)
#define PG8_STAGEA(b, h, ub, kt) do { if constexpr (GATHER) PG8_STAGE(rsA, PG8_SA(b, h), (unsigned)(kt) * 128u, offc[h]); else PG8_STAGE(rsA, PG8_SA(b, h), (ub) + (unsigned)(h) * hstep + (unsigned)(kt) * 128u, voffA); } while (0)
#define PG8_STAGEB(b, h, ub, kt) PG8_STAGE(rsB, PG8_SB(b, h), (ub) + (unsigned)(h) * hstep + (unsigned)(kt) * 128u, voffB)
#define PG8_LDA(dst, b, h) do { _Pragma("unroll") for (int m = 0; m < 4; ++m) _Pragma("unroll") for (int k = 0; k < 2; ++k) dst[m][k] = *(const LAS bf16x8*)(lds + PG8_SA(b, h) + aoff + m * 2048 + k * 1024); } while (0)
#define PG8_LDB(dst, b, h) do { _Pragma("unroll") for (int n = 0; n < 2; ++n) _Pragma("unroll") for (int k = 0; k < 2; ++k) dst[n][k] = *(const LAS bf16x8*)(lds + PG8_SB(b, h) + boff + n * 2048 + k * 1024); } while (0)
#define PG8_MMA(ai, bj, At, Bt) do { __builtin_amdgcn_s_setprio(1); _Pragma("unroll") for (int m = 0; m < 4; ++m) _Pragma("unroll") for (int n = 0; n < 2; ++n) _Pragma("unroll") for (int k = 0; k < 2; ++k) \
        acc[ai][bj][m][n] = __builtin_amdgcn_mfma_f32_16x16x32_bf16(Bt[n][k], At[m][k], acc[ai][bj][m][n], 0, 0, 0); __builtin_amdgcn_s_setprio(0); } while (0)
#define PG8_WAIT_V(n) asm volatile("s_waitcnt vmcnt(" #n ")" ::: "memory")
#define PG8_WAIT_L(n) asm volatile("s_waitcnt lgkmcnt(" #n ")" ::: "memory")
#define PG8_BAR __builtin_amdgcn_s_barrier()
#define PG8_SCHED __builtin_amdgcn_sched_barrier(0)
    Unit cur, nxt; int ui = 0;
    if (!S.next(0, cur)) return;
    if constexpr (GATHER) {
#pragma unroll
        for (int h = 0; h < 2; ++h)
#pragma unroll
            for (int i = 0; i < 2; ++i) { int R, C; stage_rc(tid * 16 + i * 8192, R, C); const int r = h * HALF + R; const int sl = r < cur.nvalid ? list[cur.io + r] : 0; offc[h][i] = (unsigned)(sl >> 2) * (unsigned)(K * 2) + (unsigned)C * 2u; }
    }
    f32x4 acc[2][2][4][2];
#pragma unroll
    for (int a = 0; a < 2; ++a)
#pragma unroll
        for (int b = 0; b < 2; ++b)
#pragma unroll
            for (int m = 0; m < 4; ++m)
#pragma unroll
                for (int n = 0; n < 2; ++n) acc[a][b][m][n] = (f32x4){0.f, 0.f, 0.f, 0.f};
    bf16x8 At[4][2], B0[2][2], B1[2][2];
    unsigned cA = cur.ao, cB = cur.bo;
    PG8_STAGEB(0, 0, cB, 0); PG8_STAGEB(0, 1, cB, 0); PG8_STAGEA(0, 0, cA, 0); PG8_STAGEA(0, 1, cA, 0);
    if (wr == 1) PG8_BAR;
    PG8_WAIT_V(2); PG8_BAR;
    PG8_STAGEB(1, 0, cB, 1); PG8_STAGEA(1, 0, cA, 1); PG8_STAGEB(1, 1, cB, 1);
    PG8_WAIT_V(6); PG8_BAR;
    for (;;) {
        const bool has_next = S.next(ui + 1, nxt);
        const unsigned nA = has_next ? nxt.ao : cA, nB = has_next ? nxt.bo : cB;
        if constexpr (GATHER) { if (has_next && wid == 0) __builtin_amdgcn_global_load_lds((const unsigned*)(list + nxt.io + lane * 4), (LAS unsigned*)idxbuf, 16, 0, 0); }
        for (int t = 0; t < nt; t += 2) {
            const bool last = (t == nt - 2);
            const unsigned a2 = last ? nA : cA, b2 = last ? nB : cB; const int kt2 = last ? 0 : t + 2;
            PG8_LDB(B0, 0, 0); PG8_LDB(B1, 0, 1); PG8_SCHED; PG8_LDA(At, 0, 0); PG8_STAGEA(1, 1, cA, t + 1);
            PG8_WAIT_V(8); PG8_WAIT_L(0); PG8_BAR; PG8_MMA(0, 0, At, B0); PG8_MMA(0, 1, At, B1); PG8_BAR; PG8_SCHED;
            if constexpr (GATHER) { if (last && has_next) {
#pragma unroll
                for (int h = 0; h < 2; ++h)
#pragma unroll
                    for (int i = 0; i < 2; ++i) { int R, C; stage_rc(tid * 16 + i * 8192, R, C); const int r = h * HALF + R; const int sl = r < nxt.nvalid ? idxbuf[r] : 0; offc[h][i] = (unsigned)(sl >> 2) * (unsigned)(K * 2) + (unsigned)C * 2u; }
            } }
            PG8_LDA(At, 0, 1); PG8_STAGEB(0, 0, b2, kt2); PG8_STAGEB(0, 1, b2, kt2); PG8_STAGEA(0, 0, a2, kt2);
            PG8_WAIT_V(8); PG8_WAIT_L(0); PG8_BAR; PG8_MMA(1, 0, At, B0); PG8_MMA(1, 1, At, B1); PG8_BAR; PG8_SCHED;
            PG8_LDB(B0, 1, 0); PG8_LDB(B1, 1, 1); PG8_SCHED; PG8_LDA(At, 1, 0); PG8_STAGEA(0, 1, a2, kt2);
            PG8_WAIT_V(8); PG8_WAIT_L(0); PG8_BAR; PG8_MMA(0, 0, At, B0); PG8_MMA(0, 1, At, B1); PG8_BAR; PG8_SCHED;
            PG8_LDA(At, 1, 1); PG8_STAGEB(1, 0, b2, kt2 + 1); PG8_STAGEB(1, 1, b2, kt2 + 1); PG8_STAGEA(1, 0, a2, kt2 + 1);
            PG8_WAIT_V(8); PG8_WAIT_L(0); PG8_BAR; PG8_MMA(1, 0, At, B0); PG8_MMA(1, 1, At, B1); PG8_BAR; PG8_SCHED;
        }
        if (wr == 0) PG8_BAR;
        E(acc, cur, wr, wc, fr, fq);
        if (!has_next) break;
#pragma unroll
        for (int a = 0; a < 2; ++a)
#pragma unroll
            for (int b = 0; b < 2; ++b)
#pragma unroll
                for (int m = 0; m < 4; ++m)
#pragma unroll
                    for (int n = 0; n < 2; ++n) acc[a][b][m][n] = (f32x4){0.f, 0.f, 0.f, 0.f};
        cur = nxt; cA = nA; cB = nB; ++ui;
        if (wr == 1) PG8_BAR;
    }
    PG8_WAIT_V(0);
    PG8_BAR;
#undef PG8_SA
#undef PG8_SB
#undef PG8_STAGE
#undef PG8_STAGEA
#undef PG8_STAGEB
#undef PG8_LDA
#undef PG8_LDB
#undef PG8_MMA
#undef PG8_WAIT_V
#undef PG8_WAIT_L
#undef PG8_BAR
#undef PG8_SCHED
}

struct EpiBf16 {
    static constexpr bool PERM = true;
    bf16_t* O; int ldc; const float* bias;
    DI void operator()(const f32x4 (&acc)[2][2][4][2], const Unit& u, int wr, int wc, int fr, int fq) const {
        const int row0 = u.r0 + wr * 64 + fr, col0 = u.c0 + wc * 32 + 8 * fq;
        f32x4 bv[2][2];
#pragma unroll
        for (int bj = 0; bj < 2; ++bj)
#pragma unroll
            for (int n = 0; n < 2; ++n) bv[bj][n] = bias ? *(const f32x4*)(bias + col0 + bj * HALF + 4 * n) : (f32x4){0.f, 0.f, 0.f, 0.f};
#pragma unroll
        for (int ai = 0; ai < 2; ++ai)
#pragma unroll
            for (int m = 0; m < 4; ++m) { bf16_t* rowp = O + (size_t)(row0 + ai * HALF + m * 16) * ldc + col0;
#pragma unroll
                for (int bj = 0; bj < 2; ++bj) { const f32x4 v0 = acc[ai][bj][m][0] + bv[bj][0], v1 = acc[ai][bj][m][1] + bv[bj][1];
                    u32x4 w; w.x = pk2(v0[0], v0[1]); w.y = pk2(v0[2], v0[3]); w.z = pk2(v1[0], v1[1]); w.w = pk2(v1[2], v1[3]);
                    *(u32x4*)(rowp + bj * HALF) = w; } }
    }
};
struct EpiF32 {
    static constexpr bool PERM = false;
    float* Y; int ldc; const float* bias;
    DI void operator()(const f32x4 (&acc)[2][2][4][2], const Unit& u, int wr, int wc, int fr, int fq) const {
        const int row0 = u.r0 + wr * 64 + fr, col0 = u.c0 + wc * 32 + 4 * fq;
        f32x4 bv[2][2];
#pragma unroll
        for (int bj = 0; bj < 2; ++bj)
#pragma unroll
            for (int n = 0; n < 2; ++n) bv[bj][n] = bias ? *(const f32x4*)(bias + col0 + bj * HALF + 16 * n) : (f32x4){0.f, 0.f, 0.f, 0.f};
#pragma unroll
        for (int ai = 0; ai < 2; ++ai)
#pragma unroll
            for (int m = 0; m < 4; ++m) { float* rowp = Y + (size_t)(row0 + ai * HALF + m * 16) * ldc + col0;
#pragma unroll
                for (int bj = 0; bj < 2; ++bj)
#pragma unroll
                    for (int n = 0; n < 2; ++n) *(f32x4*)(rowp + bj * HALF + 16 * n) = acc[ai][bj][m][n] + bv[bj][n]; }
    }
};
DI float swiglu1(float g, float lin) {
    g = fminf(g, 7.0f); lin = fminf(fmaxf(lin, -7.0f), 7.0f);
    const float s = __builtin_amdgcn_rcpf(1.0f + __builtin_amdgcn_exp2f(-1.702f * LOG2E * g));
    return g * s * (lin + 1.0f);
}
struct EpiSwiglu {
    static constexpr bool PERM = true;
    bf16_t* O; const float* bias;
    DI void operator()(const f32x4 (&acc)[2][2][4][2], const Unit& u, int wr, int wc, int fr, int fq) const {
        const int row0 = u.r0 + wr * 64 + fr, col0 = u.c0 + wc * 32 + 8 * fq;
        const float* bp = bias + (size_t)u.aux * (2 * FF) + col0;
        f32x4 bv[2][2];
#pragma unroll
        for (int bj = 0; bj < 2; ++bj)
#pragma unroll
            for (int n = 0; n < 2; ++n) bv[bj][n] = *(const f32x4*)(bp + bj * HALF + 4 * n);
#pragma unroll
        for (int ai = 0; ai < 2; ++ai)
#pragma unroll
            for (int m = 0; m < 4; ++m) { bf16_t* rowp = O + (size_t)(row0 + ai * HALF + m * 16) * FF + (col0 >> 1);
#pragma unroll
                for (int bj = 0; bj < 2; ++bj) { const f32x4 v0 = acc[ai][bj][m][0] + bv[bj][0], v1 = acc[ai][bj][m][1] + bv[bj][1];
                    u32x2 w; w.x = pk2(swiglu1(v0[0], v0[1]), swiglu1(v0[2], v0[3])); w.y = pk2(swiglu1(v1[0], v1[1]), swiglu1(v1[2], v1[3]));
                    *(u32x2*)(rowp + bj * (HALF / 2)) = w; } }
    }
};
struct EpiMoe2 {
    static constexpr bool PERM = true;
    bf16_t* O; const float* bias; const float* gate; const int* list;
    DI void operator()(const f32x4 (&acc)[2][2][4][2], const Unit& u, int wr, int wc, int fr, int fq) const {
        const int rl0 = wr * 64 + fr, col0 = u.c0 + wc * 32 + 8 * fq;
        const float* bp = bias + (size_t)u.aux * DM + col0;
        f32x4 bv[2][2];
#pragma unroll
        for (int bj = 0; bj < 2; ++bj)
#pragma unroll
            for (int n = 0; n < 2; ++n) bv[bj][n] = *(const f32x4*)(bp + bj * HALF + 4 * n);
#pragma unroll
        for (int ai = 0; ai < 2; ++ai)
#pragma unroll
            for (int m = 0; m < 4; ++m) { const int rl = rl0 + ai * HALF + m * 16;
                if (rl < u.nvalid) { const int slot = list[u.io + rl]; const float g = gate[slot]; bf16_t* rowp = O + (size_t)slot * DM + col0;
#pragma unroll
                    for (int bj = 0; bj < 2; ++bj) { const f32x4 v0 = (acc[ai][bj][m][0] + bv[bj][0]) * g, v1 = (acc[ai][bj][m][1] + bv[bj][1]) * g;
                        u32x4 w; w.x = pk2(v0[0], v0[1]); w.y = pk2(v0[2], v0[3]); w.z = pk2(v1[0], v1[1]); w.w = pk2(v1[2], v1[3]);
                        *(u32x4*)(rowp + bj * HALF) = w; } } }
    }
};
struct DenseOrder {
    int nN, nunits, G, c, r0; unsigned step;
    DI bool next(int i, Unit& u) const {
        const int L = i * G + c; if (L >= nunits) return false;
        const int pm = L / nN, pn = L - pm * nN;
        u.ao = (unsigned)pm * step; u.bo = (unsigned)pn * step; u.r0 = r0 + pm * BM; u.c0 = pn * BM; u.aux = 0; u.io = 0u; u.nvalid = 256; return true;
    }
};
template <int LGN, int BROWS>
struct MoeOrder {
    const volatile LAS unsigned* misc; int G, c;
    DI bool next(int i, Unit& u) const {
        const int L = i * G + c; const int ntile = __builtin_amdgcn_readfirstlane((int)misc[MW_TP + 32]);
        if (L >= (ntile << LGN)) return false;
        const int T = L >> LGN, pn = L & ((1 << LGN) - 1); const int e = __builtin_amdgcn_readfirstlane((int)misc[MW_TEXP + T]);
        const int mt = T - __builtin_amdgcn_readfirstlane((int)misc[MW_TP + e]); int nv = __builtin_amdgcn_readfirstlane((int)misc[MW_CN + e]) - mt * 256; if (nv > 256) nv = 256;
        u.ao = (unsigned)T * (256u * 1024u * 2u); u.bo = (unsigned)(e * BROWS + pn * 256) * (1024u * 2u); u.r0 = T * BM; u.c0 = pn * BM; u.aux = e;
        u.io = (unsigned)(e * CAP + mt * 256); u.nvalid = nv; return true;
    }
};
}

#define XB_TMO      128
#define XB_XCNT(j)  (256  + 64 * (j))
#define XB_XSUB(j)  (1280 + 64 * (j))
#define XB_XGEN(j)  (2304 + 64 * (j))
#define XB_TOP      3328
#define XB_TOPGEN   3392
#define XCD_BAR_WORDS 3456
#define XB_SPIN_CAP (1u << 18)
DI unsigned xb_ld(unsigned* p)              { return __hip_atomic_load(p, __ATOMIC_RELAXED, __HIP_MEMORY_SCOPE_AGENT); }
DI unsigned xb_add(unsigned* p, unsigned v) { return __hip_atomic_fetch_add(p, v, __ATOMIC_RELAXED, __HIP_MEMORY_SCOPE_AGENT); }
DI unsigned xb_xcc_id() { return (unsigned)__builtin_amdgcn_s_getreg((3 << 11) | 20) & 0xFu; }
#define XB_SPIN(cond, bar) do { unsigned _sp = 0; while (cond) { __builtin_amdgcn_s_sleep(1); \
    if ((++_sp & 255u) == 0u) { if (xb_ld(&(bar)[XB_TMO])) break; if (_sp > XB_SPIN_CAP) { atomicAdd(&(bar)[XB_TMO], 1u); break; } } } } while (0)
struct XcdBarrier { unsigned* bar; unsigned x; volatile LAS unsigned* st; };
DI XcdBarrier xcd_barrier_post(unsigned* bar, volatile LAS unsigned* st) {
    XcdBarrier b; b.bar = bar; b.x = xb_xcc_id(); b.st = st;
    if (threadIdx.x == 0) (void)xb_add(&bar[XB_XCNT(b.x)], 1u);
    return b;
}
DI void xcd_barrier_complete(unsigned* bar, unsigned x, unsigned& nloc, unsigned& nx) {
    const unsigned G = gridDim.x * gridDim.y * gridDim.z;
    unsigned sum, cnt, mine, sp = 0u;
    for (;;) {
        sum = 0u; cnt = 0u; mine = 0u;
#pragma unroll
        for (unsigned j = 0; j < 16; ++j) { const unsigned c = xb_ld(&bar[XB_XCNT(j)]); sum += c; cnt += (c > 0u) ? 1u : 0u; mine = (j == x) ? c : mine; }
        if (sum == G) break;
        __builtin_amdgcn_s_sleep(1);
        if ((++sp & 255u) == 0u) { if (xb_ld(&bar[XB_TMO])) break; if (sp > XB_SPIN_CAP) { atomicAdd(&bar[XB_TMO], 1u); break; } }
    }
    nloc = mine > 0u ? mine : 1u; nx = cnt > 0u ? cnt : 1u;
}
DI void xcd_barrier(const XcdBarrier& b) {
    asm volatile("s_waitcnt vmcnt(0)" ::: "memory");
    __syncthreads();
    if (threadIdx.x == 0) {
        unsigned* bar = b.bar;
        __builtin_amdgcn_s_waitcnt(0);
        unsigned nloc = b.st[0], nx = b.st[1];
        if (nloc == 0u) { xcd_barrier_complete(bar, b.x, nloc, nx); b.st[0] = nloc; b.st[1] = nx; }
        const unsigned old = xb_add(&bar[XB_XSUB(b.x)], 1u);
        const unsigned gen = old / nloc;
        if (old + 1u == (gen + 1u) * nloc) {
            __builtin_amdgcn_fence(__ATOMIC_RELEASE, "agent");
            asm volatile("s_waitcnt vmcnt(0)" ::: "memory");
            const unsigned og = xb_add(&bar[XB_TOP], 1u);
            const unsigned tg = og / nx;
            if (og + 1u == (tg + 1u) * nx) xb_add(&bar[XB_TOPGEN], 1u);
            else XB_SPIN(xb_ld(&bar[XB_TOPGEN]) == tg, bar);
            __builtin_amdgcn_fence(__ATOMIC_ACQUIRE, "agent");
            xb_add(&bar[XB_XGEN(b.x)], 1u);
            asm volatile("s_waitcnt vmcnt(0)" ::: "memory");
        } else {
            XB_SPIN(xb_ld(&bar[XB_XGEN(b.x)]) == gen, bar);
            __builtin_amdgcn_fence(__ATOMIC_ACQUIRE, "agent");
            asm volatile("s_waitcnt vmcnt(0)" ::: "memory");
        }
    }
    __syncthreads();
}

struct Args { const float* in[36]; float* out; unsigned char* ws; int ph_lo, ph_hi; };
enum { I_X = 0, I_C, I_CTX, I_CCTX, I_ADAW, I_ADAB, I_LN1G, I_LN1B, I_LN2G, I_LN2B, I_WIN_WQKV, I_WIN_BQKV, I_WIN_SINK, I_WIN_WO, I_WIN_BO,
       I_AXG_WQKV, I_AXG_QN, I_AXG_KN, I_AXG_WO, I_MLA_WQA, I_MLA_QN, I_MLA_WQB, I_MLA_WKVA, I_MLA_KVN, I_MLA_WKVB, I_MLA_WO,
       I_DIFF_WQKV, I_DIFF_LAM, I_DIFF_SUBLN, I_DIFF_WO, I_RW, I_RB, I_WIN, I_BIN, I_WOUT, I_BOUT };

struct Ctx {
    LAS unsigned char* lds; volatile LAS unsigned* misc; unsigned char* ws; int tid, lane, wave, vcu, G;
};
extern __shared__ __attribute__((aligned(16))) unsigned char lds_raw[];
DI Ctx make_ctx(unsigned char* ws, int wave_s) {
    int bx = blockIdx.x, G = gridDim.x;
    asm volatile("" : "+s"(bx), "+s"(G), "+s"(wave_s)); asm volatile("" : "+s"(ws));
    unsigned z = 0u; asm volatile("" : "+v"(z));
    const int tid = wave_s * 64 + (int)__builtin_amdgcn_mbcnt_hi(~0u, __builtin_amdgcn_mbcnt_lo(~0u, z));
    Ctx C; C.lds = (LAS unsigned char*)lds_raw; C.misc = (volatile LAS unsigned*)(C.lds + MISC_OFF); C.ws = ws;
    C.tid = tid; C.lane = tid & 63; C.wave = wave_s;
    C.G = G; C.vcu = (G % 8 == 0) ? (bx % 8) * (G / 8) + bx / 8 : bx;
    return C;
}
DI const float* inp(const Ctx& C, int i) {
    const unsigned lo = __builtin_amdgcn_readfirstlane(C.misc[MW_PTR + 2 * i]), hi = __builtin_amdgcn_readfirstlane(C.misc[MW_PTR + 2 * i + 1]);
    return (const float*)(((unsigned long long)hi << 32) | lo);
}
DI int modidx(int row) { return row < NCTX ? 8 : ((row - NCTX) >> 11); }
DI const float* modp(const Ctx& C, int l, int m, int part) { return (const float*)(C.ws + WS_MOD) + ((size_t)(l * 9 + m) * 6 + part) * DM; }

DI void sincos_acc(float ang, float& s, float& c) {
    const double x = (double)ang; const int q = (int)__builtin_rint(x * 0.6366197723675814); const double rd = x - (double)q * 1.5707963267948966;
    const float r = (float)rd, r2 = r * r;
    const float sp = r + r * r2 * (-1.6666654611e-1f + r2 * (8.3321608736e-3f + r2 * (-1.9515295891e-4f)));
    const float cp = 1.0f - 0.5f * r2 + r2 * r2 * (4.166664568298827e-2f + r2 * (-1.388731625493765e-3f + r2 * 2.443315711809948e-5f));
    switch (q & 3) { case 0: s = sp; c = cp; break; case 1: s = cp; c = -sp; break; case 2: s = -sp; c = -cp; break; default: s = -cp; c = sp; break; }
}
DI void cvt_item(const float* src, int N, bf16_t* dst, int Kd, int row_off, int k0, int n0, int lane) {
    const int n = n0 + lane; const bool valid = n < N;
    const float* sp = src + (size_t)k0 * N + (valid ? n : 0);
    float v[64];
#pragma unroll
    for (int i = 0; i < 64; ++i) v[i] = sp[(size_t)i * N];
    if (valid) {
        bf16_t* dp = dst + (size_t)(row_off + n) * Kd + k0;
#pragma unroll
        for (int j = 0; j < 8; ++j) { u32x4 w; w.x = pk2(v[8 * j], v[8 * j + 1]); w.y = pk2(v[8 * j + 2], v[8 * j + 3]); w.z = pk2(v[8 * j + 4], v[8 * j + 5]); w.w = pk2(v[8 * j + 6], v[8 * j + 7]);
            *(u32x4*)(dp + 8 * j) = w; }
    }
}
DI bool cvt_mat(int& r, const float* src, int K, int N, bf16_t* dst, int row_off, int lane) {
    const int nb = (N + 63) >> 6, items = (K >> 6) * nb;
    if (r < items) { const int kb = r / nb, nbk = r - kb * nb; cvt_item(src, N, dst, K, row_off, kb * 64, nbk * 64, lane); return true; }
    r -= items; return false;
}
DI void phase_prologue(int wave_s, unsigned char* ws0) {
    const Ctx C = make_ctx(ws0, wave_s); unsigned char* ws = C.ws;
    if (C.vcu < 384) {
        LAS float* sv = (LAS float*)C.lds; LAS float* part = sv + 9 * 1024;
        for (int i = C.tid; i < 9 * 1024; i += 512) { const int m = i >> 10, k = i & 1023; const float c = m < 8 ? inp(C, I_C)[m * 1024 + k] : inp(C, I_CCTX)[k]; sv[i] = c / (1.0f + expf(-c)); }
        __syncthreads();
        for (int it = C.vcu; it < 384; it += C.G) {
            const int l = it / 96, cg = it - l * 96;
            const float* w = inp(C, I_ADAW) + (size_t)l * 1024 * 6144 + cg * 64 + C.lane;
            float acc[9];
#pragma unroll
            for (int m = 0; m < 9; ++m) acc[m] = 0.f;
#pragma unroll 32
            for (int kk = 0; kk < 128; ++kk) { const int k = C.wave * 128 + kk; const float wv = w[(size_t)k * 6144];
#pragma unroll
                for (int m = 0; m < 9; ++m) acc[m] += sv[m * 1024 + k] * wv; }
#pragma unroll
            for (int m = 0; m < 9; ++m) part[(C.wave * 9 + m) * 64 + C.lane] = acc[m];
            __syncthreads();
            for (int i = C.tid; i < 576; i += 512) { const int m = i >> 6, j = i & 63; float s = 0.f;
#pragma unroll
                for (int w8 = 0; w8 < 8; ++w8) s += part[(w8 * 9 + m) * 64 + j];
                const int col = cg * 64 + j; ((float*)(ws + WS_MOD))[(size_t)(l * 9 + m) * 6144 + col] = s + inp(C, I_ADAB)[l * 6144 + col]; }
            __syncthreads();
        }
    }
    {
        float* rt = (float*)(ws + WS_ROPE);
        const int total = 2048 * 2 * (16 + 32 + 8);
        for (int i = C.vcu * 512 + C.tid; i < total; i += C.G * 512) {
            int nf, base, idx = i;
            if (idx < 2048 * 2 * 16) { nf = 16; base = RT16; } else if ((idx -= 2048 * 2 * 16) < 2048 * 2 * 32) { nf = 32; base = RT32; } else { idx -= 2048 * 2 * 32; nf = 8; base = RT8; }
            const int f = idx % nf, half = (idx / nf) & 1, pos = idx / (2 * nf);
            const float pv = (float)(half == 0 ? (pos >> 6) : (pos & 63));
            const float inv = exp2f(-((float)f / (float)nf) * 13.287712379549449f);
            const float ang = pv * inv; float s, c; sincos_acc(ang, s, c);
            rt[base + idx] = c; rt[base + 2048 * 2 * nf + idx] = s;
        }
    }
    {
        bf16_t* wsm = (bf16_t*)(ws + WS_WSMALL);
        const int gw = C.vcu * 8 + C.wave, NGW = C.G * 8;
        constexpr int NI_IN = 128 * 512, NI_OUT = 128 * 256, NI_SMALL = 384 + 256 + 384 + 256 + 96 + 80 + 144 + 128 + 256 + 768 + 256;
        for (int it = gw; it < NI_IN + NI_OUT + NI_SMALL; it += NGW) {
            int r = it;
            if (r < NI_IN) { const int le = r >> 9, q = r & 511; cvt_item(inp(C, I_WIN) + (size_t)le * 1024 * 2048, 2048, (bf16_t*)(ws + WS_WIN) + (size_t)le * 2048 * 1024, 1024, 0, (q >> 5) * 64, (q & 31) * 64, C.lane); continue; }
            r -= NI_IN;
            if (r < NI_OUT) { const int le = r >> 8, q = r & 255; cvt_item(inp(C, I_WOUT) + (size_t)le * 1024 * 1024, 1024, (bf16_t*)(ws + WS_WOUT) + (size_t)le * 1024 * 1024, 1024, 0, (q >> 4) * 64, (q & 15) * 64, C.lane); continue; }
            r -= NI_OUT;
            if (cvt_mat(r, inp(C, I_WIN_WQKV), 1024, 1536, wsm + OFF_WQKV0 / 2, 0, C.lane)) continue;
            if (cvt_mat(r, inp(C, I_WIN_WO), 1024, 1024, wsm + OFF_WO0 / 2, 0, C.lane)) continue;
            if (cvt_mat(r, inp(C, I_AXG_WQKV), 1024, 1536, wsm + OFF_WQKV1 / 2, 0, C.lane)) continue;
            if (cvt_mat(r, inp(C, I_AXG_WO), 1024, 1024, wsm + OFF_WO1 / 2, 0, C.lane)) continue;
            if (cvt_mat(r, inp(C, I_MLA_WQA), 1024, 384, wsm + OFF_WA / 2, 0, C.lane)) continue;
            if (cvt_mat(r, inp(C, I_MLA_WKVA), 1024, 288, wsm + OFF_WA / 2, 384, C.lane)) continue;
            if (cvt_mat(r, inp(C, I_MLA_WQB), 384, 1536, wsm + OFF_WQB / 2, 0, C.lane)) continue;
            if (cvt_mat(r, inp(C, I_MLA_WKVB), 256, 2048, wsm + OFF_WKVB / 2, 0, C.lane)) continue;
            if (cvt_mat(r, inp(C, I_MLA_WO), 1024, 1024, wsm + OFF_WO2 / 2, 0, C.lane)) continue;
            if (cvt_mat(r, inp(C, I_DIFF_WQKV), 1024, 3072, wsm + OFF_WQKV3 / 2, 0, C.lane)) continue;
            cvt_mat(r, inp(C, I_DIFF_WO), 1024, 1024, wsm + OFF_WO3 / 2, 0, C.lane);
        }
        for (int i = C.vcu * 512 + C.tid; i < 4 * 32 * 1024; i += C.G * 512) { const int k = i & 1023, e = (i >> 10) & 31, l = i >> 15;
            const float w = inp(C, I_RW)[((size_t)l * 1024 + k) * 32 + e]; const bf16_t hi = f2bf(w); bf16_t* rwt = (bf16_t*)(ws + WS_RWT) + (size_t)l * 2 * 32 * 1024;
            rwt[e * 1024 + k] = hi; rwt[32 * 1024 + e * 1024 + k] = f2bf(w - bf2f(hi)); }
        for (int i = C.vcu * 512 + C.tid; i < 96 * 1024 / 8; i += C.G * 512) *(u32x4*)(wsm + OFF_WA / 2 + (size_t)672 * 1024 + (size_t)i * 8) = (u32x4){0u, 0u, 0u, 0u};
    }
}

DI void ld_row(const float* p, int lane, f32x4 (&v)[4]) {
#pragma unroll
    for (int j = 0; j < 4; ++j) v[j] = *(const f32x4*)(p + j * 256 + lane * 4);
}
DI void st_row(float* p, int lane, const f32x4 (&v)[4]) {
#pragma unroll
    for (int j = 0; j < 4; ++j) *(f32x4*)(p + j * 256 + lane * 4) = v[j];
}
DI void st_row_bf(bf16_t* p, int lane, const f32x4 (&v)[4]) {
#pragma unroll
    for (int j = 0; j < 4; ++j) { u32x2 w; w.x = pk2(v[j][0], v[j][1]); w.y = pk2(v[j][2], v[j][3]); *(u32x2*)(p + j * 256 + lane * 4) = w; }
}
DI void layernorm_row(f32x4 (&v)[4], const float* g, const float* b, int lane) {
    float s = 0.f;
#pragma unroll
    for (int j = 0; j < 4; ++j) s += (v[j][0] + v[j][1]) + (v[j][2] + v[j][3]);
    const float mean = wave_sum(s, lane) * (1.0f / DM); float q = 0.f;
#pragma unroll
    for (int j = 0; j < 4; ++j) { v[j] = v[j] - mean; q += (v[j][0] * v[j][0] + v[j][1] * v[j][1]) + (v[j][2] * v[j][2] + v[j][3] * v[j][3]); }
    const float rstd = 1.0f / sqrtf(wave_sum(q, lane) * (1.0f / DM) + LN_EPS);
    f32x4 gg[4], bb[4]; ld_row(g, lane, gg); ld_row(b, lane, bb);
#pragma unroll
    for (int j = 0; j < 4; ++j) v[j] = (v[j] * rstd) * gg[j] + bb[j];
}
DI void modulate_row(const f32x4 (&x)[4], const float* sh, const float* sc, int lane, f32x4 (&h)[4]) {
    f32x4 a[4], b[4]; ld_row(sc, lane, a); ld_row(sh, lane, b);
#pragma unroll
    for (int j = 0; j < 4; ++j) h[j] = x[j] * (1.0f + a[j]) + b[j];
}

DI void phase_modh0(int wave_s, unsigned char* ws_) {
    const Ctx C = make_ctx(ws_, wave_s);
    float* X = (float*)(C.ws + WS_X); bf16_t* H = (bf16_t*)(C.ws + WS_H);
    for (int row = C.vcu * 8 + C.wave; row < NT; row += C.G * 8) {
        const float* src = row < NCTX ? inp(C, I_CTX) + (size_t)row * DM : inp(C, I_X) + (size_t)(row - NCTX) * DM;
        f32x4 v[4], h[4]; ld_row(src, C.lane, v); st_row(X + (size_t)row * DM, C.lane, v);
        const int m = modidx(row); modulate_row(v, modp(C, 0, m, 0), modp(C, 0, m, 1), C.lane, h);
        st_row_bf(H + (size_t)row * DM, C.lane, h);
    }
}

template <int NF> DI void rope_heads(bf16_t* p, int nheads, int stride, const float* rt, int rtbase, int pos, int lane) {
    constexpr int CPH = 2 * (NF / 8);
    const float* ct = rt + rtbase + (size_t)pos * 2 * NF; const float* st = ct + 2048 * 2 * NF;
    for (int c = lane; c < nheads * CPH; c += 64) {
        const int hh = c / CPH, rem = c - hh * CPH, half = rem / (NF / 8), sub = rem - half * (NF / 8);
        bf16_t* x1p = p + hh * stride + half * 2 * NF + sub * 8; bf16_t* x2p = x1p + NF;
        const u32x4 a = *(const u32x4*)x1p, b = *(const u32x4*)x2p;
        const f32x4 c0 = *(const f32x4*)(ct + half * NF + sub * 8), c1 = *(const f32x4*)(ct + half * NF + sub * 8 + 4);
        const f32x4 s0 = *(const f32x4*)(st + half * NF + sub * 8), s1 = *(const f32x4*)(st + half * NF + sub * 8 + 4);
        float x1[8] = {bf_lo(a.x), bf_hi(a.x), bf_lo(a.y), bf_hi(a.y), bf_lo(a.z), bf_hi(a.z), bf_lo(a.w), bf_hi(a.w)};
        float x2[8] = {bf_lo(b.x), bf_hi(b.x), bf_lo(b.y), bf_hi(b.y), bf_lo(b.z), bf_hi(b.z), bf_lo(b.w), bf_hi(b.w)};
        float cc[8] = {c0[0], c0[1], c0[2], c0[3], c1[0], c1[1], c1[2], c1[3]}, ss[8] = {s0[0], s0[1], s0[2], s0[3], s1[0], s1[1], s1[2], s1[3]};
        float y1[8], y2[8];
#pragma unroll
        for (int i = 0; i < 8; ++i) { y1[i] = x1[i] * cc[i] - x2[i] * ss[i]; y2[i] = x1[i] * ss[i] + x2[i] * cc[i]; }
        u32x4 o1, o2; o1.x = pk2(y1[0], y1[1]); o1.y = pk2(y1[2], y1[3]); o1.z = pk2(y1[4], y1[5]); o1.w = pk2(y1[6], y1[7]);
        o2.x = pk2(y2[0], y2[1]); o2.y = pk2(y2[2], y2[3]); o2.z = pk2(y2[4], y2[5]); o2.w = pk2(y2[6], y2[7]);
        *(u32x4*)x1p = o1; *(u32x4*)x2p = o2;
    }
}
DI void vt_items(const Ctx& C, const bf16_t* src, int pitch, int col0, int hstride, int HV, int DV, bf16_t* Vt) {
    const int dvb_n = DV >> 6, items = NB * HV * dvb_n * 36;
    for (int it = C.vcu * 8 + C.wave; it < items; it += C.G * 8) {
        const int kbk = it % 36; int r = it / 36; const int dvb = r % dvb_n; r /= dvb_n; const int hv = r % HV, b = r / HV;
        const int key0 = kbk * 64;
        const int row0 = key0 < CTXL ? b * CTXL + key0 : NCTX + b * SEQ + (key0 - CTXL);
        const bf16_t* sp = src + (size_t)row0 * pitch + col0 + hv * hstride + dvb * 64 + C.lane;
        bf16_t v[64];
#pragma unroll
        for (int i = 0; i < 64; ++i) v[i] = sp[(size_t)i * pitch];
        bf16_t* dp = Vt + ((size_t)(b * HV + hv) * DV + dvb * 64 + C.lane) * NKEY + key0;
#pragma unroll
        for (int j = 0; j < 8; ++j) { u32x4 w; w.x = v[8 * j] | ((unsigned)v[8 * j + 1] << 16); w.y = v[8 * j + 2] | ((unsigned)v[8 * j + 3] << 16);
            w.z = v[8 * j + 4] | ((unsigned)v[8 * j + 5] << 16); w.w = v[8 * j + 6] | ((unsigned)v[8 * j + 7] << 16); *(u32x4*)(dp + 8 * j) = w; }
    }
}
DI int latent_pos(int row) { return (row - NCTX) & (SEQ - 1); }

DI void phase_post(int wave_s, unsigned char* ws0, int l) {
    const Ctx C = make_ctx(ws0, wave_s); unsigned char* ws = C.ws; const float* rt = (const float*)(ws + WS_ROPE);
    bf16_t* RAW = (bf16_t*)(ws + WS_RAW); bf16_t* Vt = (bf16_t*)(ws + WS_VT);
    const int gw = C.vcu * 8 + C.wave, NGW = C.G * 8;
    if (l == 0) {
        for (int row = NCTX + gw; row < NT; row += NGW) rope_heads<16>(RAW + (size_t)row * 1536, 20, 64, rt, RT16, latent_pos(row), C.lane);
        vt_items(C, RAW, 1536, 1280, 64, 4, 64, Vt);
    } else if (l == 1) {
        const float* qn = inp(C, I_AXG_QN); const float* kn = inp(C, I_AXG_KN);
        const int hs = C.lane >> 5, half = (C.lane >> 4) & 1, q2 = (C.lane & 15) * 2, d1 = half * 64 + q2, d2 = d1 + 32;
        const f32x2 gq1 = *(const f32x2*)(qn + d1), gq2 = *(const f32x2*)(qn + d2), gk1 = *(const f32x2*)(kn + d1), gk2 = *(const f32x2*)(kn + d2);
        for (int row = gw; row < NT; row += NGW) {
            bf16_t* p = RAW + (size_t)row * 1536; const bool lat = row >= NCTX;
            f32x2 cs = {1.f, 1.f}, sn = {0.f, 0.f};
            if (lat) { const int pos = latent_pos(row); cs = *(const f32x2*)(rt + RT32 + (pos * 2 + half) * 32 + q2); sn = *(const f32x2*)(rt + RT32 + 2048 * 2 * 32 + (pos * 2 + half) * 32 + q2); }
            unsigned w1[5], w2[5];
#pragma unroll
            for (int ps = 0; ps < 5; ++ps) { const int hh = ps * 2 + hs; w1[ps] = *(const unsigned*)(p + hh * 128 + d1); w2[ps] = *(const unsigned*)(p + hh * 128 + d2); }
#pragma unroll
            for (int ps = 0; ps < 5; ++ps) { const int hh = ps * 2 + hs;
                float a0 = bf_lo(w1[ps]), a1 = bf_hi(w1[ps]), b0 = bf_lo(w2[ps]), b1 = bf_hi(w2[ps]);
                float ss = (a0 * a0 + a1 * a1) + (b0 * b0 + b1 * b1);
#pragma unroll
                for (int o = 1; o < 32; o <<= 1) ss += shx(ss, o, C.lane);
                const float r = 1.0f / sqrtf(ss * (1.0f / 128.0f) + NORM_EPS);
                const bool isq = hh < 8; const f32x2 g1 = isq ? gq1 : gk1, g2 = isq ? gq2 : gk2;
                a0 = a0 * r * g1[0]; a1 = a1 * r * g1[1]; b0 = b0 * r * g2[0]; b1 = b1 * r * g2[1];
                *(unsigned*)(p + hh * 128 + d1) = pk2(a0 * cs[0] - b0 * sn[0], a1 * cs[1] - b1 * sn[1]);
                *(unsigned*)(p + hh * 128 + d2) = pk2(a0 * sn[0] + b0 * cs[0], a1 * sn[1] + b1 * cs[1]);
            }
        }
        vt_items(C, RAW, 1536, 1280, 128, 2, 128, Vt);
    } else if (l == 2) {
        bf16_t* CQ = (bf16_t*)(ws + WS_CQ); bf16_t* CKV = (bf16_t*)(ws + WS_CKV); bf16_t* KPE = (bf16_t*)(ws + WS_KPE);
        const float* qn = inp(C, I_MLA_QN); const float* kvn = inp(C, I_MLA_KVN);
        for (int row = gw; row < NT; row += NGW) {
            const bf16_t* p = RAW + (size_t)row * 768;
            float q[6], ssq = 0.f;
#pragma unroll
            for (int j = 0; j < 6; ++j) { q[j] = bf2f(p[j * 64 + C.lane]); ssq += q[j] * q[j]; }
            const float rq = 1.0f / sqrtf(wave_sum(ssq, C.lane) * (1.0f / 384.0f) + NORM_EPS);
#pragma unroll
            for (int j = 0; j < 6; ++j) CQ[(size_t)row * 384 + j * 64 + C.lane] = f2bf(q[j] * rq * qn[j * 64 + C.lane]);
            float kv[4], ssk = 0.f;
#pragma unroll
            for (int j = 0; j < 4; ++j) { kv[j] = bf2f(p[384 + j * 64 + C.lane]); ssk += kv[j] * kv[j]; }
            const float rk = 1.0f / sqrtf(wave_sum(ssk, C.lane) * (1.0f / 256.0f) + NORM_EPS);
#pragma unroll
            for (int j = 0; j < 4; ++j) CKV[(size_t)row * 256 + j * 64 + C.lane] = f2bf(kv[j] * rk * kvn[j * 64 + C.lane]);
            if (C.lane < 16) {
                const int half = C.lane >> 3, f = C.lane & 7; float x1 = bf2f(p[640 + half * 16 + f]), x2 = bf2f(p[640 + half * 16 + 8 + f]);
                float cs = 1.f, sn = 0.f;
                if (row >= NCTX) { const int pos = latent_pos(row); cs = rt[RT8 + (pos * 2 + half) * 8 + f]; sn = rt[RT8 + 2048 * 2 * 8 + (pos * 2 + half) * 8 + f]; }
                KPE[(size_t)row * 32 + half * 16 + f] = f2bf(x1 * cs - x2 * sn); KPE[(size_t)row * 32 + half * 16 + 8 + f] = f2bf(x1 * sn + x2 * cs);
            }
        }
    } else {
        for (int row = NCTX + gw; row < NT; row += NGW) rope_heads<16>(RAW + (size_t)row * 3072, 32, 64, rt, RT16, latent_pos(row), C.lane);
        vt_items(C, RAW, 3072, 2048, 128, 8, 128, Vt);
    }
}
DI void phase_postb(int wave_s, unsigned char* ws0) {
    const Ctx C = make_ctx(ws0, wave_s); unsigned char* ws = C.ws; const float* rt = (const float*)(ws + WS_ROPE);
    bf16_t* Q2 = (bf16_t*)(ws + WS_Q2); const bf16_t* KV2 = (const bf16_t*)(ws + WS_KV2); const bf16_t* KPE = (const bf16_t*)(ws + WS_KPE); bf16_t* KF = (bf16_t*)(ws + WS_KF);
    const int gw = C.vcu * 8 + C.wave, NGW = C.G * 8;
    for (int row = gw; row < NT; row += NGW) {
        if (row >= NCTX) rope_heads<8>(Q2 + (size_t)row * 1536 + 64, 16, 96, rt, RT8, latent_pos(row), C.lane);
        for (int c = C.lane; c < 192; c += 64) { const int h = c / 12, j = c - h * 12;
            const u32x4 v = j < 8 ? *(const u32x4*)(KV2 + (size_t)row * 2048 + h * 128 + j * 8) : *(const u32x4*)(KPE + (size_t)row * 32 + (j - 8) * 8);
            *(u32x4*)(KF + (size_t)row * 1536 + h * 96 + j * 8) = v; }
    }
    vt_items(C, KV2, 2048, 64, 128, 16, 64, (bf16_t*)(ws + WS_VT));
}

struct AttnP { const bf16_t* Q; int qp; const bf16_t* K; int kp; const bf16_t* Vt; bf16_t* O; int G; int HV; float cscale; const float* sink; float lam; float osc; const float* subln; };
DI int crow(int reg, int h) { return (reg & 3) + 8 * (reg >> 2) + 4 * h; }

template <int DQK, int DV, bool DIFF, bool WIN>
DI void attn_unit(const Ctx& C, const AttnP& P, int b, int hsel, int qt, bool ctxq) {
    constexpr int KH = DIFF ? 2 : 1, KS = DQK * 2 + 16, VS = 136, KBYTES = KH * 64 * KS, BUFB = KBYTES + DV * VS;
    constexpr int KCH = DQK / 8, NKC = KH * 64 * KCH, NKL = (NKC + 511) / 512, NVC = DV * 8, NVL = NVC / 512;
    constexpr int QROWS = DIFF ? 128 : 256, NKS = DQK / 16, NDV = DV / 32;
    static_assert(2 * BUFB <= RING_BYTES, "attention LDS");
    const int tid = C.tid, lane = C.lane, wave = C.wave, r = lane & 31, h = lane >> 5;
    const int wg = DIFF ? (wave >> 2) : 0, wrow = (DIFF ? (wave & 3) : wave) * 32;
    const int hq = DIFF ? 2 * hsel + wg : hsel, hk0 = DIFF ? 2 * hsel : hsel / P.G, hv = DIFF ? hsel : hsel / P.G;
    const int qrow0 = ctxq ? b * CTXL : NCTX + b * SEQ + qt * QROWS;
    int t_lo = 0, t_hi = 0;
    if (!ctxq) { if (WIN) { t_lo = 4 * qt - 2; if (t_lo < 0) t_lo = 0; t_hi = 4 * qt + 6; if (t_hi > 32) t_hi = 32; } else { t_lo = 0; t_hi = 32; } }
    const int ntile = 4 + (t_hi - t_lo);
    LAS unsigned char* lds = C.lds;
    bf16x8 qf[NKS];
    { const bf16_t* qptr = P.Q + (size_t)(qrow0 + wrow + r) * P.qp + hq * DQK + 8 * h;
#pragma unroll
      for (int ks = 0; ks < NKS; ++ks) qf[ks] = *(const bf16x8*)(qptr + ks * 16); }
    u32x4 kreg[NKL], vreg[NVL];
    const bf16_t* vbase = P.Vt + (size_t)(b * P.HV + hv) * DV * NKEY;
#define ATT_LOAD(j) do { const int _j = (j); const int krow0 = _j < 4 ? b * CTXL + _j * 64 : NCTX + b * SEQ + (t_lo + _j - 4) * 64; const int vkey0 = _j < 4 ? _j * 64 : CTXL + (t_lo + _j - 4) * 64; \
        _Pragma("unroll") for (int i = 0; i < NKL; ++i) { const int c = tid + i * 512; if (NKC % 512 == 0 || c < NKC) { const int kh = c / (64 * KCH), rem = c - kh * (64 * KCH), key = rem / KCH, dc = rem - key * KCH; \
            kreg[i] = *(const u32x4*)(P.K + (size_t)(krow0 + key) * P.kp + (hk0 + kh) * DQK + dc * 8); } } \
        _Pragma("unroll") for (int i = 0; i < NVL; ++i) { const int c = tid + i * 512; const int dv = c >> 3, kc = c & 7; vreg[i] = *(const u32x4*)(vbase + (size_t)dv * NKEY + vkey0 + kc * 8); } } while (0)
#define ATT_WRITE(buf) do { LAS unsigned char* _b = lds + (buf) * BUFB; \
        _Pragma("unroll") for (int i = 0; i < NKL; ++i) { const int c = tid + i * 512; if (NKC % 512 == 0 || c < NKC) { const int kh = c / (64 * KCH), rem = c - kh * (64 * KCH), key = rem / KCH, dc = rem - key * KCH; \
            *(LAS u32x4*)(_b + kh * 64 * KS + key * KS + dc * 16) = kreg[i]; } } \
        _Pragma("unroll") for (int i = 0; i < NVL; ++i) { const int c = tid + i * 512; const int dv = c >> 3, kc = c & 7; LAS unsigned char* d = _b + KBYTES + dv * VS + kc * 16; \
            *(LAS u32x2*)d = (u32x2){vreg[i].x, vreg[i].y}; *(LAS u32x2*)(d + 8) = (u32x2){vreg[i].z, vreg[i].w}; } } while (0)
    f32x16 o[NDV];
#pragma unroll
    for (int d = 0; d < NDV; ++d)
#pragma unroll
        for (int i = 0; i < 16; ++i) o[d][i] = 0.f;
    float m_run = -INFINITY, l_run = 0.f;
    const int qpos = qt * QROWS + wrow + r;
    __syncthreads();
    ATT_LOAD(0); ATT_WRITE(0);
    __syncthreads();
    for (int j = 0; j < ntile; ++j) {
        const int cur = j & 1;
        const LAS unsigned char* kb_ = lds + cur * BUFB + wg * 64 * KS + r * KS + 16 * h;
        const LAS unsigned char* vb_ = lds + cur * BUFB + KBYTES + r * VS + 8 * h;
        f32x16 s0, s1;
#pragma unroll
        for (int i = 0; i < 16; ++i) { s0[i] = 0.f; s1[i] = 0.f; }
#pragma unroll
        for (int ks = 0; ks < NKS; ++ks) {
            const bf16x8 a0 = *(const LAS bf16x8*)(kb_ + ks * 32), a1 = *(const LAS bf16x8*)(kb_ + 32 * KS + ks * 32);
            s0 = __builtin_amdgcn_mfma_f32_32x32x16_bf16(a0, qf[ks], s0, 0, 0, 0);
            s1 = __builtin_amdgcn_mfma_f32_32x32x16_bf16(a1, qf[ks], s1, 0, 0, 0);
        }
        float mx = -INFINITY;
#pragma unroll
        for (int i = 0; i < 16; ++i) { s0[i] *= P.cscale; s1[i] *= P.cscale; }
        if (WIN) { if (!ctxq && j >= 4) { const int kp0 = (t_lo + j - 4) * 64;
#pragma unroll
            for (int i = 0; i < 16; ++i) { const int k0 = kp0 + crow(i, h), d0 = qpos - k0, d1 = d0 - 32;
                if (d0 > 128 || d0 < -128) s0[i] = -INFINITY; if (d1 > 128 || d1 < -128) s1[i] = -INFINITY; } } }
#pragma unroll
        for (int i = 0; i < 16; ++i) mx = fmaxf(mx, fmaxf(s0[i], s1[i]));
        mx = fmaxf(mx, shx(mx, 32, lane));
        const float m_new = fmaxf(m_run, mx);
        const float alpha = __builtin_amdgcn_exp2f(m_run - m_new);
        float rs = 0.f;
#pragma unroll
        for (int i = 0; i < 16; ++i) { s0[i] = __builtin_amdgcn_exp2f(s0[i] - m_new); s1[i] = __builtin_amdgcn_exp2f(s1[i] - m_new); rs += s0[i] + s1[i]; }
        rs += shx(rs, 32, lane);
        l_run = l_run * alpha + rs; m_run = m_new;
        if (!__all(alpha == 1.0f)) {
#pragma unroll
            for (int d = 0; d < NDV; ++d)
#pragma unroll
                for (int i = 0; i < 16; ++i) o[d][i] *= alpha;
        }
        if (j + 1 < ntile) ATT_LOAD(j + 1);
        bf16x8 pf[2][2];
#pragma unroll
        for (int s = 0; s < 2; ++s) {
            u32x4 w0, w1;
            w0.x = pk2(s0[8 * s + 0], s0[8 * s + 1]); w0.y = pk2(s0[8 * s + 2], s0[8 * s + 3]); w0.z = pk2(s0[8 * s + 4], s0[8 * s + 5]); w0.w = pk2(s0[8 * s + 6], s0[8 * s + 7]);
            w1.x = pk2(s1[8 * s + 0], s1[8 * s + 1]); w1.y = pk2(s1[8 * s + 2], s1[8 * s + 3]); w1.z = pk2(s1[8 * s + 4], s1[8 * s + 5]); w1.w = pk2(s1[8 * s + 6], s1[8 * s + 7]);
            pf[0][s] = __builtin_bit_cast(bf16x8, w0); pf[1][s] = __builtin_bit_cast(bf16x8, w1);
        }
#pragma unroll
        for (int d = 0; d < NDV; ++d)
#pragma unroll
            for (int kb = 0; kb < 2; ++kb)
#pragma unroll
                for (int s = 0; s < 2; ++s) {
                    const LAS unsigned char* vp = vb_ + d * 32 * VS + kb * 64 + s * 32;
                    const u32x2 lo = *(const LAS u32x2*)vp, hi = *(const LAS u32x2*)(vp + 16);
                    const u32x4 vv = {lo.x, lo.y, hi.x, hi.y};
                    o[d] = __builtin_amdgcn_mfma_f32_32x32x16_bf16(__builtin_bit_cast(bf16x8, vv), pf[kb][s], o[d], 0, 0, 0);
                }
        if (j + 1 < ntile) ATT_WRITE(cur ^ 1);
        __syncthreads();
    }
#undef ATT_LOAD
#undef ATT_WRITE
    float lfin = l_run, fsc = 1.0f;
    if (WIN) { const float sk = P.sink[hq] * LOG2E; const float m2 = fmaxf(m_run, sk); fsc = __builtin_amdgcn_exp2f(m_run - m2); lfin = l_run * fsc + __builtin_amdgcn_exp2f(sk - m2); }
    const float inv = fsc / lfin;
    bf16_t* orow = P.O + (size_t)(qrow0 + wrow + r) * DM;
    if (!DIFF) {
#pragma unroll
        for (int d = 0; d < NDV; ++d)
#pragma unroll
            for (int g = 0; g < 4; ++g) { u32x2 w; w.x = pk2(o[d][4 * g] * inv, o[d][4 * g + 1] * inv); w.y = pk2(o[d][4 * g + 2] * inv, o[d][4 * g + 3] * inv);
                *(u32x2*)(orow + hq * DV + d * 32 + 8 * g + 4 * h) = w; }
    } else {
        LAS float* o2 = (LAS float*)lds;
        if (wg == 1) {
#pragma unroll
            for (int d = 0; d < NDV; ++d)
#pragma unroll
                for (int g = 0; g < 4; ++g) *(LAS f32x4*)(o2 + (wrow + r) * 132 + d * 32 + 8 * g + 4 * h) = (f32x4){o[d][4 * g] * inv, o[d][4 * g + 1] * inv, o[d][4 * g + 2] * inv, o[d][4 * g + 3] * inv};
        }
        __syncthreads();
        if (wg == 0) {
            float ssq = 0.f;
#pragma unroll
            for (int d = 0; d < NDV; ++d)
#pragma unroll
                for (int g = 0; g < 4; ++g) { const f32x4 t = *(const LAS f32x4*)(o2 + (wrow + r) * 132 + d * 32 + 8 * g + 4 * h);
#pragma unroll
                    for (int i = 0; i < 4; ++i) { const float v = o[d][4 * g + i] * inv - P.lam * t[i]; o[d][4 * g + i] = v; ssq += v * v; } }
            ssq += shx(ssq, 32, lane);
            const float rn = P.osc / sqrtf(ssq * (1.0f / DV) + NORM_EPS);
#pragma unroll
            for (int d = 0; d < NDV; ++d)
#pragma unroll
                for (int g = 0; g < 4; ++g) { const int dv = d * 32 + 8 * g + 4 * h; const f32x4 sg = *(const f32x4*)(P.subln + dv);
                    u32x2 w; w.x = pk2(o[d][4 * g] * rn * sg[0], o[d][4 * g + 1] * rn * sg[1]); w.y = pk2(o[d][4 * g + 2] * rn * sg[2], o[d][4 * g + 3] * rn * sg[3]);
                    *(u32x2*)(orow + hsel * DV + dv) = w; }
        }
    }
}


DI AttnP attn_base(unsigned char* ws) { AttnP P; P.Vt = (const bf16_t*)(ws + WS_VT); P.O = (bf16_t*)(ws + WS_O); P.sink = nullptr; P.lam = 0.f; P.osc = 1.f; P.subln = nullptr; return P; }
DI void ph_attn0(int wave_s, unsigned char* ws0) {
    const Ctx C = make_ctx(ws0, wave_s); unsigned char* ws = C.ws; const float* sink = inp(C, I_WIN_SINK); AttnP P = attn_base(ws); const bf16_t* RAW = (const bf16_t*)(ws + WS_RAW);
    P.Q = RAW; P.qp = 1536; P.K = RAW + 1024; P.kp = 1536; P.G = 4; P.HV = 4; P.cscale = 0.125f * LOG2E; P.sink = sink;
    for (int u = C.vcu; u < 1024 + 128; u += C.G) {
        if (u < 1024) { const int b = u >> 7, rem = u & 127; attn_unit<64, 64, false, true>(C, P, b, rem >> 3, rem & 7, false); }
        else { const int v = u - 1024; attn_unit<64, 64, false, true>(C, P, v >> 4, v & 15, 0, true); }
    }
}
DI void ph_attn1(int wave_s, unsigned char* ws0) {
    const Ctx C = make_ctx(ws0, wave_s); unsigned char* ws = C.ws; AttnP P = attn_base(ws); const bf16_t* RAW = (const bf16_t*)(ws + WS_RAW);
    P.Q = RAW; P.qp = 1536; P.K = RAW + 1024; P.kp = 1536; P.G = 4; P.HV = 2; P.cscale = 0.08838834764831845f * LOG2E;
    for (int u = C.vcu; u < 512 + 64; u += C.G) {
        if (u < 512) { const int b = u >> 6, rem = u & 63; attn_unit<128, 128, false, false>(C, P, b, rem >> 3, rem & 7, false); }
        else { const int v = u - 512; attn_unit<128, 128, false, false>(C, P, v >> 3, v & 7, 0, true); }
    }
}
DI void ph_attn2(int wave_s, unsigned char* ws0) {
    const Ctx C = make_ctx(ws0, wave_s); unsigned char* ws = C.ws; AttnP P = attn_base(ws);
    P.Q = (const bf16_t*)(ws + WS_Q2); P.qp = 1536; P.K = (const bf16_t*)(ws + WS_KF); P.kp = 1536; P.G = 1; P.HV = 16; P.cscale = 0.10206207261596577f * LOG2E;
    for (int u = C.vcu; u < 1024 + 128; u += C.G) {
        if (u < 1024) { const int b = u >> 7, rem = u & 127; attn_unit<96, 64, false, false>(C, P, b, rem >> 3, rem & 7, false); }
        else { const int v = u - 1024; attn_unit<96, 64, false, false>(C, P, v >> 4, v & 15, 0, true); }
    }
}
DI void ph_attn3(int wave_s, unsigned char* ws0) {
    const Ctx C = make_ctx(ws0, wave_s); unsigned char* ws = C.ws; const float* lp = inp(C, I_DIFF_LAM); const float* subln = inp(C, I_DIFF_SUBLN); AttnP P = attn_base(ws); const bf16_t* RAW = (const bf16_t*)(ws + WS_RAW);
    P.Q = RAW; P.qp = 3072; P.K = RAW + 1024; P.kp = 3072; P.G = 1; P.HV = 8; P.cscale = 0.125f * LOG2E; P.subln = subln;
    const float linit = 0.8f - 0.6f * expf(-0.3f * 3.0f);
    const float s1 = wave_sum(lp[C.lane] * lp[64 + C.lane], C.lane), s2 = wave_sum(lp[128 + C.lane] * lp[192 + C.lane], C.lane);
    P.lam = expf(s1) - expf(s2) + linit; P.osc = 1.0f - linit;
    for (int u = C.vcu; u < 1024; u += C.G) { const int b = u >> 7, rem = u & 127; attn_unit<64, 128, true, false>(C, P, b, rem >> 4, rem & 15, false); }
}

DI void moe_tables(const Ctx& C, int l) {
    const unsigned* cnt = (const unsigned*)(C.ws + WS_CTL) + CW_CNT + l * 32;
    __syncthreads();
    if (C.tid == 0) {
        unsigned t = 0, c = 0;
#pragma nounroll
        for (int e = 0; e < NEXP; ++e) { const unsigned n = __hip_atomic_load(cnt + e, __ATOMIC_RELAXED, __HIP_MEMORY_SCOPE_AGENT); C.misc[MW_TP + e] = t; C.misc[MW_CP + e] = c; C.misc[MW_CN + e] = n; const unsigned nt = (n + 255u) >> 8;
            for (unsigned i = 0; i < nt; ++i) C.misc[MW_TEXP + t + i] = (unsigned)e; t += nt; c += n; }
        C.misc[MW_TP + 32] = t; C.misc[MW_CP + 32] = c;
    }
    __syncthreads();
    __builtin_amdgcn_sched_barrier(0);
}

DI void ln1_rows2(const Ctx& C, int l, int row0, int row1, bool two) {
    unsigned char* ws = C.ws; float* X = (float*)(ws + WS_X); const float* Y = (const float*)(ws + WS_Y); bf16_t* H = (bf16_t*)(ws + WS_H); bf16_t* HLO = (bf16_t*)(ws + WS_HLO);
    f32x4 xa[4], ya[4], xb[4], yb[4];
    ld_row(X + (size_t)row0 * DM, C.lane, xa); ld_row(Y + (size_t)row0 * DM, C.lane, ya);
    if (two) { ld_row(X + (size_t)row1 * DM, C.lane, xb); ld_row(Y + (size_t)row1 * DM, C.lane, yb); }
#pragma unroll
    for (int rr = 0; rr < 2; ++rr) {
        if (rr == 1 && !two) break;
        const int row = rr ? row1 : row0; const int m = modidx(row);
        f32x4 x[4], g1[4], h[4]; ld_row(modp(C, l, m, 2), C.lane, g1);
#pragma unroll
        for (int j = 0; j < 4; ++j) x[j] = (rr ? xb[j] : xa[j]) * DN_ALPHA + g1[j] * (rr ? yb[j] : ya[j]);
        layernorm_row(x, inp(C, I_LN1G) + l * DM, inp(C, I_LN1B) + l * DM, C.lane);
        st_row(X + (size_t)row * DM, C.lane, x);
        modulate_row(x, modp(C, l, m, 3), modp(C, l, m, 4), C.lane, h);
#pragma unroll
        for (int j = 0; j < 4; ++j) {
            u32x2 whi; whi.x = pk2(h[j][0], h[j][1]); whi.y = pk2(h[j][2], h[j][3]);
            u32x2 wlo; wlo.x = pk2(h[j][0] - bf_lo(whi.x), h[j][1] - bf_hi(whi.x)); wlo.y = pk2(h[j][2] - bf_lo(whi.y), h[j][3] - bf_hi(whi.y));
            *(u32x2*)(H + (size_t)row * DM + j * 256 + C.lane * 4) = whi; *(u32x2*)(HLO + (size_t)row * DM + j * 256 + C.lane * 4) = wlo;
        }
    }
}
DI void phase_ln1(int wave_s, unsigned char* ws0, int l) {
    const Ctx C = make_ctx(ws0, wave_s); unsigned char* ws = C.ws;
    LAS float* logits = (LAS float*)C.lds;
    LAS int* lsel = (LAS int*)(logits + 8 * 16 * 33);
    LAS int* lslot = lsel + 288;
    const int rbase = l == 3 ? NCTX : 0, nrows = NT - rbase;
    const int rpb = (nrows + C.G - 1) / C.G;
    const int brow0 = rbase + C.vcu * rpb; int bn = NT - brow0; if (bn > rpb) bn = rpb; if (bn < 0) bn = 0; if (bn > 72) bn = 72;
    for (int i = C.wave; i < bn; i += 16) ln1_rows2(C, l, brow0 + i, brow0 + i + 8, i + 8 < bn);
    asm volatile("s_waitcnt vmcnt(0)" ::: "memory");
    __syncthreads();
    const bf16_t* H = (const bf16_t*)(ws + WS_H); const bf16_t* HLO = (const bf16_t*)(ws + WS_HLO);
    const bf16_t* RWH = (const bf16_t*)(ws + WS_RWT) + (size_t)l * 2 * 32 * 1024; const bf16_t* RWL = RWH + 32 * 1024;
    const float* rb = inp(C, I_RB) + l * NEXP; float* gate = (float*)(ws + WS_GATE);
    const int ntile = (bn + 15) >> 4;
    if (C.wave < ntile) {
        const int fr = C.lane & 15, fq = C.lane >> 4;
        int ar = C.wave * 16 + fr; if (ar >= bn) ar = bn - 1;
        const bf16_t* ah_p = H + (size_t)(brow0 + ar) * DM + fq * 8; const bf16_t* al_p = HLO + (size_t)(brow0 + ar) * DM + fq * 8;
        const bf16_t* bh_p = RWH + (size_t)fr * DM + fq * 8; const bf16_t* bl_p = RWL + (size_t)fr * DM + fq * 8;
        f32x4 acc0 = {0.f, 0.f, 0.f, 0.f}, acc1 = {0.f, 0.f, 0.f, 0.f};
#pragma unroll 4
        for (int ks = 0; ks < 32; ++ks) {
            const bf16x8 ah = *(const bf16x8*)(ah_p + ks * 32), al = *(const bf16x8*)(al_p + ks * 32);
            const bf16x8 bh0 = *(const bf16x8*)(bh_p + ks * 32), bl0 = *(const bf16x8*)(bl_p + ks * 32);
            const bf16x8 bh1 = *(const bf16x8*)(bh_p + 16 * DM + ks * 32), bl1 = *(const bf16x8*)(bl_p + 16 * DM + ks * 32);
            acc0 = __builtin_amdgcn_mfma_f32_16x16x32_bf16(ah, bh0, acc0, 0, 0, 0); acc0 = __builtin_amdgcn_mfma_f32_16x16x32_bf16(al, bh0, acc0, 0, 0, 0); acc0 = __builtin_amdgcn_mfma_f32_16x16x32_bf16(ah, bl0, acc0, 0, 0, 0);
            acc1 = __builtin_amdgcn_mfma_f32_16x16x32_bf16(ah, bh1, acc1, 0, 0, 0); acc1 = __builtin_amdgcn_mfma_f32_16x16x32_bf16(al, bh1, acc1, 0, 0, 0); acc1 = __builtin_amdgcn_mfma_f32_16x16x32_bf16(ah, bl1, acc1, 0, 0, 0);
        }
        LAS float* lg = logits + C.wave * 16 * 33;
        const float rb0 = rb[fr], rb1 = rb[16 + fr];
#pragma unroll
        for (int i = 0; i < 4; ++i) { lg[(4 * fq + i) * 33 + fr] = acc0[i] + rb0; lg[(4 * fq + i) * 33 + 16 + fr] = acc1[i] + rb1; }
        asm volatile("s_waitcnt lgkmcnt(0)" ::: "memory");
        if (C.lane < 16 && C.wave * 16 + C.lane < bn) {
            const int r = C.lane, li = (C.wave * 16 + r) * 4, grow = brow0 + C.wave * 16 + r;
            float v0 = -INFINITY, v1 = -INFINITY, v2 = -INFINITY, v3 = -INFINITY; int i0 = 0, i1 = 0, i2 = 0, i3 = 0;
            for (int e = 0; e < 32; ++e) { const float x = lg[r * 33 + e];
                if (x > v3) { if (x > v2) { v3 = v2; i3 = i2; if (x > v1) { v2 = v1; i2 = i1; if (x > v0) { v1 = v0; i1 = i0; v0 = x; i0 = e; } else { v1 = x; i1 = e; } } else { v2 = x; i2 = e; } } else { v3 = x; i3 = e; } } }
            const float e1 = expf(v1 - v0), e2 = expf(v2 - v0), e3 = expf(v3 - v0), inv = 1.0f / (1.0f + e1 + e2 + e3);
            lsel[li] = i0; lsel[li + 1] = i1; lsel[li + 2] = i2; lsel[li + 3] = i3;
            lslot[li] = grow * 4; lslot[li + 1] = grow * 4 + 1; lslot[li + 2] = grow * 4 + 2; lslot[li + 3] = grow * 4 + 3;
            *(f32x4*)(gate + (size_t)grow * 4) = (f32x4){inv, e1 * inv, e2 * inv, e3 * inv};
        }
    }
    __syncthreads();
    if (C.tid < 32) {
        const int e = C.tid, nsel = bn * 4; int n = 0;
        for (int i = 0; i < nsel; ++i) n += (lsel[i] == e) ? 1 : 0;
        if (n) {
            unsigned* cnt = (unsigned*)(ws + WS_CTL) + CW_CNT + l * 32 + e;
            const unsigned base = __hip_atomic_fetch_add(cnt, (unsigned)n, __ATOMIC_RELAXED, __HIP_MEMORY_SCOPE_AGENT);
            int* list = (int*)(ws + WS_LIST) + (size_t)e * CAP + base; int j = 0;
            for (int i = 0; i < nsel; ++i) if (lsel[i] == e) { list[j] = lslot[i]; ++j; }
        }
    }
    __syncthreads();
}

DI void phase_ln2(int wave_s, unsigned char* ws0, int l) {
    const Ctx C = make_ctx(ws0, wave_s); unsigned char* ws = C.ws; float* X = (float*)(ws + WS_X); bf16_t* H = (bf16_t*)(ws + WS_H); const bf16_t* YS = (const bf16_t*)(ws + WS_YS);
    const int r0 = l == 3 ? NCTX : 0;
    for (int rowa = r0 + C.vcu * 8 + C.wave; rowa < NT; rowa += 2 * C.G * 8) {
        const int rowb = rowa + C.G * 8; const bool two = rowb < NT;
        f32x4 xs[2][4], ys[2][4];
#pragma unroll
        for (int rr = 0; rr < 2; ++rr) { if (rr == 1 && !two) break; const int row = rr ? rowb : rowa;
            ld_row(X + (size_t)row * DM, C.lane, xs[rr]);
            u32x2 w[4][4];
#pragma unroll
            for (int k = 0; k < 4; ++k)
#pragma unroll
                for (int j = 0; j < 4; ++j) w[k][j] = *(const u32x2*)(YS + ((size_t)row * 4 + k) * DM + j * 256 + C.lane * 4);
#pragma unroll
            for (int j = 0; j < 4; ++j) { ys[rr][j] = (f32x4){0.f, 0.f, 0.f, 0.f};
#pragma unroll
                for (int k = 0; k < 4; ++k) ys[rr][j] += (f32x4){bf_lo(w[k][j].x), bf_hi(w[k][j].x), bf_lo(w[k][j].y), bf_hi(w[k][j].y)}; } }
#pragma unroll
        for (int rr = 0; rr < 2; ++rr) { if (rr == 1 && !two) break; const int row = rr ? rowb : rowa; const int m = modidx(row);
            f32x4 x[4], g2[4]; ld_row(modp(C, l, m, 5), C.lane, g2);
#pragma unroll
            for (int j = 0; j < 4; ++j) x[j] = xs[rr][j] * DN_ALPHA + g2[j] * ys[rr][j];
            layernorm_row(x, inp(C, I_LN2G) + l * DM, inp(C, I_LN2B) + l * DM, C.lane);
            if (l == 3) { st_row((float*)inp(C, 36) + (size_t)(row - NCTX) * DM, C.lane, x); }
            else { st_row(X + (size_t)row * DM, C.lane, x); f32x4 h[4]; modulate_row(x, modp(C, l + 1, m, 0), modp(C, l + 1, m, 1), C.lane, h); st_row_bf(H + (size_t)row * DM, C.lane, h); } }
    }
}

DI void ph_gemm_bf16(int wave_s, unsigned char* ws0, const bf16_t* A, const bf16_t* Bt, int M, int N, int K, bf16_t* out, int ldc, int bias_idx) {
    const Ctx C = make_ctx(ws0, wave_s); const float* bias = bias_idx >= 0 ? inp(C, bias_idx) : nullptr;
    pg8::DenseOrder S; S.nN = N / 256; S.nunits = (M / 256) * S.nN; S.G = C.G; S.c = C.vcu; S.r0 = 0; S.step = 256u * (unsigned)K * 2u;
    pg8::EpiBf16 E{out, ldc, bias};
    pg8::gemm_phase<false, pg8::EpiBf16, pg8::DenseOrder>(C.lds, nullptr, nullptr, C.tid, K, pg8::make_rsrc(A), pg8::make_rsrc(Bt), S, E);
}
DI void ph_gemm_wo(int wave_s, unsigned char* ws0, const bf16_t* W, int r0, int bias_idx) {
    const Ctx C = make_ctx(ws0, wave_s); unsigned char* ws = C.ws; const float* bias = bias_idx >= 0 ? inp(C, bias_idx) : nullptr;
    pg8::DenseOrder S; S.nN = 4; S.nunits = ((NT - r0) / 256) * 4; S.G = C.G; S.c = C.vcu; S.r0 = r0; S.step = 256u * 1024u * 2u;
    pg8::EpiF32 E{(float*)(ws + WS_Y), DM, bias};
    pg8::gemm_phase<false, pg8::EpiF32, pg8::DenseOrder>(C.lds, nullptr, nullptr, C.tid, 1024, pg8::make_rsrc((const bf16_t*)(ws + WS_O) + (size_t)r0 * DM), pg8::make_rsrc(W), S, E);
}
DI void ph_moe1(int wave_s, unsigned char* ws0, int l) {
    const Ctx C = make_ctx(ws0, wave_s); unsigned char* ws = C.ws; const float* b_in = inp(C, I_BIN);
    moe_tables(C, l);
    pg8::MoeOrder<3, 2048> S; S.misc = C.misc; S.G = C.G; S.c = C.vcu;
    pg8::EpiSwiglu E{(bf16_t*)(ws + WS_ACT), b_in + (size_t)l * 32 * 2048};
    pg8::gemm_phase<true, pg8::EpiSwiglu, pg8::MoeOrder<3, 2048>>(C.lds, (LAS int*)(C.lds + MISC_OFF) + MW_IDX, (const int*)(ws + WS_LIST), C.tid, 1024,
        pg8::make_rsrc(ws + WS_H), pg8::make_rsrc(ws + WS_WIN + (size_t)l * 32 * 2048 * 1024 * 2), S, E);
}
DI void ph_moe2(int wave_s, unsigned char* ws0, int l) {
    const Ctx C = make_ctx(ws0, wave_s); unsigned char* ws = C.ws; const float* b_out = inp(C, I_BOUT);
    moe_tables(C, l);
    pg8::MoeOrder<2, 1024> S; S.misc = C.misc; S.G = C.G; S.c = C.vcu;
    pg8::EpiMoe2 E{(bf16_t*)(ws + WS_YS), b_out + (size_t)l * 32 * 1024, (const float*)(ws + WS_GATE), (const int*)(ws + WS_LIST)};
    pg8::gemm_phase<false, pg8::EpiMoe2, pg8::MoeOrder<2, 1024>>(C.lds, nullptr, nullptr, C.tid, 1024,
        pg8::make_rsrc(ws + WS_ACT), pg8::make_rsrc(ws + WS_WOUT + (size_t)l * 32 * 1024 * 1024 * 2), S, E);
}

constexpr int NPHASE = 2 + 11 * DEPTH;

__global__ void __launch_bounds__(512, 2) dit_fwd(Args args) {
    {
        LAS unsigned* mz = (LAS unsigned*)((LAS unsigned char*)lds_raw + MISC_OFF);
        for (int u = threadIdx.x; u < (LDS_BYTES - MISC_OFF) / 4; u += 512) mz[u] = 0u;
        __syncthreads();
        if (threadIdx.x == 0) {
#pragma unroll
            for (int i = 0; i < 36; ++i) { const unsigned long long p = (unsigned long long)args.in[i]; mz[MW_PTR + 2 * i] = (unsigned)p; mz[MW_PTR + 2 * i + 1] = (unsigned)(p >> 32); }
            const unsigned long long p = (unsigned long long)args.out; mz[MW_PTR + 72] = (unsigned)p; mz[MW_PTR + 73] = (unsigned)(p >> 32);
        }
        __syncthreads();
    }
    const int wave_s = __builtin_amdgcn_readfirstlane((int)threadIdx.x >> 6);
    const int lo = args.ph_lo, hi = args.ph_hi;
    unsigned char* ws = args.ws;
    XcdBarrier bar; bar.bar = (unsigned*)(ws + WS_CTL) + CW_BAR; bar.x = 0; bar.st = nullptr;
    if (hi - lo > 1) bar = xcd_barrier_post((unsigned*)(ws + WS_CTL) + CW_BAR, (volatile LAS unsigned*)((LAS unsigned char*)lds_raw + MISC_OFF) + 8);
#define IN(k) (lo <= (k) && (k) < hi)
#define SEAM(k) do { if ((k) + 1 < hi) xcd_barrier(bar); } while (0)
    bf16_t* wsm = (bf16_t*)(ws + WS_WSMALL);
    if (IN(0)) { PREP(0) phase_prologue(wave_s, ws); SEAM(0); }
    if (IN(1)) { phase_modh0(wave_s, ws); SEAM(1); }
    for (int l = 0; l < DEPTH; ++l) {
        const int pb = 2 + 11 * l;
        if (IN(pb + 0)) {
            const bf16_t* W = wsm + (l == 0 ? OFF_WQKV0 : l == 1 ? OFF_WQKV1 : l == 2 ? OFF_WA : OFF_WQKV3) / 2;
            const int N = l == 2 ? 768 : (l == 3 ? 3072 : 1536);
            PREP(1) ph_gemm_bf16(wave_s, ws, (const bf16_t*)(ws + WS_H), W, NT, N, 1024, (bf16_t*)(ws + WS_RAW), N, l == 0 ? (int)I_WIN_BQKV : -1);
            SEAM(pb + 0);
        }
        if (IN(pb + 1)) { phase_post(wave_s, ws, l); SEAM(pb + 1); }
        if (l == 2) {
            if (IN(pb + 2)) {
                PREP(1) for (int j = 0; j < 2; ++j)
                    ph_gemm_bf16(wave_s, ws, (const bf16_t*)(ws + (j == 0 ? WS_CQ : WS_CKV)), wsm + (j == 0 ? OFF_WQB : OFF_WKVB) / 2, NT, j == 0 ? 1536 : 2048, j == 0 ? 384 : 256,
                                 (bf16_t*)(ws + (j == 0 ? WS_Q2 : WS_KV2)), j == 0 ? 1536 : 2048, -1);
                SEAM(pb + 2);
            }
            if (IN(pb + 3)) { phase_postb(wave_s, ws); SEAM(pb + 3); }
        }
        if (IN(pb + 4)) {
            PREP(2) if (l == 0) ph_attn0(wave_s, ws); else if (l == 1) ph_attn1(wave_s, ws); else if (l == 2) ph_attn2(wave_s, ws); else ph_attn3(wave_s, ws);
            SEAM(pb + 4);
        }
        if (IN(pb + 5)) {
            const bf16_t* W = wsm + (l == 0 ? OFF_WO0 : l == 1 ? OFF_WO1 : l == 2 ? OFF_WO2 : OFF_WO3) / 2;
            PREP(3) ph_gemm_wo(wave_s, ws, W, l == 3 ? NCTX : 0, l == 0 ? (int)I_WIN_BO : -1);
            SEAM(pb + 5);
        }
        if (IN(pb + 6)) { phase_ln1(wave_s, ws, l); SEAM(pb + 6); }
        if (IN(pb + 8)) { PREP(5) ph_moe1(wave_s, ws, l); SEAM(pb + 8); }
        if (IN(pb + 9)) { PREP(6) ph_moe2(wave_s, ws, l); SEAM(pb + 9); }
        if (IN(pb + 10)) { phase_ln2(wave_s, ws, l); SEAM(pb + 10); }
    }
#undef IN
#undef SEAM
}

extern "C" void kernel_launch(void* const* d_in, const int* in_sizes, int n_in, void* d_out, int out_size, void* d_ws, size_t ws_size, hipStream_t stream) {
    static int grid = 0;
    if (grid == 0) {
        if (n_in != 36 || out_size != NB * SEQ * DM || ws_size < WS_END) { fprintf(stderr, "kernel_launch: unexpected shapes (n_in %d out %d ws %zu need %zu)\n", n_in, out_size, ws_size, (size_t)WS_END); grid = -1; return; }
        int dev = 0, cus = 0, per_cu = 0;
        if (hipGetDevice(&dev) != hipSuccess || hipDeviceGetAttribute(&cus, hipDeviceAttributeMultiprocessorCount, dev) != hipSuccess) { grid = -1; return; }
        if (hipFuncSetAttribute((const void*)dit_fwd, hipFuncAttributeMaxDynamicSharedMemorySize, LDS_BYTES) != hipSuccess) { fprintf(stderr, "kernel_launch: hipFuncSetAttribute failed\n"); grid = -1; return; }
        if (hipOccupancyMaxActiveBlocksPerMultiprocessor(&per_cu, (const void*)dit_fwd, 512, LDS_BYTES) != hipSuccess || per_cu < 1) fprintf(stderr, "kernel_launch: occupancy query says %d\n", per_cu);
        (void)hipGetLastError();
        grid = cus;
    }
    if (grid < 0) return;
    (void)hipMemsetAsync((char*)d_ws + WS_CTL, 0, CTL_BYTES, stream);
    Args a{};
    for (int i = 0; i < 36; ++i) a.in[i] = (const float*)d_in[i];
    a.out = (float*)d_out; a.ws = (unsigned char*)d_ws;
#if MK_PER_PHASE
    for (int ph = 0; ph < NPHASE; ++ph) {
        const int l = ph < 2 ? 0 : (ph - 2) / 11, s = ph < 2 ? 0 : (ph - 2) % 11;
        if (ph >= 2 && (s == 2 || s == 3) && l != 2) continue;
        a.ph_lo = ph; a.ph_hi = ph + 1;
        hipLaunchKernelGGL(dit_fwd, dim3(grid), dim3(512), LDS_BYTES, stream, a);
    }
#else
    a.ph_lo = 0; a.ph_hi = NPHASE;
    hipLaunchKernelGGL(dit_fwd, dim3(grid), dim3(512), LDS_BYTES, stream, a);
#endif
    const hipError_t le = hipPeekAtLastError();
    if (le != hipSuccess) fprintf(stderr, "kernel_launch: launch failed: %s\n", hipGetErrorName(le));
}
```

```cpp
#include <hip/hip_runtime.h>
#include <cstdio>
#include <cstdint>

#ifndef MK_PER_PHASE
#define MK_PER_PHASE 0
#endif

#ifndef PROBE_DOUBLE
#define PROBE_DOUBLE 0
#endif
#define PREP(bit) for (int rep_ = 0; rep_ < 1 + ((PROBE_DOUBLE >> (bit)) & 1); ++rep_)
#define DI __device__ __forceinline__
#define GAS __attribute__((address_space(1)))
#define LAS __attribute__((address_space(3)))
typedef unsigned short bf16_t;
typedef short bf16x8 __attribute__((ext_vector_type(8)));
typedef float f32x2 __attribute__((ext_vector_type(2)));
typedef float f32x4 __attribute__((ext_vector_type(4)));
typedef float f32x16 __attribute__((ext_vector_type(16)));
typedef unsigned u32x2 __attribute__((ext_vector_type(2)));
typedef unsigned u32x4 __attribute__((ext_vector_type(4)));
typedef __bf16 bfv2 __attribute__((ext_vector_type(2)));

DI unsigned pk2(float lo, float hi) { f32x2 v = {lo, hi}; return __builtin_bit_cast(unsigned, __builtin_convertvector(v, bfv2)); }
DI float bf_lo(unsigned w) { return __uint_as_float(w << 16); }
DI float bf_hi(unsigned w) { return __uint_as_float(w & 0xffff0000u); }
DI float bf2f(bf16_t h) { return __uint_as_float((unsigned)h << 16); }
DI bf16_t f2bf(float f) { return (bf16_t)(pk2(f, 0.f) & 0xffffu); }
DI float shx(float v, int m, int lane) { return __int_as_float(__builtin_amdgcn_ds_bpermute((lane ^ m) << 2, __float_as_int(v))); }
DI float wave_sum(float v, int lane) {
#pragma unroll
    for (int o = 1; o < 64; o <<= 1) v += shx(v, o, lane);
    return v;
}

constexpr int NB = 8, SEQ = 2048, CTXL = 256, DM = 1024, DEPTH = 4;
constexpr int NCTX = NB * CTXL;
constexpr int NT = NCTX + NB * SEQ;
constexpr int NKEY = CTXL + SEQ;
constexpr int NEXP = 32, FF = 1024, CAP = NT;
constexpr int MAXT = 320;
constexpr float DN_ALPHA = 1.681792830507429f;
constexpr float LN_EPS = 1e-5f, NORM_EPS = 1e-6f;
constexpr float LOG2E = 1.4426950408889634f;
constexpr float ATT_THR = 8.0f;

constexpr size_t MiB = 1u << 20;
constexpr size_t WS_CTL = 0, CTL_BYTES = 1 * MiB;
constexpr size_t WS_MOD = 1 * MiB;
constexpr size_t WS_ROPE = 2 * MiB;
constexpr size_t WS_WSMALL = 4 * MiB;
constexpr size_t OFF_WQKV0 = 0, OFF_WO0 = 3 * MiB, OFF_WQKV1 = 5 * MiB, OFF_WO1 = 8 * MiB, OFF_WA = 10 * MiB, OFF_WQB = 12 * MiB,
                 OFF_WKVB = 14 * MiB, OFF_WO2 = 15 * MiB, OFF_WQKV3 = 17 * MiB, OFF_WO3 = 23 * MiB;
constexpr size_t WS_WIN = 32 * MiB;
constexpr size_t WS_WOUT = WS_WIN + 512 * MiB;
constexpr size_t WS_X = WS_WOUT + 256 * MiB;
constexpr size_t WS_H = WS_X + 72 * MiB;
constexpr size_t WS_RAW = WS_H + 36 * MiB;
constexpr size_t WS_CQ = WS_RAW + 108 * MiB;
constexpr size_t WS_CKV = WS_CQ + 14 * MiB;
constexpr size_t WS_KPE = WS_CKV + 9 * MiB;
constexpr size_t WS_Q2 = WS_KPE + 2 * MiB;
constexpr size_t WS_KV2 = WS_Q2 + 54 * MiB;
constexpr size_t WS_KF = WS_KV2 + 72 * MiB;
constexpr size_t WS_VT = WS_KF + 54 * MiB;
constexpr size_t WS_O = WS_VT + 36 * MiB;
constexpr size_t WS_Y = WS_O + 36 * MiB;
constexpr size_t WS_LIST = WS_Y + 72 * MiB;
constexpr size_t WS_GATE = WS_LIST + 3 * MiB;
constexpr size_t WS_POS = WS_GATE + 1 * MiB;
constexpr size_t WS_GS = WS_POS + 1 * MiB;
constexpr size_t WS_HS = WS_GS + 1 * MiB;
constexpr size_t WS_ACT = WS_HS + 160 * MiB;
constexpr size_t WS_YS = WS_ACT + 160 * MiB;
constexpr size_t WS_HLO = WS_YS + 160 * MiB;
constexpr size_t WS_RWT = WS_HLO + 36 * MiB;
constexpr size_t WS_END = WS_RWT + 1 * MiB;
constexpr int CW_CNT = 64;
constexpr int CW_BAR = 4096;

constexpr int RT16 = 0, RT32 = RT16 + 2 * 2048 * 2 * 16, RT8 = RT32 + 2 * 2048 * 2 * 32, RT_END = RT8 + 2 * 2048 * 2 * 8;

constexpr int RING_BYTES = 131072;
constexpr int MISC_OFF = RING_BYTES;
constexpr int LDS_BYTES = 147456;
constexpr int MW_TP = 64, MW_CP = 128, MW_TEXP = 192, MW_PTR = 512, MW_CN = 600, MW_IDX = 1024;

namespace pg8 {
constexpr int BM = 256, BK = 64, HALF = 128, HTB = HALF * BK * 2, STAGE_BYTES = 8 * HTB;
__host__ __device__ __forceinline__ int lds_byte(int r, int c) { const int st = (r >> 4) * 2 + (c >> 5), rr = r & 15, cc = c & 31, ob = rr * 64 + cc * 2; return st * 1024 + (ob ^ (((ob >> 9) & 1) << 5)); }
__host__ __device__ __forceinline__ void stage_rc(int b, int& R, int& C) { const int st = b / 1024, sb = b % 1024, swz = sb ^ (((sb >> 9) & 1) << 5); R = (st >> 1) * 16 + swz / 64; C = (st & 1) * 32 + (swz % 64) / 2; }
__host__ __device__ __forceinline__ int perm32(int rho) { const int n = rho >> 4, i = rho & 15; return 8 * (i >> 2) + 4 * n + (i & 3); }

struct Unit { unsigned ao, bo; int r0, c0, aux; unsigned io; int nvalid; };
typedef __amdgpu_buffer_rsrc_t rsrc_t;
DI rsrc_t make_rsrc(const void* base) { return __builtin_amdgcn_make_buffer_rsrc((void*)base, 0, 0x7fffffff, 0x00020000); }

template <bool GATHER, class Epi, class Sched>
__device__ __forceinline__ void gemm_phase(LAS unsigned char* lds, LAS int* idxbuf, const int* list, const int tid, const int K, const rsrc_t rsA, const rsrc_t rsB, const Sched& S, const Epi& E) {
    const int wid = __builtin_amdgcn_readfirstlane(tid >> 6), lane = tid & 63, wr = wid >> 2, wc = wid & 3, fr = lane & 15, fq = lane >> 4;
    const int nt = K / BK;
    unsigned voffA[2], voffB[2], offc[2][2];
#pragma unroll
    for (int i = 0; i < 2; ++i) { int R, C; stage_rc(tid * 16 + i * 8192, R, C); const int Rb = Epi::PERM ? ((R & ~31) + perm32(R & 31)) : R;
        voffA[i] = (unsigned)(R * K + C) * 2u; voffB[i] = (unsigned)(Rb * K + C) * 2u; offc[0][i] = 0u; offc[1][i] = 0u; }
    const unsigned hstep = (unsigned)(HALF * K * 2);
    const unsigned ldsw = (unsigned)wid * 1024u;
    const int aoff = lds_byte(wr * 64 + fr, fq * 8), boff = lds_byte(wc * 32 + fr, fq * 8);
#define PG8_SA(b, h) (((b) * 2 + (h)) * HTB)
#define PG8_SB(b, h) ((4 + (b) * 2 + (h)) * HTB)
#define PG8_STAGE(rs, bufoff, soff, voff) do { _Pragma("unroll") for (int _i = 0; _i < 2; ++_i) \
        __builtin_amdgcn_raw_ptr_buffer_load_lds((rs), (LAS void*)(lds + (bufoff) + ldsw + _i * 8192), 16, (voff)[_i], (soff), 0, 0); } while (0)
#define PG8_STAGEA(b, h, ub, kt) do { if constexpr (GATHER) PG8_STAGE(rsA, PG8_SA(b, h), (unsigned)(kt) * 128u, offc[h]); else PG8_STAGE(rsA, PG8_SA(b, h), (ub) + (unsigned)(h) * hstep + (unsigned)(kt) * 128u, voffA); } while (0)
#define PG8_STAGEB(b, h, ub, kt) PG8_STAGE(rsB, PG8_SB(b, h), (ub) + (unsigned)(h) * hstep + (unsigned)(kt) * 128u, voffB)
#define PG8_LDA(dst, b, h) do { _Pragma("unroll") for (int m = 0; m < 4; ++m) _Pragma("unroll") for (int k = 0; k < 2; ++k) dst[m][k] = *(const LAS bf16x8*)(lds + PG8_SA(b, h) + aoff + m * 2048 + k * 1024); } while (0)
#define PG8_LDB(dst, b, h) do { _Pragma("unroll") for (int n = 0; n < 2; ++n) _Pragma("unroll") for (int k = 0; k < 2; ++k) dst[n][k] = *(const LAS bf16x8*)(lds + PG8_SB(b, h) + boff + n * 2048 + k * 1024); } while (0)
#define PG8_MMA(ai, bj, At, Bt) do { __builtin_amdgcn_s_setprio(1); _Pragma("unroll") for (int m = 0; m < 4; ++m) _Pragma("unroll") for (int n = 0; n < 2; ++n) _Pragma("unroll") for (int k = 0; k < 2; ++k) \
        acc[ai][bj][m][n] = __builtin_amdgcn_mfma_f32_16x16x32_bf16(Bt[n][k], At[m][k], acc[ai][bj][m][n], 0, 0, 0); __builtin_amdgcn_s_setprio(0); } while (0)
#define PG8_WAIT_V(n) asm volatile("s_waitcnt vmcnt(" #n ")" ::: "memory")
#define PG8_WAIT_L(n) asm volatile("s_waitcnt lgkmcnt(" #n ")" ::: "memory")
#define PG8_BAR __builtin_amdgcn_s_barrier()
#define PG8_SCHED __builtin_amdgcn_sched_barrier(0)
    Unit cur, nxt; int ui = 0;
    if (!S.next(0, cur)) return;
    if constexpr (GATHER) {
#pragma unroll
        for (int h = 0; h < 2; ++h)
#pragma unroll
            for (int i = 0; i < 2; ++i) { int R, C; stage_rc(tid * 16 + i * 8192, R, C); const int r = h * HALF + R; const int sl = r < cur.nvalid ? list[cur.io + r] : 0; offc[h][i] = (unsigned)(sl >> 2) * (unsigned)(K * 2) + (unsigned)C * 2u; }
    }
    f32x4 acc[2][2][4][2];
#pragma unroll
    for (int a = 0; a < 2; ++a)
#pragma unroll
        for (int b = 0; b < 2; ++b)
#pragma unroll
            for (int m = 0; m < 4; ++m)
#pragma unroll
                for (int n = 0; n < 2; ++n) acc[a][b][m][n] = (f32x4){0.f, 0.f, 0.f, 0.f};
    bf16x8 At[4][2], B0[2][2], B1[2][2];
    unsigned cA = cur.ao, cB = cur.bo;
    PG8_STAGEB(0, 0, cB, 0); PG8_STAGEB(0, 1, cB, 0); PG8_STAGEA(0, 0, cA, 0); PG8_STAGEA(0, 1, cA, 0);
    if (wr == 1) PG8_BAR;
    PG8_WAIT_V(2); PG8_BAR;
    PG8_STAGEB(1, 0, cB, 1); PG8_STAGEA(1, 0, cA, 1); PG8_STAGEB(1, 1, cB, 1);
    PG8_WAIT_V(6); PG8_BAR;
    for (;;) {
        const bool has_next = S.next(ui + 1, nxt);
        const unsigned nA = has_next ? nxt.ao : cA, nB = has_next ? nxt.bo : cB;
        if constexpr (GATHER) { if (has_next && wid == 0) __builtin_amdgcn_global_load_lds((const unsigned*)(list + nxt.io + lane * 4), (LAS unsigned*)idxbuf, 16, 0, 0); }
        for (int t = 0; t < nt; t += 2) {
            const bool last = (t == nt - 2);
            const unsigned a2 = last ? nA : cA, b2 = last ? nB : cB; const int kt2 = last ? 0 : t + 2;
            PG8_LDB(B0, 0, 0); PG8_LDB(B1, 0, 1); PG8_SCHED; PG8_LDA(At, 0, 0); PG8_STAGEA(1, 1, cA, t + 1);
            PG8_WAIT_V(8); PG8_WAIT_L(0); PG8_BAR; PG8_MMA(0, 0, At, B0); PG8_MMA(0, 1, At, B1); PG8_BAR; PG8_SCHED;
            if constexpr (GATHER) { if (last && has_next) {
#pragma unroll
                for (int h = 0; h < 2; ++h)
#pragma unroll
                    for (int i = 0; i < 2; ++i) { int R, C; stage_rc(tid * 16 + i * 8192, R, C); const int r = h * HALF + R; const int sl = r < nxt.nvalid ? idxbuf[r] : 0; offc[h][i] = (unsigned)(sl >> 2) * (unsigned)(K * 2) + (unsigned)C * 2u; }
            } }
            PG8_LDA(At, 0, 1); PG8_STAGEB(0, 0, b2, kt2); PG8_STAGEB(0, 1, b2, kt2); PG8_STAGEA(0, 0, a2, kt2);
            PG8_WAIT_V(8); PG8_WAIT_L(0); PG8_BAR; PG8_MMA(1, 0, At, B0); PG8_MMA(1, 1, At, B1); PG8_BAR; PG8_SCHED;
            PG8_LDB(B0, 1, 0); PG8_LDB(B1, 1, 1); PG8_SCHED; PG8_LDA(At, 1, 0); PG8_STAGEA(0, 1, a2, kt2);
            PG8_WAIT_V(8); PG8_WAIT_L(0); PG8_BAR; PG8_MMA(0, 0, At, B0); PG8_MMA(0, 1, At, B1); PG8_BAR; PG8_SCHED;
            PG8_LDA(At, 1, 1); PG8_STAGEB(1, 0, b2, kt2 + 1); PG8_STAGEB(1, 1, b2, kt2 + 1); PG8_STAGEA(1, 0, a2, kt2 + 1);
            PG8_WAIT_V(8); PG8_WAIT_L(0); PG8_BAR; PG8_MMA(1, 0, At, B0); PG8_MMA(1, 1, At, B1); PG8_BAR; PG8_SCHED;
        }
        if (wr == 0) PG8_BAR;
        E(acc, cur, wr, wc, fr, fq);
        if (!has_next) break;
#pragma unroll
        for (int a = 0; a < 2; ++a)
#pragma unroll
            for (int b = 0; b < 2; ++b)
#pragma unroll
                for (int m = 0; m < 4; ++m)
#pragma unroll
                    for (int n = 0; n < 2; ++n) acc[a][b][m][n] = (f32x4){0.f, 0.f, 0.f, 0.f};
        cur = nxt; cA = nA; cB = nB; ++ui;
        if (wr == 1) PG8_BAR;
    }
    PG8_WAIT_V(0);
    PG8_BAR;
#undef PG8_SA
#undef PG8_SB
#undef PG8_STAGE
#undef PG8_STAGEA
#undef PG8_STAGEB
#undef PG8_LDA
#undef PG8_LDB
#undef PG8_MMA
#undef PG8_WAIT_V
#undef PG8_WAIT_L
#undef PG8_BAR
#undef PG8_SCHED
}

struct EpiBf16 {
    static constexpr bool PERM = true;
    bf16_t* O; int ldc; const float* bias;
    DI void operator()(const f32x4 (&acc)[2][2][4][2], const Unit& u, int wr, int wc, int fr, int fq) const {
        const int row0 = u.r0 + wr * 64 + fr, col0 = u.c0 + wc * 32 + 8 * fq;
        f32x4 bv[2][2];
#pragma unroll
        for (int bj = 0; bj < 2; ++bj)
#pragma unroll
            for (int n = 0; n < 2; ++n) bv[bj][n] = bias ? *(const f32x4*)(bias + col0 + bj * HALF + 4 * n) : (f32x4){0.f, 0.f, 0.f, 0.f};
#pragma unroll
        for (int ai = 0; ai < 2; ++ai)
#pragma unroll
            for (int m = 0; m < 4; ++m) { bf16_t* rowp = O + (size_t)(row0 + ai * HALF + m * 16) * ldc + col0;
#pragma unroll
                for (int bj = 0; bj < 2; ++bj) { const f32x4 v0 = acc[ai][bj][m][0] + bv[bj][0], v1 = acc[ai][bj][m][1] + bv[bj][1];
                    u32x4 w; w.x = pk2(v0[0], v0[1]); w.y = pk2(v0[2], v0[3]); w.z = pk2(v1[0], v1[1]); w.w = pk2(v1[2], v1[3]);
                    *(u32x4*)(rowp + bj * HALF) = w; } }
    }
};
struct EpiF32 {
    static constexpr bool PERM = false;
    float* Y; int ldc; const float* bias;
    DI void operator()(const f32x4 (&acc)[2][2][4][2], const Unit& u, int wr, int wc, int fr, int fq) const {
        const int row0 = u.r0 + wr * 64 + fr, col0 = u.c0 + wc * 32 + 4 * fq;
        f32x4 bv[2][2];
#pragma unroll
        for (int bj = 0; bj < 2; ++bj)
#pragma unroll
            for (int n = 0; n < 2; ++n) bv[bj][n] = bias ? *(const f32x4*)(bias + col0 + bj * HALF + 16 * n) : (f32x4){0.f, 0.f, 0.f, 0.f};
#pragma unroll
        for (int ai = 0; ai < 2; ++ai)
#pragma unroll
            for (int m = 0; m < 4; ++m) { float* rowp = Y + (size_t)(row0 + ai * HALF + m * 16) * ldc + col0;
#pragma unroll
                for (int bj = 0; bj < 2; ++bj)
#pragma unroll
                    for (int n = 0; n < 2; ++n) *(f32x4*)(rowp + bj * HALF + 16 * n) = acc[ai][bj][m][n] + bv[bj][n]; }
    }
};
DI float swiglu1(float g, float lin) {
    g = fminf(g, 7.0f); lin = fminf(fmaxf(lin, -7.0f), 7.0f);
    const float s = __builtin_amdgcn_rcpf(1.0f + __builtin_amdgcn_exp2f(-1.702f * LOG2E * g));
    return g * s * (lin + 1.0f);
}
struct EpiSwiglu {
    static constexpr bool PERM = true;
    bf16_t* O; const float* bias;
    DI void operator()(const f32x4 (&acc)[2][2][4][2], const Unit& u, int wr, int wc, int fr, int fq) const {
        const int row0 = u.r0 + wr * 64 + fr, col0 = u.c0 + wc * 32 + 8 * fq;
        const float* bp = bias + (size_t)u.aux * (2 * FF) + col0;
        f32x4 bv[2][2];
#pragma unroll
        for (int bj = 0; bj < 2; ++bj)
#pragma unroll
            for (int n = 0; n < 2; ++n) bv[bj][n] = *(const f32x4*)(bp + bj * HALF + 4 * n);
#pragma unroll
        for (int ai = 0; ai < 2; ++ai)
#pragma unroll
            for (int m = 0; m < 4; ++m) { bf16_t* rowp = O + (size_t)(row0 + ai * HALF + m * 16) * FF + (col0 >> 1);
#pragma unroll
                for (int bj = 0; bj < 2; ++bj) { const f32x4 v0 = acc[ai][bj][m][0] + bv[bj][0], v1 = acc[ai][bj][m][1] + bv[bj][1];
                    u32x2 w; w.x = pk2(swiglu1(v0[0], v0[1]), swiglu1(v0[2], v0[3])); w.y = pk2(swiglu1(v1[0], v1[1]), swiglu1(v1[2], v1[3]));
                    *(u32x2*)(rowp + bj * (HALF / 2)) = w; } }
    }
};
struct EpiMoe2 {
    static constexpr bool PERM = true;
    bf16_t* O; const float* bias; const float* gate; const int* list;
    DI void operator()(const f32x4 (&acc)[2][2][4][2], const Unit& u, int wr, int wc, int fr, int fq) const {
        const int rl0 = wr * 64 + fr, col0 = u.c0 + wc * 32 + 8 * fq;
        const float* bp = bias + (size_t)u.aux * DM + col0;
        f32x4 bv[2][2];
#pragma unroll
        for (int bj = 0; bj < 2; ++bj)
#pragma unroll
            for (int n = 0; n < 2; ++n) bv[bj][n] = *(const f32x4*)(bp + bj * HALF + 4 * n);
#pragma unroll
        for (int ai = 0; ai < 2; ++ai)
#pragma unroll
            for (int m = 0; m < 4; ++m) { const int rl = rl0 + ai * HALF + m * 16;
                if (rl < u.nvalid) { const int slot = list[u.io + rl]; const float g = gate[slot]; bf16_t* rowp = O + (size_t)slot * DM + col0;
#pragma unroll
                    for (int bj = 0; bj < 2; ++bj) { const f32x4 v0 = (acc[ai][bj][m][0] + bv[bj][0]) * g, v1 = (acc[ai][bj][m][1] + bv[bj][1]) * g;
                        u32x4 w; w.x = pk2(v0[0], v0[1]); w.y = pk2(v0[2], v0[3]); w.z = pk2(v1[0], v1[1]); w.w = pk2(v1[2], v1[3]);
                        *(u32x4*)(rowp + bj * HALF) = w; } } }
    }
};
struct DenseOrder {
    int nN, nunits, G, c, r0; unsigned step;
    DI bool next(int i, Unit& u) const {
        const int L = i * G + c; if (L >= nunits) return false;
        const int pm = L / nN, pn = L - pm * nN;
        u.ao = (unsigned)pm * step; u.bo = (unsigned)pn * step; u.r0 = r0 + pm * BM; u.c0 = pn * BM; u.aux = 0; u.io = 0u; u.nvalid = 256; return true;
    }
};
template <int LGN, int BROWS>
struct MoeOrder {
    const volatile LAS unsigned* misc; int G, c;
    DI bool next(int i, Unit& u) const {
        const int L = i * G + c; const int ntile = __builtin_amdgcn_readfirstlane((int)misc[MW_TP + 32]);
        if (L >= (ntile << LGN)) return false;
        const int T = L >> LGN, pn = L & ((1 << LGN) - 1); const int e = __builtin_amdgcn_readfirstlane((int)misc[MW_TEXP + T]);
        const int mt = T - __builtin_amdgcn_readfirstlane((int)misc[MW_TP + e]); int nv = __builtin_amdgcn_readfirstlane((int)misc[MW_CN + e]) - mt * 256; if (nv > 256) nv = 256;
        u.ao = (unsigned)T * (256u * 1024u * 2u); u.bo = (unsigned)(e * BROWS + pn * 256) * (1024u * 2u); u.r0 = T * BM; u.c0 = pn * BM; u.aux = e;
        u.io = (unsigned)(e * CAP + mt * 256); u.nvalid = nv; return true;
    }
};
}

#define XB_TMO      128
#define XB_XCNT(j)  (256  + 64 * (j))
#define XB_XSUB(j)  (1280 + 64 * (j))
#define XB_XGEN(j)  (2304 + 64 * (j))
#define XB_TOP      3328
#define XB_TOPGEN   3392
#define XCD_BAR_WORDS 3456
#define XB_SPIN_CAP (1u << 18)
DI unsigned xb_ld(unsigned* p)              { return __hip_atomic_load(p, __ATOMIC_RELAXED, __HIP_MEMORY_SCOPE_AGENT); }
DI unsigned xb_add(unsigned* p, unsigned v) { return __hip_atomic_fetch_add(p, v, __ATOMIC_RELAXED, __HIP_MEMORY_SCOPE_AGENT); }
DI unsigned xb_xcc_id() { return (unsigned)__builtin_amdgcn_s_getreg((3 << 11) | 20) & 0xFu; }
#define XB_SPIN(cond, bar) do { unsigned _sp = 0; while (cond) { __builtin_amdgcn_s_sleep(1); \
    if ((++_sp & 255u) == 0u) { if (xb_ld(&(bar)[XB_TMO])) break; if (_sp > XB_SPIN_CAP) { atomicAdd(&(bar)[XB_TMO], 1u); break; } } } } while (0)
struct XcdBarrier { unsigned* bar; unsigned x; volatile LAS unsigned* st; };
DI XcdBarrier xcd_barrier_post(unsigned* bar, volatile LAS unsigned* st) {
    XcdBarrier b; b.bar = bar; b.x = xb_xcc_id(); b.st = st;
    if (threadIdx.x == 0) (void)xb_add(&bar[XB_XCNT(b.x)], 1u);
    return b;
}
DI void xcd_barrier_complete(unsigned* bar, unsigned x, unsigned& nloc, unsigned& nx) {
    const unsigned G = gridDim.x * gridDim.y * gridDim.z;
    unsigned sum, cnt, mine, sp = 0u;
    for (;;) {
        sum = 0u; cnt = 0u; mine = 0u;
#pragma unroll
        for (unsigned j = 0; j < 16; ++j) { const unsigned c = xb_ld(&bar[XB_XCNT(j)]); sum += c; cnt += (c > 0u) ? 1u : 0u; mine = (j == x) ? c : mine; }
        if (sum == G) break;
        __builtin_amdgcn_s_sleep(1);
        if ((++sp & 255u) == 0u) { if (xb_ld(&bar[XB_TMO])) break; if (sp > XB_SPIN_CAP) { atomicAdd(&bar[XB_TMO], 1u); break; } }
    }
    nloc = mine > 0u ? mine : 1u; nx = cnt > 0u ? cnt : 1u;
}
DI void xcd_barrier(const XcdBarrier& b) {
    asm volatile("s_waitcnt vmcnt(0)" ::: "memory");
    __syncthreads();
    if (threadIdx.x == 0) {
        unsigned* bar = b.bar;
        __builtin_amdgcn_s_waitcnt(0);
        unsigned nloc = b.st[0], nx = b.st[1];
        if (nloc == 0u) { xcd_barrier_complete(bar, b.x, nloc, nx); b.st[0] = nloc; b.st[1] = nx; }
        const unsigned old = xb_add(&bar[XB_XSUB(b.x)], 1u);
        const unsigned gen = old / nloc;
        if (old + 1u == (gen + 1u) * nloc) {
            __builtin_amdgcn_fence(__ATOMIC_RELEASE, "agent");
            asm volatile("s_waitcnt vmcnt(0)" ::: "memory");
            const unsigned og = xb_add(&bar[XB_TOP], 1u);
            const unsigned tg = og / nx;
            if (og + 1u == (tg + 1u) * nx) xb_add(&bar[XB_TOPGEN], 1u);
            else XB_SPIN(xb_ld(&bar[XB_TOPGEN]) == tg, bar);
            __builtin_amdgcn_fence(__ATOMIC_ACQUIRE, "agent");
            xb_add(&bar[XB_XGEN(b.x)], 1u);
            asm volatile("s_waitcnt vmcnt(0)" ::: "memory");
        } else {
            XB_SPIN(xb_ld(&bar[XB_XGEN(b.x)]) == gen, bar);
            __builtin_amdgcn_fence(__ATOMIC_ACQUIRE, "agent");
            asm volatile("s_waitcnt vmcnt(0)" ::: "memory");
        }
    }
    __syncthreads();
}

struct Args { const float* in[36]; float* out; unsigned char* ws; int ph_lo, ph_hi; };
enum { I_X = 0, I_C, I_CTX, I_CCTX, I_ADAW, I_ADAB, I_LN1G, I_LN1B, I_LN2G, I_LN2B, I_WIN_WQKV, I_WIN_BQKV, I_WIN_SINK, I_WIN_WO, I_WIN_BO,
       I_AXG_WQKV, I_AXG_QN, I_AXG_KN, I_AXG_WO, I_MLA_WQA, I_MLA_QN, I_MLA_WQB, I_MLA_WKVA, I_MLA_KVN, I_MLA_WKVB, I_MLA_WO,
       I_DIFF_WQKV, I_DIFF_LAM, I_DIFF_SUBLN, I_DIFF_WO, I_RW, I_RB, I_WIN, I_BIN, I_WOUT, I_BOUT };

struct Ctx {
    LAS unsigned char* lds; volatile LAS unsigned* misc; unsigned char* ws; int tid, lane, wave, vcu, G;
};
extern __shared__ __attribute__((aligned(16))) unsigned char lds_raw[];
DI Ctx make_ctx(unsigned char* ws, int wave_s) {
    int bx = blockIdx.x, G = gridDim.x;
    asm volatile("" : "+s"(bx), "+s"(G), "+s"(wave_s)); asm volatile("" : "+s"(ws));
    unsigned z = 0u; asm volatile("" : "+v"(z));
    const int tid = wave_s * 64 + (int)__builtin_amdgcn_mbcnt_hi(~0u, __builtin_amdgcn_mbcnt_lo(~0u, z));
    Ctx C; C.lds = (LAS unsigned char*)lds_raw; C.misc = (volatile LAS unsigned*)(C.lds + MISC_OFF); C.ws = ws;
    C.tid = tid; C.lane = tid & 63; C.wave = wave_s;
    C.G = G; C.vcu = (G % 8 == 0) ? (bx % 8) * (G / 8) + bx / 8 : bx;
    return C;
}
DI const float* inp(const Ctx& C, int i) {
    const unsigned lo = __builtin_amdgcn_readfirstlane(C.misc[MW_PTR + 2 * i]), hi = __builtin_amdgcn_readfirstlane(C.misc[MW_PTR + 2 * i + 1]);
    return (const float*)(((unsigned long long)hi << 32) | lo);
}
DI int modidx(int row) { return row < NCTX ? 8 : ((row - NCTX) >> 11); }
DI const float* modp(const Ctx& C, int l, int m, int part) { return (const float*)(C.ws + WS_MOD) + ((size_t)(l * 9 + m) * 6 + part) * DM; }

DI void sincos_acc(float ang, float& s, float& c) {
    const double x = (double)ang; const int q = (int)__builtin_rint(x * 0.6366197723675814); const double rd = x - (double)q * 1.5707963267948966;
    const float r = (float)rd, r2 = r * r;
    const float sp = r + r * r2 * (-1.6666654611e-1f + r2 * (8.3321608736e-3f + r2 * (-1.9515295891e-4f)));
    const float cp = 1.0f - 0.5f * r2 + r2 * r2 * (4.166664568298827e-2f + r2 * (-1.388731625493765e-3f + r2 * 2.443315711809948e-5f));
    switch (q & 3) { case 0: s = sp; c = cp; break; case 1: s = cp; c = -sp; break; case 2: s = -sp; c = -cp; break; default: s = -cp; c = sp; break; }
}
DI void cvt_item(const float* src, int N, bf16_t* dst, int Kd, int row_off, int k0, int n0, int lane) {
    const int n = n0 + lane; const bool valid = n < N;
    const float* sp = src + (size_t)k0 * N + (valid ? n : 0);
    float v[64];
#pragma unroll
    for (int i = 0; i < 64; ++i) v[i] = __builtin_nontemporal_load(sp + (size_t)i * N);
    if (valid) {
        bf16_t* dp = dst + (size_t)(row_off + n) * Kd + k0;
#pragma unroll
        for (int j = 0; j < 8; ++j) { u32x4 w; w.x = pk2(v[8 * j], v[8 * j + 1]); w.y = pk2(v[8 * j + 2], v[8 * j + 3]); w.z = pk2(v[8 * j + 4], v[8 * j + 5]); w.w = pk2(v[8 * j + 6], v[8 * j + 7]);
            *(u32x4*)(dp + 8 * j) = w; }
    }
}
DI bool cvt_mat(int& r, const float* src, int K, int N, bf16_t* dst, int row_off, int lane) {
    const int nb = (N + 63) >> 6, items = (K >> 6) * nb;
    if (r < items) { const int kb = r / nb, nbk = r - kb * nb; cvt_item(src, N, dst, K, row_off, kb * 64, nbk * 64, lane); return true; }
    r -= items; return false;
}
DI void phase_prologue(int wave_s, unsigned char* ws0) {
    const Ctx C = make_ctx(ws0, wave_s); unsigned char* ws = C.ws;
    if (C.vcu < 384) {
        LAS float* sv = (LAS float*)C.lds; LAS float* part = sv + 9 * 1024;
        for (int i = C.tid; i < 9 * 1024; i += 512) { const int m = i >> 10, k = i & 1023; const float c = m < 8 ? inp(C, I_C)[m * 1024 + k] : inp(C, I_CCTX)[k]; sv[i] = c / (1.0f + expf(-c)); }
        __syncthreads();
        for (int it = C.vcu; it < 384; it += C.G) {
            const int l = it / 96, cg = it - l * 96;
            const float* w = inp(C, I_ADAW) + (size_t)l * 1024 * 6144 + cg * 64 + C.lane;
            float acc[9];
#pragma unroll
            for (int m = 0; m < 9; ++m) acc[m] = 0.f;
#pragma unroll 32
            for (int kk = 0; kk < 128; ++kk) { const int k = C.wave * 128 + kk; const float wv = w[(size_t)k * 6144];
#pragma unroll
                for (int m = 0; m < 9; ++m) acc[m] += sv[m * 1024 + k] * wv; }
#pragma unroll
            for (int m = 0; m < 9; ++m) part[(C.wave * 9 + m) * 64 + C.lane] = acc[m];
            __syncthreads();
            for (int i = C.tid; i < 576; i += 512) { const int m = i >> 6, j = i & 63; float s = 0.f;
#pragma unroll
                for (int w8 = 0; w8 < 8; ++w8) s += part[(w8 * 9 + m) * 64 + j];
                const int col = cg * 64 + j; ((float*)(ws + WS_MOD))[(size_t)(l * 9 + m) * 6144 + col] = s + inp(C, I_ADAB)[l * 6144 + col]; }
            __syncthreads();
        }
    }
    {
        float* rt = (float*)(ws + WS_ROPE);
        const int total = 2048 * 2 * (16 + 32 + 8);
        for (int i = C.vcu * 512 + C.tid; i < total; i += C.G * 512) {
            int nf, base, idx = i;
            if (idx < 2048 * 2 * 16) { nf = 16; base = RT16; } else if ((idx -= 2048 * 2 * 16) < 2048 * 2 * 32) { nf = 32; base = RT32; } else { idx -= 2048 * 2 * 32; nf = 8; base = RT8; }
            const int f = idx % nf, half = (idx / nf) & 1, pos = idx / (2 * nf);
            const float pv = (float)(half == 0 ? (pos >> 6) : (pos & 63));
            const float inv = exp2f(-((float)f / (float)nf) * 13.287712379549449f);
            const float ang = pv * inv; float s, c; sincos_acc(ang, s, c);
            rt[base + idx] = c; rt[base + 2048 * 2 * nf + idx] = s;
        }
    }
    {
        bf16_t* wsm = (bf16_t*)(ws + WS_WSMALL);
        const int gw = C.vcu * 8 + C.wave, NGW = C.G * 8;
        constexpr int NI_IN = 128 * 512, NI_OUT = 128 * 256, NI_SMALL = 384 + 256 + 384 + 256 + 96 + 80 + 144 + 128 + 256 + 768 + 256;
        for (int it = gw; it < NI_IN + NI_OUT + NI_SMALL; it += NGW) {
            int r = it;
            if (r < NI_IN) { const int le = r >> 9, q = r & 511; cvt_item(inp(C, I_WIN) + (size_t)le * 1024 * 2048, 2048, (bf16_t*)(ws + WS_WIN) + (size_t)le * 2048 * 1024, 1024, 0, (q >> 5) * 64, (q & 31) * 64, C.lane); continue; }
            r -= NI_IN;
            if (r < NI_OUT) { const int le = r >> 8, q = r & 255; cvt_item(inp(C, I_WOUT) + (size_t)le * 1024 * 1024, 1024, (bf16_t*)(ws + WS_WOUT) + (size_t)le * 1024 * 1024, 1024, 0, (q >> 4) * 64, (q & 15) * 64, C.lane); continue; }
            r -= NI_OUT;
            if (cvt_mat(r, inp(C, I_WIN_WQKV), 1024, 1536, wsm + OFF_WQKV0 / 2, 0, C.lane)) continue;
            if (cvt_mat(r, inp(C, I_WIN_WO), 1024, 1024, wsm + OFF_WO0 / 2, 0, C.lane)) continue;
            if (cvt_mat(r, inp(C, I_AXG_WQKV), 1024, 1536, wsm + OFF_WQKV1 / 2, 0, C.lane)) continue;
            if (cvt_mat(r, inp(C, I_AXG_WO), 1024, 1024, wsm + OFF_WO1 / 2, 0, C.lane)) continue;
            if (cvt_mat(r, inp(C, I_MLA_WQA), 1024, 384, wsm + OFF_WA / 2, 0, C.lane)) continue;
            if (cvt_mat(r, inp(C, I_MLA_WKVA), 1024, 288, wsm + OFF_WA / 2, 384, C.lane)) continue;
            if (cvt_mat(r, inp(C, I_MLA_WQB), 384, 1536, wsm + OFF_WQB / 2, 0, C.lane)) continue;
            if (cvt_mat(r, inp(C, I_MLA_WKVB), 256, 2048, wsm + OFF_WKVB / 2, 0, C.lane)) continue;
            if (cvt_mat(r, inp(C, I_MLA_WO), 1024, 1024, wsm + OFF_WO2 / 2, 0, C.lane)) continue;
            if (cvt_mat(r, inp(C, I_DIFF_WQKV), 1024, 3072, wsm + OFF_WQKV3 / 2, 0, C.lane)) continue;
            cvt_mat(r, inp(C, I_DIFF_WO), 1024, 1024, wsm + OFF_WO3 / 2, 0, C.lane);
        }
        for (int i = C.vcu * 512 + C.tid; i < 4 * 32 * 1024; i += C.G * 512) { const int k = i & 1023, e = (i >> 10) & 31, l = i >> 15;
            const float w = inp(C, I_RW)[((size_t)l * 1024 + k) * 32 + e]; const bf16_t hi = f2bf(w); bf16_t* rwt = (bf16_t*)(ws + WS_RWT) + (size_t)l * 2 * 32 * 1024;
            rwt[e * 1024 + k] = hi; rwt[32 * 1024 + e * 1024 + k] = f2bf(w - bf2f(hi)); }
        for (int i = C.vcu * 512 + C.tid; i < 96 * 1024 / 8; i += C.G * 512) *(u32x4*)(wsm + OFF_WA / 2 + (size_t)672 * 1024 + (size_t)i * 8) = (u32x4){0u, 0u, 0u, 0u};
    }
}

DI void ld_row(const float* p, int lane, f32x4 (&v)[4]) {
#pragma unroll
    for (int j = 0; j < 4; ++j) v[j] = *(const f32x4*)(p + j * 256 + lane * 4);
}
DI void st_row(float* p, int lane, const f32x4 (&v)[4]) {
#pragma unroll
    for (int j = 0; j < 4; ++j) *(f32x4*)(p + j * 256 + lane * 4) = v[j];
}
DI void st_row_bf(bf16_t* p, int lane, const f32x4 (&v)[4]) {
#pragma unroll
    for (int j = 0; j < 4; ++j) { u32x2 w; w.x = pk2(v[j][0], v[j][1]); w.y = pk2(v[j][2], v[j][3]); *(u32x2*)(p + j * 256 + lane * 4) = w; }
}
DI void layernorm_row(f32x4 (&v)[4], const float* g, const float* b, int lane) {
    float s = 0.f;
#pragma unroll
    for (int j = 0; j < 4; ++j) s += (v[j][0] + v[j][1]) + (v[j][2] + v[j][3]);
    const float mean = wave_sum(s, lane) * (1.0f / DM); float q = 0.f;
#pragma unroll
    for (int j = 0; j < 4; ++j) { v[j] = v[j] - mean; q += (v[j][0] * v[j][0] + v[j][1] * v[j][1]) + (v[j][2] * v[j][2] + v[j][3] * v[j][3]); }
    const float rstd = 1.0f / sqrtf(wave_sum(q, lane) * (1.0f / DM) + LN_EPS);
    f32x4 gg[4], bb[4]; ld_row(g, lane, gg); ld_row(b, lane, bb);
#pragma unroll
    for (int j = 0; j < 4; ++j) v[j] = (v[j] * rstd) * gg[j] + bb[j];
}
DI void modulate_row(const f32x4 (&x)[4], const float* sh, const float* sc, int lane, f32x4 (&h)[4]) {
    f32x4 a[4], b[4]; ld_row(sc, lane, a); ld_row(sh, lane, b);
#pragma unroll
    for (int j = 0; j < 4; ++j) h[j] = x[j] * (1.0f + a[j]) + b[j];
}

DI void phase_modh0(int wave_s, unsigned char* ws_) {
    const Ctx C = make_ctx(ws_, wave_s);
    float* X = (float*)(C.ws + WS_X); bf16_t* H = (bf16_t*)(C.ws + WS_H);
    for (int row = C.vcu * 8 + C.wave; row < NT; row += C.G * 8) {
        const float* src = row < NCTX ? inp(C, I_CTX) + (size_t)row * DM : inp(C, I_X) + (size_t)(row - NCTX) * DM;
        f32x4 v[4], h[4]; ld_row(src, C.lane, v); st_row(X + (size_t)row * DM, C.lane, v);
        const int m = modidx(row); modulate_row(v, modp(C, 0, m, 0), modp(C, 0, m, 1), C.lane, h);
        st_row_bf(H + (size_t)row * DM, C.lane, h);
    }
}

template <int NF> DI void rope_heads(bf16_t* p, int nheads, int stride, const float* rt, int rtbase, int pos, int lane) {
    constexpr int CPH = 2 * (NF / 8);
    const float* ct = rt + rtbase + (size_t)pos * 2 * NF; const float* st = ct + 2048 * 2 * NF;
    for (int c = lane; c < nheads * CPH; c += 64) {
        const int hh = c / CPH, rem = c - hh * CPH, half = rem / (NF / 8), sub = rem - half * (NF / 8);
        bf16_t* x1p = p + hh * stride + half * 2 * NF + sub * 8; bf16_t* x2p = x1p + NF;
        const u32x4 a = *(const u32x4*)x1p, b = *(const u32x4*)x2p;
        const f32x4 c0 = *(const f32x4*)(ct + half * NF + sub * 8), c1 = *(const f32x4*)(ct + half * NF + sub * 8 + 4);
        const f32x4 s0 = *(const f32x4*)(st + half * NF + sub * 8), s1 = *(const f32x4*)(st + half * NF + sub * 8 + 4);
        float x1[8] = {bf_lo(a.x), bf_hi(a.x), bf_lo(a.y), bf_hi(a.y), bf_lo(a.z), bf_hi(a.z), bf_lo(a.w), bf_hi(a.w)};
        float x2[8] = {bf_lo(b.x), bf_hi(b.x), bf_lo(b.y), bf_hi(b.y), bf_lo(b.z), bf_hi(b.z), bf_lo(b.w), bf_hi(b.w)};
        float cc[8] = {c0[0], c0[1], c0[2], c0[3], c1[0], c1[1], c1[2], c1[3]}, ss[8] = {s0[0], s0[1], s0[2], s0[3], s1[0], s1[1], s1[2], s1[3]};
        float y1[8], y2[8];
#pragma unroll
        for (int i = 0; i < 8; ++i) { y1[i] = x1[i] * cc[i] - x2[i] * ss[i]; y2[i] = x1[i] * ss[i] + x2[i] * cc[i]; }
        u32x4 o1, o2; o1.x = pk2(y1[0], y1[1]); o1.y = pk2(y1[2], y1[3]); o1.z = pk2(y1[4], y1[5]); o1.w = pk2(y1[6], y1[7]);
        o2.x = pk2(y2[0], y2[1]); o2.y = pk2(y2[2], y2[3]); o2.z = pk2(y2[4], y2[5]); o2.w = pk2(y2[6], y2[7]);
        *(u32x4*)x1p = o1; *(u32x4*)x2p = o2;
    }
}
DI void vt_items(const Ctx& C, const bf16_t* src, int pitch, int col0, int hstride, int HV, int DV, bf16_t* Vt) {
    const int dvb_n = DV >> 6, items = NB * HV * dvb_n * 36;
    for (int it = C.vcu * 8 + C.wave; it < items; it += C.G * 8) {
        const int kbk = it % 36; int r = it / 36; const int dvb = r % dvb_n; r /= dvb_n; const int hv = r % HV, b = r / HV;
        const int key0 = kbk * 64;
        const int row0 = key0 < CTXL ? b * CTXL + key0 : NCTX + b * SEQ + (key0 - CTXL);
        const bf16_t* sp = src + (size_t)row0 * pitch + col0 + hv * hstride + dvb * 64 + C.lane;
        bf16_t v[64];
#pragma unroll
        for (int i = 0; i < 64; ++i) v[i] = sp[(size_t)i * pitch];
        bf16_t* dp = Vt + ((size_t)(b * HV + hv) * DV + dvb * 64 + C.lane) * NKEY + key0;
#pragma unroll
        for (int j = 0; j < 8; ++j) { u32x4 w; w.x = v[8 * j] | ((unsigned)v[8 * j + 1] << 16); w.y = v[8 * j + 2] | ((unsigned)v[8 * j + 3] << 16);
            w.z = v[8 * j + 4] | ((unsigned)v[8 * j + 5] << 16); w.w = v[8 * j + 6] | ((unsigned)v[8 * j + 7] << 16); *(u32x4*)(dp + 8 * j) = w; }
    }
}
DI int latent_pos(int row) { return (row - NCTX) & (SEQ - 1); }

DI void phase_post(int wave_s, unsigned char* ws0, int l) {
    const Ctx C = make_ctx(ws0, wave_s); unsigned char* ws = C.ws; const float* rt = (const float*)(ws + WS_ROPE);
    bf16_t* RAW = (bf16_t*)(ws + WS_RAW); bf16_t* Vt = (bf16_t*)(ws + WS_VT);
    const int gw = C.vcu * 8 + C.wave, NGW = C.G * 8;
    if (l == 0) {
        for (int row = NCTX + gw; row < NT; row += NGW) rope_heads<16>(RAW + (size_t)row * 1536, 20, 64, rt, RT16, latent_pos(row), C.lane);
        vt_items(C, RAW, 1536, 1280, 64, 4, 64, Vt);
    } else if (l == 1) {
        const float* qn = inp(C, I_AXG_QN); const float* kn = inp(C, I_AXG_KN);
        const int hs = C.lane >> 5, half = (C.lane >> 4) & 1, q2 = (C.lane & 15) * 2, d1 = half * 64 + q2, d2 = d1 + 32;
        const f32x2 gq1 = *(const f32x2*)(qn + d1), gq2 = *(const f32x2*)(qn + d2), gk1 = *(const f32x2*)(kn + d1), gk2 = *(const f32x2*)(kn + d2);
        for (int row = gw; row < NT; row += NGW) {
            bf16_t* p = RAW + (size_t)row * 1536; const bool lat = row >= NCTX;
            f32x2 cs = {1.f, 1.f}, sn = {0.f, 0.f};
            if (lat) { const int pos = latent_pos(row); cs = *(const f32x2*)(rt + RT32 + (pos * 2 + half) * 32 + q2); sn = *(const f32x2*)(rt + RT32 + 2048 * 2 * 32 + (pos * 2 + half) * 32 + q2); }
            unsigned w1[5], w2[5];
#pragma unroll
            for (int ps = 0; ps < 5; ++ps) { const int hh = ps * 2 + hs; w1[ps] = *(const unsigned*)(p + hh * 128 + d1); w2[ps] = *(const unsigned*)(p + hh * 128 + d2); }
#pragma unroll
            for (int ps = 0; ps < 5; ++ps) { const int hh = ps * 2 + hs;
                float a0 = bf_lo(w1[ps]), a1 = bf_hi(w1[ps]), b0 = bf_lo(w2[ps]), b1 = bf_hi(w2[ps]);
                float ss = (a0 * a0 + a1 * a1) + (b0 * b0 + b1 * b1);
#pragma unroll
                for (int o = 1; o < 32; o <<= 1) ss += shx(ss, o, C.lane);
                const float r = 1.0f / sqrtf(ss * (1.0f / 128.0f) + NORM_EPS);
                const bool isq = hh < 8; const f32x2 g1 = isq ? gq1 : gk1, g2 = isq ? gq2 : gk2;
                a0 = a0 * r * g1[0]; a1 = a1 * r * g1[1]; b0 = b0 * r * g2[0]; b1 = b1 * r * g2[1];
                *(unsigned*)(p + hh * 128 + d1) = pk2(a0 * cs[0] - b0 * sn[0], a1 * cs[1] - b1 * sn[1]);
                *(unsigned*)(p + hh * 128 + d2) = pk2(a0 * sn[0] + b0 * cs[0], a1 * sn[1] + b1 * cs[1]);
            }
        }
        vt_items(C, RAW, 1536, 1280, 128, 2, 128, Vt);
    } else if (l == 2) {
        bf16_t* CQ = (bf16_t*)(ws + WS_CQ); bf16_t* CKV = (bf16_t*)(ws + WS_CKV); bf16_t* KPE = (bf16_t*)(ws + WS_KPE);
        const float* qn = inp(C, I_MLA_QN); const float* kvn = inp(C, I_MLA_KVN);
        for (int row = gw; row < NT; row += NGW) {
            const bf16_t* p = RAW + (size_t)row * 768;
            float q[6], ssq = 0.f;
#pragma unroll
            for (int j = 0; j < 6; ++j) { q[j] = bf2f(p[j * 64 + C.lane]); ssq += q[j] * q[j]; }
            const float rq = 1.0f / sqrtf(wave_sum(ssq, C.lane) * (1.0f / 384.0f) + NORM_EPS);
#pragma unroll
            for (int j = 0; j < 6; ++j) CQ[(size_t)row * 384 + j * 64 + C.lane] = f2bf(q[j] * rq * qn[j * 64 + C.lane]);
            float kv[4], ssk = 0.f;
#pragma unroll
            for (int j = 0; j < 4; ++j) { kv[j] = bf2f(p[384 + j * 64 + C.lane]); ssk += kv[j] * kv[j]; }
            const float rk = 1.0f / sqrtf(wave_sum(ssk, C.lane) * (1.0f / 256.0f) + NORM_EPS);
#pragma unroll
            for (int j = 0; j < 4; ++j) CKV[(size_t)row * 256 + j * 64 + C.lane] = f2bf(kv[j] * rk * kvn[j * 64 + C.lane]);
            if (C.lane < 16) {
                const int half = C.lane >> 3, f = C.lane & 7; float x1 = bf2f(p[640 + half * 16 + f]), x2 = bf2f(p[640 + half * 16 + 8 + f]);
                float cs = 1.f, sn = 0.f;
                if (row >= NCTX) { const int pos = latent_pos(row); cs = rt[RT8 + (pos * 2 + half) * 8 + f]; sn = rt[RT8 + 2048 * 2 * 8 + (pos * 2 + half) * 8 + f]; }
                KPE[(size_t)row * 32 + half * 16 + f] = f2bf(x1 * cs - x2 * sn); KPE[(size_t)row * 32 + half * 16 + 8 + f] = f2bf(x1 * sn + x2 * cs);
            }
        }
    } else {
        for (int row = NCTX + gw; row < NT; row += NGW) rope_heads<16>(RAW + (size_t)row * 3072, 32, 64, rt, RT16, latent_pos(row), C.lane);
        vt_items(C, RAW, 3072, 2048, 128, 8, 128, Vt);
    }
}
DI void phase_postb(int wave_s, unsigned char* ws0) {
    const Ctx C = make_ctx(ws0, wave_s); unsigned char* ws = C.ws; const float* rt = (const float*)(ws + WS_ROPE);
    bf16_t* Q2 = (bf16_t*)(ws + WS_Q2); const bf16_t* KV2 = (const bf16_t*)(ws + WS_KV2); const bf16_t* KPE = (const bf16_t*)(ws + WS_KPE); bf16_t* KF = (bf16_t*)(ws + WS_KF);
    const int gw = C.vcu * 8 + C.wave, NGW = C.G * 8;
    for (int row = gw; row < NT; row += NGW) {
        if (row >= NCTX) rope_heads<8>(Q2 + (size_t)row * 1536 + 64, 16, 96, rt, RT8, latent_pos(row), C.lane);
        for (int c = C.lane; c < 192; c += 64) { const int h = c / 12, j = c - h * 12;
            const u32x4 v = j < 8 ? *(const u32x4*)(KV2 + (size_t)row * 2048 + h * 128 + j * 8) : *(const u32x4*)(KPE + (size_t)row * 32 + (j - 8) * 8);
            *(u32x4*)(KF + (size_t)row * 1536 + h * 96 + j * 8) = v; }
    }
    vt_items(C, KV2, 2048, 64, 128, 16, 64, (bf16_t*)(ws + WS_VT));
}

struct AttnP { const bf16_t* Q; int qp; const bf16_t* K; int kp; const bf16_t* Vt; bf16_t* O; int G; int HV; float cscale; const float* sink; float lam; float osc; const float* subln; };
DI int crow(int reg, int h) { return (reg & 3) + 8 * (reg >> 2) + 4 * h; }

template <int DQK, int DV, bool DIFF, bool WIN>
DI void attn_unit(const Ctx& C, const AttnP& P, int b, int hsel, int qt, bool ctxq) {
    constexpr int KH = DIFF ? 2 : 1, KS = DQK * 2 + 16, VS = 136, KBYTES = KH * 64 * KS, BUFB = KBYTES + DV * VS;
    constexpr int KCH = DQK / 8, NKC = KH * 64 * KCH, NKL = (NKC + 511) / 512, NVC = DV * 8, NVL = NVC / 512;
    constexpr int QROWS = DIFF ? 128 : 256, NKS = DQK / 16, NDV = DV / 32;
    static_assert(2 * BUFB <= RING_BYTES, "attention LDS");
    const int tid = C.tid, lane = C.lane, wave = C.wave, r = lane & 31, h = lane >> 5;
    const int wg = DIFF ? (wave >> 2) : 0, wrow = (DIFF ? (wave & 3) : wave) * 32;
    const int hq = DIFF ? 2 * hsel + wg : hsel, hk0 = DIFF ? 2 * hsel : hsel / P.G, hv = DIFF ? hsel : hsel / P.G;
    const int qrow0 = ctxq ? b * CTXL : NCTX + b * SEQ + qt * QROWS;
    int t_lo = 0, t_hi = 0;
    if (!ctxq) { if (WIN) { t_lo = 4 * qt - 2; if (t_lo < 0) t_lo = 0; t_hi = 4 * qt + 6; if (t_hi > 32) t_hi = 32; } else { t_lo = 0; t_hi = 32; } }
    const int ntile = 4 + (t_hi - t_lo);
    LAS unsigned char* lds = C.lds;
    bf16x8 qf[NKS];
    { const bf16_t* qptr = P.Q + (size_t)(qrow0 + wrow + r) * P.qp + hq * DQK + 8 * h;
#pragma unroll
      for (int ks = 0; ks < NKS; ++ks) qf[ks] = *(const bf16x8*)(qptr + ks * 16); }
    u32x4 kreg[NKL], vreg[NVL];
    const bf16_t* vbase = P.Vt + (size_t)(b * P.HV + hv) * DV * NKEY;
#define ATT_LOAD(j) do { const int _j = (j); const int krow0 = _j < 4 ? b * CTXL + _j * 64 : NCTX + b * SEQ + (t_lo + _j - 4) * 64; const int vkey0 = _j < 4 ? _j * 64 : CTXL + (t_lo + _j - 4) * 64; \
        _Pragma("unroll") for (int i = 0; i < NKL; ++i) { const int c = tid + i * 512; if (NKC % 512 == 0 || c < NKC) { const int kh = c / (64 * KCH), rem = c - kh * (64 * KCH), key = rem / KCH, dc = rem - key * KCH; \
            kreg[i] = *(const u32x4*)(P.K + (size_t)(krow0 + key) * P.kp + (hk0 + kh) * DQK + dc * 8); } } \
        _Pragma("unroll") for (int i = 0; i < NVL; ++i) { const int c = tid + i * 512; const int dv = c >> 3, kc = c & 7; vreg[i] = *(const u32x4*)(vbase + (size_t)dv * NKEY + vkey0 + kc * 8); } } while (0)
#define ATT_WRITE(buf) do { LAS unsigned char* _b = lds + (buf) * BUFB; \
        _Pragma("unroll") for (int i = 0; i < NKL; ++i) { const int c = tid + i * 512; if (NKC % 512 == 0 || c < NKC) { const int kh = c / (64 * KCH), rem = c - kh * (64 * KCH), key = rem / KCH, dc = rem - key * KCH; \
            *(LAS u32x4*)(_b + kh * 64 * KS + key * KS + dc * 16) = kreg[i]; } } \
        _Pragma("unroll") for (int i = 0; i < NVL; ++i) { const int c = tid + i * 512; const int dv = c >> 3, kc = c & 7; LAS unsigned char* d = _b + KBYTES + dv * VS + kc * 16; \
            *(LAS u32x2*)d = (u32x2){vreg[i].x, vreg[i].y}; *(LAS u32x2*)(d + 8) = (u32x2){vreg[i].z, vreg[i].w}; } } while (0)
    f32x16 o[NDV];
#pragma unroll
    for (int d = 0; d < NDV; ++d)
#pragma unroll
        for (int i = 0; i < 16; ++i) o[d][i] = 0.f;
    float m_run = -INFINITY, l_run = 0.f;
    const int qpos = qt * QROWS + wrow + r;
    __syncthreads();
    ATT_LOAD(0); ATT_WRITE(0);
    __syncthreads();
    for (int j = 0; j < ntile; ++j) {
        const int cur = j & 1;
        const LAS unsigned char* kb_ = lds + cur * BUFB + wg * 64 * KS + r * KS + 16 * h;
        const LAS unsigned char* vb_ = lds + cur * BUFB + KBYTES + r * VS + 8 * h;
        f32x16 s0, s1;
#pragma unroll
        for (int i = 0; i < 16; ++i) { s0[i] = 0.f; s1[i] = 0.f; }
#pragma unroll
        for (int ks = 0; ks < NKS; ++ks) {
            const bf16x8 a0 = *(const LAS bf16x8*)(kb_ + ks * 32), a1 = *(const LAS bf16x8*)(kb_ + 32 * KS + ks * 32);
            s0 = __builtin_amdgcn_mfma_f32_32x32x16_bf16(a0, qf[ks], s0, 0, 0, 0);
            s1 = __builtin_amdgcn_mfma_f32_32x32x16_bf16(a1, qf[ks], s1, 0, 0, 0);
        }
        if (WIN) { if (!ctxq && j >= 4) { const int kp0 = (t_lo + j - 4) * 64;
#pragma unroll
            for (int i = 0; i < 16; ++i) { const int k0 = kp0 + crow(i, h), d0 = qpos - k0, d1 = d0 - 32;
                if (d0 > 128 || d0 < -128) s0[i] = -INFINITY; if (d1 > 128 || d1 < -128) s1[i] = -INFINITY; } } }
        float mx = -INFINITY;
#pragma unroll
        for (int i = 0; i < 16; ++i) mx = fmaxf(mx, fmaxf(s0[i], s1[i]));
        mx = fmaxf(mx, shx(mx, 32, lane)) * P.cscale;
        if (!__all(mx <= m_run + ATT_THR)) {
            const float m_new = fmaxf(m_run, mx);
            const float alpha = __builtin_amdgcn_exp2f(m_run - m_new);
            l_run *= alpha; m_run = m_new;
#pragma unroll
            for (int d = 0; d < NDV; ++d)
#pragma unroll
                for (int i = 0; i < 16; ++i) o[d][i] *= alpha;
        }
        float rs = 0.f;
#pragma unroll
        for (int i = 0; i < 16; ++i) { s0[i] = __builtin_amdgcn_exp2f(fmaf(s0[i], P.cscale, -m_run)); s1[i] = __builtin_amdgcn_exp2f(fmaf(s1[i], P.cscale, -m_run)); rs += s0[i] + s1[i]; }
        rs += shx(rs, 32, lane);
        l_run += rs;
        if (j + 1 < ntile) ATT_LOAD(j + 1);
        bf16x8 pf[2][2];
#pragma unroll
        for (int s = 0; s < 2; ++s) {
            u32x4 w0, w1;
            w0.x = pk2(s0[8 * s + 0], s0[8 * s + 1]); w0.y = pk2(s0[8 * s + 2], s0[8 * s + 3]); w0.z = pk2(s0[8 * s + 4], s0[8 * s + 5]); w0.w = pk2(s0[8 * s + 6], s0[8 * s + 7]);
            w1.x = pk2(s1[8 * s + 0], s1[8 * s + 1]); w1.y = pk2(s1[8 * s + 2], s1[8 * s + 3]); w1.z = pk2(s1[8 * s + 4], s1[8 * s + 5]); w1.w = pk2(s1[8 * s + 6], s1[8 * s + 7]);
            pf[0][s] = __builtin_bit_cast(bf16x8, w0); pf[1][s] = __builtin_bit_cast(bf16x8, w1);
        }
#pragma unroll
        for (int d = 0; d < NDV; ++d)
#pragma unroll
            for (int kb = 0; kb < 2; ++kb)
#pragma unroll
                for (int s = 0; s < 2; ++s) {
                    const LAS unsigned char* vp = vb_ + d * 32 * VS + kb * 64 + s * 32;
                    const u32x2 lo = *(const LAS u32x2*)vp, hi = *(const LAS u32x2*)(vp + 16);
                    const u32x4 vv = {lo.x, lo.y, hi.x, hi.y};
                    o[d] = __builtin_amdgcn_mfma_f32_32x32x16_bf16(__builtin_bit_cast(bf16x8, vv), pf[kb][s], o[d], 0, 0, 0);
                }
        if (j + 1 < ntile) ATT_WRITE(cur ^ 1);
        __syncthreads();
    }
#undef ATT_LOAD
#undef ATT_WRITE
    float lfin = l_run, fsc = 1.0f;
    if (WIN) { const float sk = P.sink[hq] * LOG2E; const float m2 = fmaxf(m_run, sk); fsc = __builtin_amdgcn_exp2f(m_run - m2); lfin = l_run * fsc + __builtin_amdgcn_exp2f(sk - m2); }
    const float inv = fsc / lfin;
    bf16_t* orow = P.O + (size_t)(qrow0 + wrow + r) * DM;
    if (!DIFF) {
#pragma unroll
        for (int d = 0; d < NDV; ++d)
#pragma unroll
            for (int g = 0; g < 4; ++g) { u32x2 w; w.x = pk2(o[d][4 * g] * inv, o[d][4 * g + 1] * inv); w.y = pk2(o[d][4 * g + 2] * inv, o[d][4 * g + 3] * inv);
                *(u32x2*)(orow + hq * DV + d * 32 + 8 * g + 4 * h) = w; }
    } else {
        LAS float* o2 = (LAS float*)lds;
        if (wg == 1) {
#pragma unroll
            for (int d = 0; d < NDV; ++d)
#pragma unroll
                for (int g = 0; g < 4; ++g) *(LAS f32x4*)(o2 + (wrow + r) * 132 + d * 32 + 8 * g + 4 * h) = (f32x4){o[d][4 * g] * inv, o[d][4 * g + 1] * inv, o[d][4 * g + 2] * inv, o[d][4 * g + 3] * inv};
        }
        __syncthreads();
        if (wg == 0) {
            float ssq = 0.f;
#pragma unroll
            for (int d = 0; d < NDV; ++d)
#pragma unroll
                for (int g = 0; g < 4; ++g) { const f32x4 t = *(const LAS f32x4*)(o2 + (wrow + r) * 132 + d * 32 + 8 * g + 4 * h);
#pragma unroll
                    for (int i = 0; i < 4; ++i) { const float v = o[d][4 * g + i] * inv - P.lam * t[i]; o[d][4 * g + i] = v; ssq += v * v; } }
            ssq += shx(ssq, 32, lane);
            const float rn = P.osc / sqrtf(ssq * (1.0f / DV) + NORM_EPS);
#pragma unroll
            for (int d = 0; d < NDV; ++d)
#pragma unroll
                for (int g = 0; g < 4; ++g) { const int dv = d * 32 + 8 * g + 4 * h; const f32x4 sg = *(const f32x4*)(P.subln + dv);
                    u32x2 w; w.x = pk2(o[d][4 * g] * rn * sg[0], o[d][4 * g + 1] * rn * sg[1]); w.y = pk2(o[d][4 * g + 2] * rn * sg[2], o[d][4 * g + 3] * rn * sg[3]);
                    *(u32x2*)(orow + hsel * DV + dv) = w; }
        }
    }
}


DI AttnP attn_base(unsigned char* ws) { AttnP P; P.Vt = (const bf16_t*)(ws + WS_VT); P.O = (bf16_t*)(ws + WS_O); P.sink = nullptr; P.lam = 0.f; P.osc = 1.f; P.subln = nullptr; return P; }
DI void ph_attn0(int wave_s, unsigned char* ws0) {
    const Ctx C = make_ctx(ws0, wave_s); unsigned char* ws = C.ws; const float* sink = inp(C, I_WIN_SINK); AttnP P = attn_base(ws); const bf16_t* RAW = (const bf16_t*)(ws + WS_RAW);
    P.Q = RAW; P.qp = 1536; P.K = RAW + 1024; P.kp = 1536; P.G = 4; P.HV = 4; P.cscale = 0.125f * LOG2E; P.sink = sink;
    for (int u = C.vcu; u < 1024 + 128; u += C.G) {
        if (u < 1024) { const int b = u >> 7, rem = u & 127; attn_unit<64, 64, false, true>(C, P, b, rem >> 3, rem & 7, false); }
        else { const int v = u - 1024; attn_unit<64, 64, false, true>(C, P, v >> 4, v & 15, 0, true); }
    }
}
DI void ph_attn1(int wave_s, unsigned char* ws0) {
    const Ctx C = make_ctx(ws0, wave_s); unsigned char* ws = C.ws; AttnP P = attn_base(ws); const bf16_t* RAW = (const bf16_t*)(ws + WS_RAW);
    P.Q = RAW; P.qp = 1536; P.K = RAW + 1024; P.kp = 1536; P.G = 4; P.HV = 2; P.cscale = 0.08838834764831845f * LOG2E;
    for (int u = C.vcu; u < 512 + 64; u += C.G) {
        if (u < 512) { const int b = u >> 6, rem = u & 63; attn_unit<128, 128, false, false>(C, P, b, rem >> 3, rem & 7, false); }
        else { const int v = u - 512; attn_unit<128, 128, false, false>(C, P, v >> 3, v & 7, 0, true); }
    }
}
DI void ph_attn2(int wave_s, unsigned char* ws0) {
    const Ctx C = make_ctx(ws0, wave_s); unsigned char* ws = C.ws; AttnP P = attn_base(ws);
    P.Q = (const bf16_t*)(ws + WS_Q2); P.qp = 1536; P.K = (const bf16_t*)(ws + WS_KF); P.kp = 1536; P.G = 1; P.HV = 16; P.cscale = 0.10206207261596577f * LOG2E;
    for (int u = C.vcu; u < 1024 + 128; u += C.G) {
        if (u < 1024) { const int b = u >> 7, rem = u & 127; attn_unit<96, 64, false, false>(C, P, b, rem >> 3, rem & 7, false); }
        else { const int v = u - 1024; attn_unit<96, 64, false, false>(C, P, v >> 4, v & 15, 0, true); }
    }
}
DI void ph_attn3(int wave_s, unsigned char* ws0) {
    const Ctx C = make_ctx(ws0, wave_s); unsigned char* ws = C.ws; const float* lp = inp(C, I_DIFF_LAM); const float* subln = inp(C, I_DIFF_SUBLN); AttnP P = attn_base(ws); const bf16_t* RAW = (const bf16_t*)(ws + WS_RAW);
    P.Q = RAW; P.qp = 3072; P.K = RAW + 1024; P.kp = 3072; P.G = 1; P.HV = 8; P.cscale = 0.125f * LOG2E; P.subln = subln;
    const float linit = 0.8f - 0.6f * expf(-0.3f * 3.0f);
    const float s1 = wave_sum(lp[C.lane] * lp[64 + C.lane], C.lane), s2 = wave_sum(lp[128 + C.lane] * lp[192 + C.lane], C.lane);
    P.lam = expf(s1) - expf(s2) + linit; P.osc = 1.0f - linit;
    for (int u = C.vcu; u < 1024; u += C.G) { const int b = u >> 7, rem = u & 127; attn_unit<64, 128, true, false>(C, P, b, rem >> 4, rem & 15, false); }
}

DI void moe_tables(const Ctx& C, int l) {
    const unsigned* cnt = (const unsigned*)(C.ws + WS_CTL) + CW_CNT + l * 32;
    __syncthreads();
    if (C.tid == 0) {
        unsigned t = 0, c = 0;
#pragma nounroll
        for (int e = 0; e < NEXP; ++e) { const unsigned n = __hip_atomic_load(cnt + e, __ATOMIC_RELAXED, __HIP_MEMORY_SCOPE_AGENT); C.misc[MW_TP + e] = t; C.misc[MW_CP + e] = c; C.misc[MW_CN + e] = n; const unsigned nt = (n + 255u) >> 8;
            for (unsigned i = 0; i < nt; ++i) C.misc[MW_TEXP + t + i] = (unsigned)e; t += nt; c += n; }
        C.misc[MW_TP + 32] = t; C.misc[MW_CP + 32] = c;
    }
    __syncthreads();
    __builtin_amdgcn_sched_barrier(0);
}

DI void ln1_rows2(const Ctx& C, int l, int row0, int row1, bool two) {
    unsigned char* ws = C.ws; float* X = (float*)(ws + WS_X); const float* Y = (const float*)(ws + WS_Y); bf16_t* H = (bf16_t*)(ws + WS_H); bf16_t* HLO = (bf16_t*)(ws + WS_HLO);
    f32x4 xa[4], ya[4], xb[4], yb[4];
    ld_row(X + (size_t)row0 * DM, C.lane, xa); ld_row(Y + (size_t)row0 * DM, C.lane, ya);
    if (two) { ld_row(X + (size_t)row1 * DM, C.lane, xb); ld_row(Y + (size_t)row1 * DM, C.lane, yb); }
#pragma unroll
    for (int rr = 0; rr < 2; ++rr) {
        if (rr == 1 && !two) break;
        const int row = rr ? row1 : row0; const int m = modidx(row);
        f32x4 x[4], g1[4], h[4]; ld_row(modp(C, l, m, 2), C.lane, g1);
#pragma unroll
        for (int j = 0; j < 4; ++j) x[j] = (rr ? xb[j] : xa[j]) * DN_ALPHA + g1[j] * (rr ? yb[j] : ya[j]);
        layernorm_row(x, inp(C, I_LN1G) + l * DM, inp(C, I_LN1B) + l * DM, C.lane);
        st_row(X + (size_t)row * DM, C.lane, x);
        modulate_row(x, modp(C, l, m, 3), modp(C, l, m, 4), C.lane, h);
#pragma unroll
        for (int j = 0; j < 4; ++j) {
            u32x2 whi; whi.x = pk2(h[j][0], h[j][1]); whi.y = pk2(h[j][2], h[j][3]);
            u32x2 wlo; wlo.x = pk2(h[j][0] - bf_lo(whi.x), h[j][1] - bf_hi(whi.x)); wlo.y = pk2(h[j][2] - bf_lo(whi.y), h[j][3] - bf_hi(whi.y));
            *(u32x2*)(H + (size_t)row * DM + j * 256 + C.lane * 4) = whi; *(u32x2*)(HLO + (size_t)row * DM + j * 256 + C.lane * 4) = wlo;
        }
    }
}
DI void phase_ln1(int wave_s, unsigned char* ws0, int l) {
    const Ctx C = make_ctx(ws0, wave_s); unsigned char* ws = C.ws;
    LAS float* part = (LAS float*)C.lds;
    LAS float* logits = part + 8 * 80 * 33;
    LAS int* lsel = (LAS int*)(logits + 80 * 33);
    LAS int* lslot = lsel + 288;
    LAS int* lrank = lslot + 288;
    LAS int* lcnt = lrank + 288;
    LAS int* lbase = lcnt + 32;
    const int rbase = l == 3 ? NCTX : 0, nrows = NT - rbase;
    const int rpb = (nrows + C.G - 1) / C.G;
    const int brow0 = rbase + C.vcu * rpb; int bn = NT - brow0; if (bn > rpb) bn = rpb; if (bn < 0) bn = 0; if (bn > 72) bn = 72;
    for (int i = C.wave; i < bn; i += 16) ln1_rows2(C, l, brow0 + i, brow0 + i + 8, i + 8 < bn);
    if (C.tid < 32) lcnt[C.tid] = 0;
    asm volatile("s_waitcnt vmcnt(0)" ::: "memory");
    __syncthreads();
    const bf16_t* H = (const bf16_t*)(ws + WS_H); const bf16_t* HLO = (const bf16_t*)(ws + WS_HLO);
    const bf16_t* RWH = (const bf16_t*)(ws + WS_RWT) + (size_t)l * 2 * 32 * 1024; const bf16_t* RWL = RWH + 32 * 1024;
    const float* rb = inp(C, I_RB) + l * NEXP; float* gate = (float*)(ws + WS_GATE);
    const int ntile = (bn + 15) >> 4;
    if (bn > 0) {
        const int fr = C.lane & 15, fq = C.lane >> 4, kw = C.wave * 128 + fq * 8;
        f32x4 acc[5][2];
#pragma unroll
        for (int t = 0; t < 5; ++t) { acc[t][0] = (f32x4){0.f, 0.f, 0.f, 0.f}; acc[t][1] = (f32x4){0.f, 0.f, 0.f, 0.f}; }
#pragma unroll
        for (int ks = 0; ks < 4; ++ks) {
            const int k0 = kw + ks * 32;
            const bf16x8 bh0 = *(const bf16x8*)(RWH + (size_t)fr * DM + k0), bl0 = *(const bf16x8*)(RWL + (size_t)fr * DM + k0);
            const bf16x8 bh1 = *(const bf16x8*)(RWH + (size_t)(16 + fr) * DM + k0), bl1 = *(const bf16x8*)(RWL + (size_t)(16 + fr) * DM + k0);
#pragma unroll
            for (int t = 0; t < 5; ++t) if (t < ntile) {
                int ar = t * 16 + fr; if (ar >= bn) ar = bn - 1;
                const bf16x8 ah = *(const bf16x8*)(H + (size_t)(brow0 + ar) * DM + k0), al = *(const bf16x8*)(HLO + (size_t)(brow0 + ar) * DM + k0);
                acc[t][0] = __builtin_amdgcn_mfma_f32_16x16x32_bf16(ah, bh0, acc[t][0], 0, 0, 0); acc[t][0] = __builtin_amdgcn_mfma_f32_16x16x32_bf16(al, bh0, acc[t][0], 0, 0, 0); acc[t][0] = __builtin_amdgcn_mfma_f32_16x16x32_bf16(ah, bl0, acc[t][0], 0, 0, 0);
                acc[t][1] = __builtin_amdgcn_mfma_f32_16x16x32_bf16(ah, bh1, acc[t][1], 0, 0, 0); acc[t][1] = __builtin_amdgcn_mfma_f32_16x16x32_bf16(al, bh1, acc[t][1], 0, 0, 0); acc[t][1] = __builtin_amdgcn_mfma_f32_16x16x32_bf16(ah, bl1, acc[t][1], 0, 0, 0);
            }
        }
        LAS float* pw = part + C.wave * 80 * 33;
#pragma unroll
        for (int t = 0; t < 5; ++t) if (t < ntile) {
#pragma unroll
            for (int i = 0; i < 4; ++i) { pw[(t * 16 + 4 * fq + i) * 33 + fr] = acc[t][0][i]; pw[(t * 16 + 4 * fq + i) * 33 + 16 + fr] = acc[t][1][i]; } }
    }
    __syncthreads();
    for (int idx = C.tid; idx < bn * 32; idx += 512) { const int r = idx >> 5, e = idx & 31; float sm = 0.f;
#pragma unroll
        for (int w = 0; w < 8; ++w) sm += part[(w * 80 + r) * 33 + e];
        logits[r * 33 + e] = sm + rb[e]; }
    __syncthreads();
    if (C.tid < bn) {
        const int r = C.tid, li = r * 4, grow = brow0 + r;
        float v0 = -INFINITY, v1 = -INFINITY, v2 = -INFINITY, v3 = -INFINITY; int i0 = 0, i1 = 0, i2 = 0, i3 = 0;
        for (int e = 0; e < 32; ++e) { const float x = logits[r * 33 + e];
            if (x > v3) { if (x > v2) { v3 = v2; i3 = i2; if (x > v1) { v2 = v1; i2 = i1; if (x > v0) { v1 = v0; i1 = i0; v0 = x; i0 = e; } else { v1 = x; i1 = e; } } else { v2 = x; i2 = e; } } else { v3 = x; i3 = e; } } }
        const float e1 = expf(v1 - v0), e2 = expf(v2 - v0), e3 = expf(v3 - v0), inv = 1.0f / (1.0f + e1 + e2 + e3);
        lsel[li] = i0; lsel[li + 1] = i1; lsel[li + 2] = i2; lsel[li + 3] = i3;
        lslot[li] = grow * 4; lslot[li + 1] = grow * 4 + 1; lslot[li + 2] = grow * 4 + 2; lslot[li + 3] = grow * 4 + 3;
        *(f32x4*)(gate + (size_t)grow * 4) = (f32x4){inv, e1 * inv, e2 * inv, e3 * inv};
    }
    __syncthreads();
    const int nsel = bn * 4;
    if (C.tid < nsel) lrank[C.tid] = __hip_atomic_fetch_add(lcnt + lsel[C.tid], 1, __ATOMIC_RELAXED, __HIP_MEMORY_SCOPE_WORKGROUP);
    __syncthreads();
    if (C.tid < 32) { const int n = lcnt[C.tid]; int base = 0;
        if (n) base = (int)__hip_atomic_fetch_add((unsigned*)(ws + WS_CTL) + CW_CNT + l * 32 + C.tid, (unsigned)n, __ATOMIC_RELAXED, __HIP_MEMORY_SCOPE_AGENT);
        lbase[C.tid] = base; }
    __syncthreads();
    if (C.tid < nsel) { const int e = lsel[C.tid]; ((int*)(ws + WS_LIST))[(size_t)e * CAP + lbase[e] + lrank[C.tid]] = lslot[C.tid]; }
    __syncthreads();
}

DI void phase_ln2(int wave_s, unsigned char* ws0, int l) {
    const Ctx C = make_ctx(ws0, wave_s); unsigned char* ws = C.ws; float* X = (float*)(ws + WS_X); bf16_t* H = (bf16_t*)(ws + WS_H); const bf16_t* YS = (const bf16_t*)(ws + WS_YS);
    const int r0 = l == 3 ? NCTX : 0;
    for (int rowa = r0 + C.vcu * 8 + C.wave; rowa < NT; rowa += 2 * C.G * 8) {
        const int rowb = rowa + C.G * 8; const bool two = rowb < NT;
        f32x4 xs[2][4], ys[2][4];
#pragma unroll
        for (int rr = 0; rr < 2; ++rr) { if (rr == 1 && !two) break; const int row = rr ? rowb : rowa;
            ld_row(X + (size_t)row * DM, C.lane, xs[rr]);
            u32x2 w[4][4];
#pragma unroll
            for (int k = 0; k < 4; ++k)
#pragma unroll
                for (int j = 0; j < 4; ++j) w[k][j] = *(const u32x2*)(YS + ((size_t)row * 4 + k) * DM + j * 256 + C.lane * 4);
#pragma unroll
            for (int j = 0; j < 4; ++j) { ys[rr][j] = (f32x4){0.f, 0.f, 0.f, 0.f};
#pragma unroll
                for (int k = 0; k < 4; ++k) ys[rr][j] += (f32x4){bf_lo(w[k][j].x), bf_hi(w[k][j].x), bf_lo(w[k][j].y), bf_hi(w[k][j].y)}; } }
#pragma unroll
        for (int rr = 0; rr < 2; ++rr) { if (rr == 1 && !two) break; const int row = rr ? rowb : rowa; const int m = modidx(row);
            f32x4 x[4], g2[4]; ld_row(modp(C, l, m, 5), C.lane, g2);
#pragma unroll
            for (int j = 0; j < 4; ++j) x[j] = xs[rr][j] * DN_ALPHA + g2[j] * ys[rr][j];
            layernorm_row(x, inp(C, I_LN2G) + l * DM, inp(C, I_LN2B) + l * DM, C.lane);
            if (l == 3) { st_row((float*)inp(C, 36) + (size_t)(row - NCTX) * DM, C.lane, x); }
            else { st_row(X + (size_t)row * DM, C.lane, x); f32x4 h[4]; modulate_row(x, modp(C, l + 1, m, 0), modp(C, l + 1, m, 1), C.lane, h); st_row_bf(H + (size_t)row * DM, C.lane, h); } }
    }
}

DI void ph_gemm_bf16(int wave_s, unsigned char* ws0, const bf16_t* A, const bf16_t* Bt, int M, int N, int K, bf16_t* out, int ldc, int bias_idx) {
    const Ctx C = make_ctx(ws0, wave_s); const float* bias = bias_idx >= 0 ? inp(C, bias_idx) : nullptr;
    pg8::DenseOrder S; S.nN = N / 256; S.nunits = (M / 256) * S.nN; S.G = C.G; S.c = C.vcu; S.r0 = 0; S.step = 256u * (unsigned)K * 2u;
    pg8::EpiBf16 E{out, ldc, bias};
    pg8::gemm_phase<false, pg8::EpiBf16, pg8::DenseOrder>(C.lds, nullptr, nullptr, C.tid, K, pg8::make_rsrc(A), pg8::make_rsrc(Bt), S, E);
}
DI void ph_gemm_wo(int wave_s, unsigned char* ws0, const bf16_t* W, int r0, int bias_idx) {
    const Ctx C = make_ctx(ws0, wave_s); unsigned char* ws = C.ws; const float* bias = bias_idx >= 0 ? inp(C, bias_idx) : nullptr;
    pg8::DenseOrder S; S.nN = 4; S.nunits = ((NT - r0) / 256) * 4; S.G = C.G; S.c = C.vcu; S.r0 = r0; S.step = 256u * 1024u * 2u;
    pg8::EpiF32 E{(float*)(ws + WS_Y), DM, bias};
    pg8::gemm_phase<false, pg8::EpiF32, pg8::DenseOrder>(C.lds, nullptr, nullptr, C.tid, 1024, pg8::make_rsrc((const bf16_t*)(ws + WS_O) + (size_t)r0 * DM), pg8::make_rsrc(W), S, E);
}
DI void ph_moe1(int wave_s, unsigned char* ws0, int l) {
    const Ctx C = make_ctx(ws0, wave_s); unsigned char* ws = C.ws; const float* b_in = inp(C, I_BIN);
    moe_tables(C, l);
    pg8::MoeOrder<3, 2048> S; S.misc = C.misc; S.G = C.G; S.c = C.vcu;
    pg8::EpiSwiglu E{(bf16_t*)(ws + WS_ACT), b_in + (size_t)l * 32 * 2048};
    pg8::gemm_phase<true, pg8::EpiSwiglu, pg8::MoeOrder<3, 2048>>(C.lds, (LAS int*)(C.lds + MISC_OFF) + MW_IDX, (const int*)(ws + WS_LIST), C.tid, 1024,
        pg8::make_rsrc(ws + WS_H), pg8::make_rsrc(ws + WS_WIN + (size_t)l * 32 * 2048 * 1024 * 2), S, E);
}
DI void ph_moe2(int wave_s, unsigned char* ws0, int l) {
    const Ctx C = make_ctx(ws0, wave_s); unsigned char* ws = C.ws; const float* b_out = inp(C, I_BOUT);
    moe_tables(C, l);
    pg8::MoeOrder<2, 1024> S; S.misc = C.misc; S.G = C.G; S.c = C.vcu;
    pg8::EpiMoe2 E{(bf16_t*)(ws + WS_YS), b_out + (size_t)l * 32 * 1024, (const float*)(ws + WS_GATE), (const int*)(ws + WS_LIST)};
    pg8::gemm_phase<false, pg8::EpiMoe2, pg8::MoeOrder<2, 1024>>(C.lds, nullptr, nullptr, C.tid, 1024,
        pg8::make_rsrc(ws + WS_ACT), pg8::make_rsrc(ws + WS_WOUT + (size_t)l * 32 * 1024 * 1024 * 2), S, E);
}

constexpr int NPHASE = 2 + 11 * DEPTH;

__global__ void __launch_bounds__(512, 2) dit_fwd(Args args) {
    {
        LAS unsigned* mz = (LAS unsigned*)((LAS unsigned char*)lds_raw + MISC_OFF);
        for (int u = threadIdx.x; u < (LDS_BYTES - MISC_OFF) / 4; u += 512) mz[u] = 0u;
        __syncthreads();
        if (threadIdx.x == 0) {
#pragma unroll
            for (int i = 0; i < 36; ++i) { const unsigned long long p = (unsigned long long)args.in[i]; mz[MW_PTR + 2 * i] = (unsigned)p; mz[MW_PTR + 2 * i + 1] = (unsigned)(p >> 32); }
            const unsigned long long p = (unsigned long long)args.out; mz[MW_PTR + 72] = (unsigned)p; mz[MW_PTR + 73] = (unsigned)(p >> 32);
        }
        __syncthreads();
    }
    const int wave_s = __builtin_amdgcn_readfirstlane((int)threadIdx.x >> 6);
    const int lo = args.ph_lo, hi = args.ph_hi;
    unsigned char* ws = args.ws;
    XcdBarrier bar; bar.bar = (unsigned*)(ws + WS_CTL) + CW_BAR; bar.x = 0; bar.st = nullptr;
    if (hi - lo > 1) bar = xcd_barrier_post((unsigned*)(ws + WS_CTL) + CW_BAR, (volatile LAS unsigned*)((LAS unsigned char*)lds_raw + MISC_OFF) + 8);
#define IN(k) (lo <= (k) && (k) < hi)
#define SEAM(k) do { if ((k) + 1 < hi) xcd_barrier(bar); } while (0)
    bf16_t* wsm = (bf16_t*)(ws + WS_WSMALL);
    if (IN(0)) { PREP(0) phase_prologue(wave_s, ws); SEAM(0); }
    if (IN(1)) { phase_modh0(wave_s, ws); SEAM(1); }
    for (int l = 0; l < DEPTH; ++l) {
        const int pb = 2 + 11 * l;
        if (IN(pb + 0)) {
            const bf16_t* W = wsm + (l == 0 ? OFF_WQKV0 : l == 1 ? OFF_WQKV1 : l == 2 ? OFF_WA : OFF_WQKV3) / 2;
            const int N = l == 2 ? 768 : (l == 3 ? 3072 : 1536);
            PREP(1) ph_gemm_bf16(wave_s, ws, (const bf16_t*)(ws + WS_H), W, NT, N, 1024, (bf16_t*)(ws + WS_RAW), N, l == 0 ? (int)I_WIN_BQKV : -1);
            SEAM(pb + 0);
        }
        if (IN(pb + 1)) { phase_post(wave_s, ws, l); SEAM(pb + 1); }
        if (l == 2) {
            if (IN(pb + 2)) {
                PREP(1) for (int j = 0; j < 2; ++j)
                    ph_gemm_bf16(wave_s, ws, (const bf16_t*)(ws + (j == 0 ? WS_CQ : WS_CKV)), wsm + (j == 0 ? OFF_WQB : OFF_WKVB) / 2, NT, j == 0 ? 1536 : 2048, j == 0 ? 384 : 256,
                                 (bf16_t*)(ws + (j == 0 ? WS_Q2 : WS_KV2)), j == 0 ? 1536 : 2048, -1);
                SEAM(pb + 2);
            }
            if (IN(pb + 3)) { phase_postb(wave_s, ws); SEAM(pb + 3); }
        }
        if (IN(pb + 4)) {
            PREP(2) if (l == 0) ph_attn0(wave_s, ws); else if (l == 1) ph_attn1(wave_s, ws); else if (l == 2) ph_attn2(wave_s, ws); else ph_attn3(wave_s, ws);
            SEAM(pb + 4);
        }
        if (IN(pb + 5)) {
            const bf16_t* W = wsm + (l == 0 ? OFF_WO0 : l == 1 ? OFF_WO1 : l == 2 ? OFF_WO2 : OFF_WO3) / 2;
            PREP(3) ph_gemm_wo(wave_s, ws, W, l == 3 ? NCTX : 0, l == 0 ? (int)I_WIN_BO : -1);
            SEAM(pb + 5);
        }
        if (IN(pb + 6)) { phase_ln1(wave_s, ws, l); SEAM(pb + 6); }
        if (IN(pb + 8)) { PREP(5) ph_moe1(wave_s, ws, l); SEAM(pb + 8); }
        if (IN(pb + 9)) { PREP(6) ph_moe2(wave_s, ws, l); SEAM(pb + 9); }
        if (IN(pb + 10)) { phase_ln2(wave_s, ws, l); SEAM(pb + 10); }
    }
#undef IN
#undef SEAM
}

extern "C" void kernel_launch(void* const* d_in, const int* in_sizes, int n_in, void* d_out, int out_size, void* d_ws, size_t ws_size, hipStream_t stream) {
    static int grid = 0;
    if (grid == 0) {
        if (n_in != 36 || out_size != NB * SEQ * DM || ws_size < WS_END) { fprintf(stderr, "kernel_launch: unexpected shapes (n_in %d out %d ws %zu need %zu)\n", n_in, out_size, ws_size, (size_t)WS_END); grid = -1; return; }
        int dev = 0, cus = 0, per_cu = 0;
        if (hipGetDevice(&dev) != hipSuccess || hipDeviceGetAttribute(&cus, hipDeviceAttributeMultiprocessorCount, dev) != hipSuccess) { grid = -1; return; }
        if (hipFuncSetAttribute((const void*)dit_fwd, hipFuncAttributeMaxDynamicSharedMemorySize, LDS_BYTES) != hipSuccess) { fprintf(stderr, "kernel_launch: hipFuncSetAttribute failed\n"); grid = -1; return; }
        if (hipOccupancyMaxActiveBlocksPerMultiprocessor(&per_cu, (const void*)dit_fwd, 512, LDS_BYTES) != hipSuccess || per_cu < 1) fprintf(stderr, "kernel_launch: occupancy query says %d\n", per_cu);
        (void)hipGetLastError();
        grid = cus;
    }
    if (grid < 0) return;
    (void)hipMemsetAsync((char*)d_ws + WS_CTL, 0, CTL_BYTES, stream);
    Args a{};
    for (int i = 0; i < 36; ++i) a.in[i] = (const float*)d_in[i];
    a.out = (float*)d_out; a.ws = (unsigned char*)d_ws;
#if MK_PER_PHASE
    for (int ph = 0; ph < NPHASE; ++ph) {
        const int l = ph < 2 ? 0 : (ph - 2) / 11, s = ph < 2 ? 0 : (ph - 2) % 11;
        if (ph >= 2 && (s == 2 || s == 3) && l != 2) continue;
        a.ph_lo = ph; a.ph_hi = ph + 1;
        hipLaunchKernelGGL(dit_fwd, dim3(grid), dim3(512), LDS_BYTES, stream, a);
    }
#else
    a.ph_lo = 0; a.ph_hi = NPHASE;
    hipLaunchKernelGGL(dit_fwd, dim3(grid), dim3(512), LDS_BYTES, stream, a);
#endif
    const hipError_t le = hipPeekAtLastError();
    if (le != hipSuccess) fprintf(stderr, "kernel_launch: launch failed: %s\n", hipGetErrorName(le));
}
```

```cpp
#include <hip/hip_runtime.h>
#include <cstdio>
#include <cstdint>

#ifndef MK_PER_PHASE
#define MK_PER_PHASE 0
#endif

#ifndef PROBE_DOUBLE
#define PROBE_DOUBLE 0
#endif
#ifndef ATT_PROBE
#define ATT_PROBE 0
#endif
#define PREP(bit) for (int rep_ = 0; rep_ < 1 + ((PROBE_DOUBLE >> (bit)) & 1); ++rep_)
#define DI __device__ __forceinline__
#define GAS __attribute__((address_space(1)))
#define LAS __attribute__((address_space(3)))
typedef unsigned short bf16_t;
typedef short bf16x8 __attribute__((ext_vector_type(8)));
typedef float f32x2 __attribute__((ext_vector_type(2)));
typedef float f32x4 __attribute__((ext_vector_type(4)));
typedef float f32x16 __attribute__((ext_vector_type(16)));
typedef unsigned u32x2 __attribute__((ext_vector_type(2)));
typedef unsigned u32x4 __attribute__((ext_vector_type(4)));
typedef __bf16 bfv2 __attribute__((ext_vector_type(2)));

DI unsigned pk2(float lo, float hi) { f32x2 v = {lo, hi}; return __builtin_bit_cast(unsigned, __builtin_convertvector(v, bfv2)); }
DI float bf_lo(unsigned w) { return __uint_as_float(w << 16); }
DI float bf_hi(unsigned w) { return __uint_as_float(w & 0xffff0000u); }
DI float bf2f(bf16_t h) { return __uint_as_float((unsigned)h << 16); }
DI bf16_t f2bf(float f) { return (bf16_t)(pk2(f, 0.f) & 0xffffu); }
DI float shx(float v, int m, int lane) { return __int_as_float(__builtin_amdgcn_ds_bpermute((lane ^ m) << 2, __float_as_int(v))); }
DI float wave_sum(float v, int lane) {
#pragma unroll
    for (int o = 1; o < 64; o <<= 1) v += shx(v, o, lane);
    return v;
}

constexpr int NB = 8, SEQ = 2048, CTXL = 256, DM = 1024, DEPTH = 4;
constexpr int NCTX = NB * CTXL;
constexpr int NT = NCTX + NB * SEQ;
constexpr int NKEY = CTXL + SEQ;
constexpr int NEXP = 32, FF = 1024, CAP = NT;
constexpr int MAXT = 320;
constexpr float DN_ALPHA = 1.681792830507429f;
constexpr float LN_EPS = 1e-5f, NORM_EPS = 1e-6f;
constexpr float LOG2E = 1.4426950408889634f;
constexpr float ATT_THR = 8.0f;

constexpr size_t MiB = 1u << 20;
constexpr size_t WS_CTL = 0, CTL_BYTES = 1 * MiB;
constexpr size_t WS_MOD = 1 * MiB;
constexpr size_t WS_ROPE = 2 * MiB;
constexpr size_t WS_WSMALL = 4 * MiB;
constexpr size_t OFF_WQKV0 = 0, OFF_WO0 = 3 * MiB, OFF_WQKV1 = 5 * MiB, OFF_WO1 = 8 * MiB, OFF_WA = 10 * MiB, OFF_WQB = 12 * MiB,
                 OFF_WKVB = 14 * MiB, OFF_WO2 = 15 * MiB, OFF_WQKV3 = 17 * MiB, OFF_WO3 = 23 * MiB;
constexpr size_t WS_WIN = 32 * MiB;
constexpr size_t WS_WOUT = WS_WIN + 512 * MiB;
constexpr size_t WS_X = WS_WOUT + 256 * MiB;
constexpr size_t WS_H = WS_X + 72 * MiB;
constexpr size_t WS_RAW = WS_H + 36 * MiB;
constexpr size_t WS_CQ = WS_RAW + 108 * MiB;
constexpr size_t WS_CKV = WS_CQ + 14 * MiB;
constexpr size_t WS_KPE = WS_CKV + 9 * MiB;
constexpr size_t WS_Q2 = WS_KPE + 2 * MiB;
constexpr size_t WS_KV2 = WS_Q2 + 54 * MiB;
constexpr size_t WS_KF = WS_KV2 + 72 * MiB;
constexpr size_t WS_VT = WS_KF + 54 * MiB;
constexpr size_t WS_O = WS_VT + 36 * MiB;
constexpr size_t WS_Y = WS_O + 36 * MiB;
constexpr size_t WS_LIST = WS_Y + 72 * MiB;
constexpr size_t WS_GATE = WS_LIST + 3 * MiB;
constexpr size_t WS_POS = WS_GATE + 1 * MiB;
constexpr size_t WS_GS = WS_POS + 1 * MiB;
constexpr size_t WS_HS = WS_GS + 1 * MiB;
constexpr size_t WS_ACT = WS_HS + 160 * MiB;
constexpr size_t WS_YS = WS_ACT + 160 * MiB;
constexpr size_t WS_HLO = WS_YS + 160 * MiB;
constexpr size_t WS_RWT = WS_HLO + 36 * MiB;
constexpr size_t WS_END = WS_RWT + 1 * MiB;
constexpr int CW_CNT = 64;
constexpr int CW_BAR = 4096;

constexpr int RT16 = 0, RT32 = RT16 + 2 * 2048 * 2 * 16, RT8 = RT32 + 2 * 2048 * 2 * 32, RT_END = RT8 + 2 * 2048 * 2 * 8;

constexpr int RING_BYTES = 131072;
constexpr int MISC_OFF = RING_BYTES;
constexpr int LDS_BYTES = 147456;
constexpr int MW_TP = 64, MW_CP = 128, MW_TEXP = 192, MW_PTR = 512, MW_CN = 600, MW_IDX = 1024;

namespace pg8 {
constexpr int BM = 256, BK = 64, HALF = 128, HTB = HALF * BK * 2, STAGE_BYTES = 8 * HTB;
__host__ __device__ __forceinline__ int lds_byte(int r, int c) { const int st = (r >> 4) * 2 + (c >> 5), rr = r & 15, cc = c & 31, ob = rr * 64 + cc * 2; return st * 1024 + (ob ^ (((ob >> 9) & 1) << 5)); }
__host__ __device__ __forceinline__ void stage_rc(int b, int& R, int& C) { const int st = b / 1024, sb = b % 1024, swz = sb ^ (((sb >> 9) & 1) << 5); R = (st >> 1) * 16 + swz / 64; C = (st & 1) * 32 + (swz % 64) / 2; }
__host__ __device__ __forceinline__ int perm32(int rho) { const int n = rho >> 4, i = rho & 15; return 8 * (i >> 2) + 4 * n + (i & 3); }

struct Unit { unsigned ao, bo; int r0, c0, aux; unsigned io; int nvalid; };
typedef __amdgpu_buffer_rsrc_t rsrc_t;
DI rsrc_t make_rsrc(const void* base) { return __builtin_amdgcn_make_buffer_rsrc((void*)base, 0, 0x7fffffff, 0x00020000); }

template <bool GATHER, class Epi, class Sched>
__device__ __forceinline__ void gemm_phase(LAS unsigned char* lds, LAS int* idxbuf, const int* list, const int tid, const int K, const rsrc_t rsA, const rsrc_t rsB, const Sched& S, const Epi& E) {
    const int wid = __builtin_amdgcn_readfirstlane(tid >> 6), lane = tid & 63, wr = wid >> 2, wc = wid & 3, fr = lane & 15, fq = lane >> 4;
    const int nt = K / BK;
    unsigned voffA[2], voffB[2], offc[2][2];
#pragma unroll
    for (int i = 0; i < 2; ++i) { int R, C; stage_rc(tid * 16 + i * 8192, R, C); const int Rb = Epi::PERM ? ((R & ~31) + perm32(R & 31)) : R;
        voffA[i] = (unsigned)(R * K + C) * 2u; voffB[i] = (unsigned)(Rb * K + C) * 2u; offc[0][i] = 0u; offc[1][i] = 0u; }
    const unsigned hstep = (unsigned)(HALF * K * 2);
    const unsigned ldsw = (unsigned)wid * 1024u;
    const int aoff = lds_byte(wr * 64 + fr, fq * 8), boff = lds_byte(wc * 32 + fr, fq * 8);
#define PG8_SA(b, h) (((b) * 2 + (h)) * HTB)
#define PG8_SB(b, h) ((4 + (b) * 2 + (h)) * HTB)
#define PG8_STAGE(rs, bufoff, soff, voff) do { _Pragma("unroll") for (int _i = 0; _i < 2; ++_i) \
        __builtin_amdgcn_raw_ptr_buffer_load_lds((rs), (LAS void*)(lds + (bufoff) + ldsw + _i * 8192), 16, (voff)[_i], (soff), 0, 0); } while (0)
#define PG8_STAGEA(b, h, ub, kt) do { if constexpr (GATHER) PG8_STAGE(rsA, PG8_SA(b, h), (unsigned)(kt) * 128u, offc[h]); else PG8_STAGE(rsA, PG8_SA(b, h), (ub) + (unsigned)(h) * hstep + (unsigned)(kt) * 128u, voffA); } while (0)
#define PG8_STAGEB(b, h, ub, kt) PG8_STAGE(rsB, PG8_SB(b, h), (ub) + (unsigned)(h) * hstep + (unsigned)(kt) * 128u, voffB)
#define PG8_LDA(dst, b, h) do { _Pragma("unroll") for (int m = 0; m < 4; ++m) _Pragma("unroll") for (int k = 0; k < 2; ++k) dst[m][k] = *(const LAS bf16x8*)(lds + PG8_SA(b, h) + aoff + m * 2048 + k * 1024); } while (0)
#define PG8_LDB(dst, b, h) do { _Pragma("unroll") for (int n = 0; n < 2; ++n) _Pragma("unroll") for (int k = 0; k < 2; ++k) dst[n][k] = *(const LAS bf16x8*)(lds + PG8_SB(b, h) + boff + n * 2048 + k * 1024); } while (0)
#define PG8_MMA(ai, bj, At, Bt) do { __builtin_amdgcn_s_setprio(1); _Pragma("unroll") for (int m = 0; m < 4; ++m) _Pragma("unroll") for (int n = 0; n < 2; ++n) _Pragma("unroll") for (int k = 0; k < 2; ++k) \
        acc[ai][bj][m][n] = __builtin_amdgcn_mfma_f32_16x16x32_bf16(Bt[n][k], At[m][k], acc[ai][bj][m][n], 0, 0, 0); __builtin_amdgcn_s_setprio(0); } while (0)
#define PG8_WAIT_V(n) asm volatile("s_waitcnt vmcnt(" #n ")" ::: "memory")
#define PG8_WAIT_L(n) asm volatile("s_waitcnt lgkmcnt(" #n ")" ::: "memory")
#define PG8_BAR __builtin_amdgcn_s_barrier()
#define PG8_SCHED __builtin_amdgcn_sched_barrier(0)
    Unit cur, nxt; int ui = 0;
    if (!S.next(0, cur)) return;
    if constexpr (GATHER) {
#pragma unroll
        for (int h = 0; h < 2; ++h)
#pragma unroll
            for (int i = 0; i < 2; ++i) { int R, C; stage_rc(tid * 16 + i * 8192, R, C); const int r = h * HALF + R; const int sl = r < cur.nvalid ? list[cur.io + r] : 0; offc[h][i] = (unsigned)(sl >> 2) * (unsigned)(K * 2) + (unsigned)C * 2u; }
    }
    f32x4 acc[2][2][4][2];
#pragma unroll
    for (int a = 0; a < 2; ++a)
#pragma unroll
        for (int b = 0; b < 2; ++b)
#pragma unroll
            for (int m = 0; m < 4; ++m)
#pragma unroll
                for (int n = 0; n < 2; ++n) acc[a][b][m][n] = (f32x4){0.f, 0.f, 0.f, 0.f};
    bf16x8 At[4][2], B0[2][2], B1[2][2];
    unsigned cA = cur.ao, cB = cur.bo;
    PG8_STAGEB(0, 0, cB, 0); PG8_STAGEB(0, 1, cB, 0); PG8_STAGEA(0, 0, cA, 0); PG8_STAGEA(0, 1, cA, 0);
    if (wr == 1) PG8_BAR;
    PG8_WAIT_V(2); PG8_BAR;
    PG8_STAGEB(1, 0, cB, 1); PG8_STAGEA(1, 0, cA, 1); PG8_STAGEB(1, 1, cB, 1);
    PG8_WAIT_V(6); PG8_BAR;
    for (;;) {
        const bool has_next = S.next(ui + 1, nxt);
        const unsigned nA = has_next ? nxt.ao : cA, nB = has_next ? nxt.bo : cB;
        if constexpr (GATHER) { if (has_next && wid == 0) __builtin_amdgcn_global_load_lds((const unsigned*)(list + nxt.io + lane * 4), (LAS unsigned*)idxbuf, 16, 0, 0); }
        for (int t = 0; t < nt; t += 2) {
            const bool last = (t == nt - 2);
            const unsigned a2 = last ? nA : cA, b2 = last ? nB : cB; const int kt2 = last ? 0 : t + 2;
            PG8_LDB(B0, 0, 0); PG8_LDB(B1, 0, 1); PG8_SCHED; PG8_LDA(At, 0, 0); PG8_STAGEA(1, 1, cA, t + 1);
            PG8_WAIT_V(8); PG8_WAIT_L(0); PG8_BAR; PG8_MMA(0, 0, At, B0); PG8_MMA(0, 1, At, B1); PG8_BAR; PG8_SCHED;
            if constexpr (GATHER) { if (last && has_next) {
#pragma unroll
                for (int h = 0; h < 2; ++h)
#pragma unroll
                    for (int i = 0; i < 2; ++i) { int R, C; stage_rc(tid * 16 + i * 8192, R, C); const int r = h * HALF + R; const int sl = r < nxt.nvalid ? idxbuf[r] : 0; offc[h][i] = (unsigned)(sl >> 2) * (unsigned)(K * 2) + (unsigned)C * 2u; }
            } }
            PG8_LDA(At, 0, 1); PG8_STAGEB(0, 0, b2, kt2); PG8_STAGEB(0, 1, b2, kt2); PG8_STAGEA(0, 0, a2, kt2);
            PG8_WAIT_V(8); PG8_WAIT_L(0); PG8_BAR; PG8_MMA(1, 0, At, B0); PG8_MMA(1, 1, At, B1); PG8_BAR; PG8_SCHED;
            PG8_LDB(B0, 1, 0); PG8_LDB(B1, 1, 1); PG8_SCHED; PG8_LDA(At, 1, 0); PG8_STAGEA(0, 1, a2, kt2);
            PG8_WAIT_V(8); PG8_WAIT_L(0); PG8_BAR; PG8_MMA(0, 0, At, B0); PG8_MMA(0, 1, At, B1); PG8_BAR; PG8_SCHED;
            PG8_LDA(At, 1, 1); PG8_STAGEB(1, 0, b2, kt2 + 1); PG8_STAGEB(1, 1, b2, kt2 + 1); PG8_STAGEA(1, 0, a2, kt2 + 1);
            PG8_WAIT_V(8); PG8_WAIT_L(0); PG8_BAR; PG8_MMA(1, 0, At, B0); PG8_MMA(1, 1, At, B1); PG8_BAR; PG8_SCHED;
        }
        if (wr == 0) PG8_BAR;
        E(acc, cur, wr, wc, fr, fq);
        if (!has_next) break;
#pragma unroll
        for (int a = 0; a < 2; ++a)
#pragma unroll
            for (int b = 0; b < 2; ++b)
#pragma unroll
                for (int m = 0; m < 4; ++m)
#pragma unroll
                    for (int n = 0; n < 2; ++n) acc[a][b][m][n] = (f32x4){0.f, 0.f, 0.f, 0.f};
        cur = nxt; cA = nA; cB = nB; ++ui;
        if (wr == 1) PG8_BAR;
    }
    PG8_WAIT_V(0);
    PG8_BAR;
#undef PG8_SA
#undef PG8_SB
#undef PG8_STAGE
#undef PG8_STAGEA
#undef PG8_STAGEB
#undef PG8_LDA
#undef PG8_LDB
#undef PG8_MMA
#undef PG8_WAIT_V
#undef PG8_WAIT_L
#undef PG8_BAR
#undef PG8_SCHED
}

struct EpiBf16 {
    static constexpr bool PERM = true;
    bf16_t* O; int ldc; const float* bias;
    DI void operator()(const f32x4 (&acc)[2][2][4][2], const Unit& u, int wr, int wc, int fr, int fq) const {
        const int row0 = u.r0 + wr * 64 + fr, col0 = u.c0 + wc * 32 + 8 * fq;
        f32x4 bv[2][2];
#pragma unroll
        for (int bj = 0; bj < 2; ++bj)
#pragma unroll
            for (int n = 0; n < 2; ++n) bv[bj][n] = bias ? *(const f32x4*)(bias + col0 + bj * HALF + 4 * n) : (f32x4){0.f, 0.f, 0.f, 0.f};
#pragma unroll
        for (int ai = 0; ai < 2; ++ai)
#pragma unroll
            for (int m = 0; m < 4; ++m) { bf16_t* rowp = O + (size_t)(row0 + ai * HALF + m * 16) * ldc + col0;
#pragma unroll
                for (int bj = 0; bj < 2; ++bj) { const f32x4 v0 = acc[ai][bj][m][0] + bv[bj][0], v1 = acc[ai][bj][m][1] + bv[bj][1];
                    u32x4 w; w.x = pk2(v0[0], v0[1]); w.y = pk2(v0[2], v0[3]); w.z = pk2(v1[0], v1[1]); w.w = pk2(v1[2], v1[3]);
                    *(u32x4*)(rowp + bj * HALF) = w; } }
    }
};
struct EpiF32 {
    static constexpr bool PERM = false;
    float* Y; int ldc; const float* bias;
    DI void operator()(const f32x4 (&acc)[2][2][4][2], const Unit& u, int wr, int wc, int fr, int fq) const {
        const int row0 = u.r0 + wr * 64 + fr, col0 = u.c0 + wc * 32 + 4 * fq;
        f32x4 bv[2][2];
#pragma unroll
        for (int bj = 0; bj < 2; ++bj)
#pragma unroll
            for (int n = 0; n < 2; ++n) bv[bj][n] = bias ? *(const f32x4*)(bias + col0 + bj * HALF + 16 * n) : (f32x4){0.f, 0.f, 0.f, 0.f};
#pragma unroll
        for (int ai = 0; ai < 2; ++ai)
#pragma unroll
            for (int m = 0; m < 4; ++m) { float* rowp = Y + (size_t)(row0 + ai * HALF + m * 16) * ldc + col0;
#pragma unroll
                for (int bj = 0; bj < 2; ++bj)
#pragma unroll
                    for (int n = 0; n < 2; ++n) *(f32x4*)(rowp + bj * HALF + 16 * n) = acc[ai][bj][m][n] + bv[bj][n]; }
    }
};
DI float swiglu1(float g, float lin) {
    g = fminf(g, 7.0f); lin = fminf(fmaxf(lin, -7.0f), 7.0f);
    const float s = __builtin_amdgcn_rcpf(1.0f + __builtin_amdgcn_exp2f(-1.702f * LOG2E * g));
    return g * s * (lin + 1.0f);
}
struct EpiSwiglu {
    static constexpr bool PERM = true;
    bf16_t* O; const float* bias;
    DI void operator()(const f32x4 (&acc)[2][2][4][2], const Unit& u, int wr, int wc, int fr, int fq) const {
        const int row0 = u.r0 + wr * 64 + fr, col0 = u.c0 + wc * 32 + 8 * fq;
        const float* bp = bias + (size_t)u.aux * (2 * FF) + col0;
        f32x4 bv[2][2];
#pragma unroll
        for (int bj = 0; bj < 2; ++bj)
#pragma unroll
            for (int n = 0; n < 2; ++n) bv[bj][n] = *(const f32x4*)(bp + bj * HALF + 4 * n);
#pragma unroll
        for (int ai = 0; ai < 2; ++ai)
#pragma unroll
            for (int m = 0; m < 4; ++m) { bf16_t* rowp = O + (size_t)(row0 + ai * HALF + m * 16) * FF + (col0 >> 1);
#pragma unroll
                for (int bj = 0; bj < 2; ++bj) { const f32x4 v0 = acc[ai][bj][m][0] + bv[bj][0], v1 = acc[ai][bj][m][1] + bv[bj][1];
                    u32x2 w; w.x = pk2(swiglu1(v0[0], v0[1]), swiglu1(v0[2], v0[3])); w.y = pk2(swiglu1(v1[0], v1[1]), swiglu1(v1[2], v1[3]));
                    *(u32x2*)(rowp + bj * (HALF / 2)) = w; } }
    }
};
struct EpiMoe2 {
    static constexpr bool PERM = true;
    bf16_t* O; const float* bias; const float* gate; const int* list;
    DI void operator()(const f32x4 (&acc)[2][2][4][2], const Unit& u, int wr, int wc, int fr, int fq) const {
        const int rl0 = wr * 64 + fr, col0 = u.c0 + wc * 32 + 8 * fq;
        const float* bp = bias + (size_t)u.aux * DM + col0;
        f32x4 bv[2][2];
#pragma unroll
        for (int bj = 0; bj < 2; ++bj)
#pragma unroll
            for (int n = 0; n < 2; ++n) bv[bj][n] = *(const f32x4*)(bp + bj * HALF + 4 * n);
#pragma unroll
        for (int ai = 0; ai < 2; ++ai)
#pragma unroll
            for (int m = 0; m < 4; ++m) { const int rl = rl0 + ai * HALF + m * 16;
                if (rl < u.nvalid) { const int slot = list[u.io + rl]; const float g = gate[slot]; bf16_t* rowp = O + (size_t)slot * DM + col0;
#pragma unroll
                    for (int bj = 0; bj < 2; ++bj) { const f32x4 v0 = (acc[ai][bj][m][0] + bv[bj][0]) * g, v1 = (acc[ai][bj][m][1] + bv[bj][1]) * g;
                        u32x4 w; w.x = pk2(v0[0], v0[1]); w.y = pk2(v0[2], v0[3]); w.z = pk2(v1[0], v1[1]); w.w = pk2(v1[2], v1[3]);
                        *(u32x4*)(rowp + bj * HALF) = w; } } }
    }
};
struct DenseOrder {
    int nN, nunits, G, c, r0; unsigned step;
    DI bool next(int i, Unit& u) const {
        const int L = i * G + c; if (L >= nunits) return false;
        const int pm = L / nN, pn = L - pm * nN;
        u.ao = (unsigned)pm * step; u.bo = (unsigned)pn * step; u.r0 = r0 + pm * BM; u.c0 = pn * BM; u.aux = 0; u.io = 0u; u.nvalid = 256; return true;
    }
};
template <int LGN, int BROWS>
struct MoeOrder {
    const volatile LAS unsigned* misc; int G, c;
    DI bool next(int i, Unit& u) const {
        const int L = i * G + c; const int ntile = __builtin_amdgcn_readfirstlane((int)misc[MW_TP + 32]);
        if (L >= (ntile << LGN)) return false;
        const int T = L >> LGN, pn = L & ((1 << LGN) - 1); const int e = __builtin_amdgcn_readfirstlane((int)misc[MW_TEXP + T]);
        const int mt = T - __builtin_amdgcn_readfirstlane((int)misc[MW_TP + e]); int nv = __builtin_amdgcn_readfirstlane((int)misc[MW_CN + e]) - mt * 256; if (nv > 256) nv = 256;
        u.ao = (unsigned)T * (256u * 1024u * 2u); u.bo = (unsigned)(e * BROWS + pn * 256) * (1024u * 2u); u.r0 = T * BM; u.c0 = pn * BM; u.aux = e;
        u.io = (unsigned)(e * CAP + mt * 256); u.nvalid = nv; return true;
    }
};
}

#define XB_TMO      128
#define XB_XCNT(j)  (256  + 64 * (j))
#define XB_XSUB(j)  (1280 + 64 * (j))
#define XB_XGEN(j)  (2304 + 64 * (j))
#define XB_TOP      3328
#define XB_TOPGEN   3392
#define XCD_BAR_WORDS 3456
#define XB_SPIN_CAP (1u << 18)
DI unsigned xb_ld(unsigned* p)              { return __hip_atomic_load(p, __ATOMIC_RELAXED, __HIP_MEMORY_SCOPE_AGENT); }
DI unsigned xb_add(unsigned* p, unsigned v) { return __hip_atomic_fetch_add(p, v, __ATOMIC_RELAXED, __HIP_MEMORY_SCOPE_AGENT); }
DI unsigned xb_xcc_id() { return (unsigned)__builtin_amdgcn_s_getreg((3 << 11) | 20) & 0xFu; }
#define XB_SPIN(cond, bar) do { unsigned _sp = 0; while (cond) { __builtin_amdgcn_s_sleep(1); \
    if ((++_sp & 255u) == 0u) { if (xb_ld(&(bar)[XB_TMO])) break; if (_sp > XB_SPIN_CAP) { atomicAdd(&(bar)[XB_TMO], 1u); break; } } } } while (0)
struct XcdBarrier { unsigned* bar; unsigned x; volatile LAS unsigned* st; };
DI XcdBarrier xcd_barrier_post(unsigned* bar, volatile LAS unsigned* st) {
    XcdBarrier b; b.bar = bar; b.x = xb_xcc_id(); b.st = st;
    if (threadIdx.x == 0) (void)xb_add(&bar[XB_XCNT(b.x)], 1u);
    return b;
}
DI void xcd_barrier_complete(unsigned* bar, unsigned x, unsigned& nloc, unsigned& nx) {
    const unsigned G = gridDim.x * gridDim.y * gridDim.z;
    unsigned sum, cnt, mine, sp = 0u;
    for (;;) {
        sum = 0u; cnt = 0u; mine = 0u;
#pragma unroll
        for (unsigned j = 0; j < 16; ++j) { const unsigned c = xb_ld(&bar[XB_XCNT(j)]); sum += c; cnt += (c > 0u) ? 1u : 0u; mine = (j == x) ? c : mine; }
        if (sum == G) break;
        __builtin_amdgcn_s_sleep(1);
        if ((++sp & 255u) == 0u) { if (xb_ld(&bar[XB_TMO])) break; if (sp > XB_SPIN_CAP) { atomicAdd(&bar[XB_TMO], 1u); break; } }
    }
    nloc = mine > 0u ? mine : 1u; nx = cnt > 0u ? cnt : 1u;
}
DI void xcd_barrier(const XcdBarrier& b) {
    asm volatile("s_waitcnt vmcnt(0)" ::: "memory");
    __syncthreads();
    if (threadIdx.x == 0) {
        unsigned* bar = b.bar;
        __builtin_amdgcn_s_waitcnt(0);
        unsigned nloc = b.st[0], nx = b.st[1];
        if (nloc == 0u) { xcd_barrier_complete(bar, b.x, nloc, nx); b.st[0] = nloc; b.st[1] = nx; }
        const unsigned old = xb_add(&bar[XB_XSUB(b.x)], 1u);
        const unsigned gen = old / nloc;
        if (old + 1u == (gen + 1u) * nloc) {
            __builtin_amdgcn_fence(__ATOMIC_RELEASE, "agent");
            asm volatile("s_waitcnt vmcnt(0)" ::: "memory");
            const unsigned og = xb_add(&bar[XB_TOP], 1u);
            const unsigned tg = og / nx;
            if (og + 1u == (tg + 1u) * nx) xb_add(&bar[XB_TOPGEN], 1u);
            else XB_SPIN(xb_ld(&bar[XB_TOPGEN]) == tg, bar);
            __builtin_amdgcn_fence(__ATOMIC_ACQUIRE, "agent");
            xb_add(&bar[XB_XGEN(b.x)], 1u);
            asm volatile("s_waitcnt vmcnt(0)" ::: "memory");
        } else {
            XB_SPIN(xb_ld(&bar[XB_XGEN(b.x)]) == gen, bar);
            __builtin_amdgcn_fence(__ATOMIC_ACQUIRE, "agent");
            asm volatile("s_waitcnt vmcnt(0)" ::: "memory");
        }
    }
    __syncthreads();
}

struct Args { const float* in[36]; float* out; unsigned char* ws; int ph_lo, ph_hi; };
enum { I_X = 0, I_C, I_CTX, I_CCTX, I_ADAW, I_ADAB, I_LN1G, I_LN1B, I_LN2G, I_LN2B, I_WIN_WQKV, I_WIN_BQKV, I_WIN_SINK, I_WIN_WO, I_WIN_BO,
       I_AXG_WQKV, I_AXG_QN, I_AXG_KN, I_AXG_WO, I_MLA_WQA, I_MLA_QN, I_MLA_WQB, I_MLA_WKVA, I_MLA_KVN, I_MLA_WKVB, I_MLA_WO,
       I_DIFF_WQKV, I_DIFF_LAM, I_DIFF_SUBLN, I_DIFF_WO, I_RW, I_RB, I_WIN, I_BIN, I_WOUT, I_BOUT };

struct Ctx {
    LAS unsigned char* lds; volatile LAS unsigned* misc; unsigned char* ws; int tid, lane, wave, vcu, G;
};
extern __shared__ __attribute__((aligned(16))) unsigned char lds_raw[];
DI Ctx make_ctx(unsigned char* ws, int wave_s) {
    int bx = blockIdx.x, G = gridDim.x;
    asm volatile("" : "+s"(bx), "+s"(G), "+s"(wave_s)); asm volatile("" : "+s"(ws));
    unsigned z = 0u; asm volatile("" : "+v"(z));
    const int tid = wave_s * 64 + (int)__builtin_amdgcn_mbcnt_hi(~0u, __builtin_amdgcn_mbcnt_lo(~0u, z));
    Ctx C; C.lds = (LAS unsigned char*)lds_raw; C.misc = (volatile LAS unsigned*)(C.lds + MISC_OFF); C.ws = ws;
    C.tid = tid; C.lane = tid & 63; C.wave = wave_s;
    C.G = G; C.vcu = (G % 8 == 0) ? (bx % 8) * (G / 8) + bx / 8 : bx;
    return C;
}
DI const float* inp(const Ctx& C, int i) {
    const unsigned lo = __builtin_amdgcn_readfirstlane(C.misc[MW_PTR + 2 * i]), hi = __builtin_amdgcn_readfirstlane(C.misc[MW_PTR + 2 * i + 1]);
    return (const float*)(((unsigned long long)hi << 32) | lo);
}
DI int modidx(int row) { return row < NCTX ? 8 : ((row - NCTX) >> 11); }
DI const float* modp(const Ctx& C, int l, int m, int part) { return (const float*)(C.ws + WS_MOD) + ((size_t)(l * 9 + m) * 6 + part) * DM; }

DI void sincos_acc(float ang, float& s, float& c) {
    const double x = (double)ang; const int q = (int)__builtin_rint(x * 0.6366197723675814); const double rd = x - (double)q * 1.5707963267948966;
    const float r = (float)rd, r2 = r * r;
    const float sp = r + r * r2 * (-1.6666654611e-1f + r2 * (8.3321608736e-3f + r2 * (-1.9515295891e-4f)));
    const float cp = 1.0f - 0.5f * r2 + r2 * r2 * (4.166664568298827e-2f + r2 * (-1.388731625493765e-3f + r2 * 2.443315711809948e-5f));
    switch (q & 3) { case 0: s = sp; c = cp; break; case 1: s = cp; c = -sp; break; case 2: s = -sp; c = -cp; break; default: s = -cp; c = sp; break; }
}
DI void cvt_item(const float* src, int N, bf16_t* dst, int Kd, int row_off, int k0, int n0, int lane) {
    const int n = n0 + lane; const bool valid = n < N;
    const float* sp = src + (size_t)k0 * N + (valid ? n : 0);
    float v[64];
#pragma unroll
    for (int i = 0; i < 64; ++i) v[i] = __builtin_nontemporal_load(sp + (size_t)i * N);
    if (valid) {
        bf16_t* dp = dst + (size_t)(row_off + n) * Kd + k0;
#pragma unroll
        for (int j = 0; j < 8; ++j) { u32x4 w; w.x = pk2(v[8 * j], v[8 * j + 1]); w.y = pk2(v[8 * j + 2], v[8 * j + 3]); w.z = pk2(v[8 * j + 4], v[8 * j + 5]); w.w = pk2(v[8 * j + 6], v[8 * j + 7]);
            *(u32x4*)(dp + 8 * j) = w; }
    }
}
DI bool cvt_mat(int& r, const float* src, int K, int N, bf16_t* dst, int row_off, int lane) {
    const int nb = (N + 63) >> 6, items = (K >> 6) * nb;
    if (r < items) { const int kb = r / nb, nbk = r - kb * nb; cvt_item(src, N, dst, K, row_off, kb * 64, nbk * 64, lane); return true; }
    r -= items; return false;
}
DI void phase_prologue(int wave_s, unsigned char* ws0) {
    const Ctx C = make_ctx(ws0, wave_s); unsigned char* ws = C.ws;
    if (C.vcu < 384) {
        LAS float* sv = (LAS float*)C.lds; LAS float* part = sv + 9 * 1024;
        for (int i = C.tid; i < 9 * 1024; i += 512) { const int m = i >> 10, k = i & 1023; const float c = m < 8 ? inp(C, I_C)[m * 1024 + k] : inp(C, I_CCTX)[k]; sv[i] = c / (1.0f + expf(-c)); }
        __syncthreads();
        for (int it = C.vcu; it < 384; it += C.G) {
            const int l = it / 96, cg = it - l * 96;
            const float* w = inp(C, I_ADAW) + (size_t)l * 1024 * 6144 + cg * 64 + C.lane;
            float acc[9];
#pragma unroll
            for (int m = 0; m < 9; ++m) acc[m] = 0.f;
#pragma unroll 32
            for (int kk = 0; kk < 128; ++kk) { const int k = C.wave * 128 + kk; const float wv = w[(size_t)k * 6144];
#pragma unroll
                for (int m = 0; m < 9; ++m) acc[m] += sv[m * 1024 + k] * wv; }
#pragma unroll
            for (int m = 0; m < 9; ++m) part[(C.wave * 9 + m) * 64 + C.lane] = acc[m];
            __syncthreads();
            for (int i = C.tid; i < 576; i += 512) { const int m = i >> 6, j = i & 63; float s = 0.f;
#pragma unroll
                for (int w8 = 0; w8 < 8; ++w8) s += part[(w8 * 9 + m) * 64 + j];
                const int col = cg * 64 + j; ((float*)(ws + WS_MOD))[(size_t)(l * 9 + m) * 6144 + col] = s + inp(C, I_ADAB)[l * 6144 + col]; }
            __syncthreads();
        }
    }
    {
        float* rt = (float*)(ws + WS_ROPE);
        const int total = 2048 * 2 * (16 + 32 + 8);
        for (int i = C.vcu * 512 + C.tid; i < total; i += C.G * 512) {
            int nf, base, idx = i;
            if (idx < 2048 * 2 * 16) { nf = 16; base = RT16; } else if ((idx -= 2048 * 2 * 16) < 2048 * 2 * 32) { nf = 32; base = RT32; } else { idx -= 2048 * 2 * 32; nf = 8; base = RT8; }
            const int f = idx % nf, half = (idx / nf) & 1, pos = idx / (2 * nf);
            const float pv = (float)(half == 0 ? (pos >> 6) : (pos & 63));
            const float inv = exp2f(-((float)f / (float)nf) * 13.287712379549449f);
            const float ang = pv * inv; float s, c; sincos_acc(ang, s, c);
            rt[base + idx] = c; rt[base + 2048 * 2 * nf + idx] = s;
        }
    }
    {
        bf16_t* wsm = (bf16_t*)(ws + WS_WSMALL);
        const int gw = C.vcu * 8 + C.wave, NGW = C.G * 8;
        constexpr int NI_IN = 128 * 512, NI_OUT = 128 * 256, NI_SMALL = 384 + 256 + 384 + 256 + 96 + 80 + 144 + 128 + 256 + 768 + 256;
        for (int it = gw; it < NI_IN + NI_OUT + NI_SMALL; it += NGW) {
            int r = it;
            if (r < NI_IN) { const int le = r >> 9, q = r & 511; cvt_item(inp(C, I_WIN) + (size_t)le * 1024 * 2048, 2048, (bf16_t*)(ws + WS_WIN) + (size_t)le * 2048 * 1024, 1024, 0, (q >> 5) * 64, (q & 31) * 64, C.lane); continue; }
            r -= NI_IN;
            if (r < NI_OUT) { const int le = r >> 8, q = r & 255; cvt_item(inp(C, I_WOUT) + (size_t)le * 1024 * 1024, 1024, (bf16_t*)(ws + WS_WOUT) + (size_t)le * 1024 * 1024, 1024, 0, (q >> 4) * 64, (q & 15) * 64, C.lane); continue; }
            r -= NI_OUT;
            if (cvt_mat(r, inp(C, I_WIN_WQKV), 1024, 1536, wsm + OFF_WQKV0 / 2, 0, C.lane)) continue;
            if (cvt_mat(r, inp(C, I_WIN_WO), 1024, 1024, wsm + OFF_WO0 / 2, 0, C.lane)) continue;
            if (cvt_mat(r, inp(C, I_AXG_WQKV), 1024, 1536, wsm + OFF_WQKV1 / 2, 0, C.lane)) continue;
            if (cvt_mat(r, inp(C, I_AXG_WO), 1024, 1024, wsm + OFF_WO1 / 2, 0, C.lane)) continue;
            if (cvt_mat(r, inp(C, I_MLA_WQA), 1024, 384, wsm + OFF_WA / 2, 0, C.lane)) continue;
            if (cvt_mat(r, inp(C, I_MLA_WKVA), 1024, 288, wsm + OFF_WA / 2, 384, C.lane)) continue;
            if (cvt_mat(r, inp(C, I_MLA_WQB), 384, 1536, wsm + OFF_WQB / 2, 0, C.lane)) continue;
            if (cvt_mat(r, inp(C, I_MLA_WKVB), 256, 2048, wsm + OFF_WKVB / 2, 0, C.lane)) continue;
            if (cvt_mat(r, inp(C, I_MLA_WO), 1024, 1024, wsm + OFF_WO2 / 2, 0, C.lane)) continue;
            if (cvt_mat(r, inp(C, I_DIFF_WQKV), 1024, 3072, wsm + OFF_WQKV3 / 2, 0, C.lane)) continue;
            cvt_mat(r, inp(C, I_DIFF_WO), 1024, 1024, wsm + OFF_WO3 / 2, 0, C.lane);
        }
        for (int i = C.vcu * 512 + C.tid; i < 4 * 32 * 1024; i += C.G * 512) { const int k = i & 1023, e = (i >> 10) & 31, l = i >> 15;
            const float w = inp(C, I_RW)[((size_t)l * 1024 + k) * 32 + e]; const bf16_t hi = f2bf(w); bf16_t* rwt = (bf16_t*)(ws + WS_RWT) + (size_t)l * 2 * 32 * 1024;
            rwt[e * 1024 + k] = hi; rwt[32 * 1024 + e * 1024 + k] = f2bf(w - bf2f(hi)); }
        for (int i = C.vcu * 512 + C.tid; i < 96 * 1024 / 8; i += C.G * 512) *(u32x4*)(wsm + OFF_WA / 2 + (size_t)672 * 1024 + (size_t)i * 8) = (u32x4){0u, 0u, 0u, 0u};
    }
}

DI void ld_row(const float* p, int lane, f32x4 (&v)[4]) {
#pragma unroll
    for (int j = 0; j < 4; ++j) v[j] = *(const f32x4*)(p + j * 256 + lane * 4);
}
DI void st_row(float* p, int lane, const f32x4 (&v)[4]) {
#pragma unroll
    for (int j = 0; j < 4; ++j) *(f32x4*)(p + j * 256 + lane * 4) = v[j];
}
DI void st_row_bf(bf16_t* p, int lane, const f32x4 (&v)[4]) {
#pragma unroll
    for (int j = 0; j < 4; ++j) { u32x2 w; w.x = pk2(v[j][0], v[j][1]); w.y = pk2(v[j][2], v[j][3]); *(u32x2*)(p + j * 256 + lane * 4) = w; }
}
DI void layernorm_row(f32x4 (&v)[4], const float* g, const float* b, int lane) {
    float s = 0.f;
#pragma unroll
    for (int j = 0; j < 4; ++j) s += (v[j][0] + v[j][1]) + (v[j][2] + v[j][3]);
    const float mean = wave_sum(s, lane) * (1.0f / DM); float q = 0.f;
#pragma unroll
    for (int j = 0; j < 4; ++j) { v[j] = v[j] - mean; q += (v[j][0] * v[j][0] + v[j][1] * v[j][1]) + (v[j][2] * v[j][2] + v[j][3] * v[j][3]); }
    const float rstd = 1.0f / sqrtf(wave_sum(q, lane) * (1.0f / DM) + LN_EPS);
    f32x4 gg[4], bb[4]; ld_row(g, lane, gg); ld_row(b, lane, bb);
#pragma unroll
    for (int j = 0; j < 4; ++j) v[j] = (v[j] * rstd) * gg[j] + bb[j];
}
DI void modulate_row(const f32x4 (&x)[4], const float* sh, const float* sc, int lane, f32x4 (&h)[4]) {
    f32x4 a[4], b[4]; ld_row(sc, lane, a); ld_row(sh, lane, b);
#pragma unroll
    for (int j = 0; j < 4; ++j) h[j] = x[j] * (1.0f + a[j]) + b[j];
}

DI void phase_modh0(int wave_s, unsigned char* ws_) {
    const Ctx C = make_ctx(ws_, wave_s);
    float* X = (float*)(C.ws + WS_X); bf16_t* H = (bf16_t*)(C.ws + WS_H);
    for (int row = C.vcu * 8 + C.wave; row < NT; row += C.G * 8) {
        const float* src = row < NCTX ? inp(C, I_CTX) + (size_t)row * DM : inp(C, I_X) + (size_t)(row - NCTX) * DM;
        f32x4 v[4], h[4]; ld_row(src, C.lane, v); st_row(X + (size_t)row * DM, C.lane, v);
        const int m = modidx(row); modulate_row(v, modp(C, 0, m, 0), modp(C, 0, m, 1), C.lane, h);
        st_row_bf(H + (size_t)row * DM, C.lane, h);
    }
}

template <int NF> DI void rope_heads(bf16_t* p, int nheads, int stride, const float* rt, int rtbase, int pos, int lane) {
    constexpr int CPH = 2 * (NF / 8);
    const float* ct = rt + rtbase + (size_t)pos * 2 * NF; const float* st = ct + 2048 * 2 * NF;
    for (int c = lane; c < nheads * CPH; c += 64) {
        const int hh = c / CPH, rem = c - hh * CPH, half = rem / (NF / 8), sub = rem - half * (NF / 8);
        bf16_t* x1p = p + hh * stride + half * 2 * NF + sub * 8; bf16_t* x2p = x1p + NF;
        const u32x4 a = *(const u32x4*)x1p, b = *(const u32x4*)x2p;
        const f32x4 c0 = *(const f32x4*)(ct + half * NF + sub * 8), c1 = *(const f32x4*)(ct + half * NF + sub * 8 + 4);
        const f32x4 s0 = *(const f32x4*)(st + half * NF + sub * 8), s1 = *(const f32x4*)(st + half * NF + sub * 8 + 4);
        float x1[8] = {bf_lo(a.x), bf_hi(a.x), bf_lo(a.y), bf_hi(a.y), bf_lo(a.z), bf_hi(a.z), bf_lo(a.w), bf_hi(a.w)};
        float x2[8] = {bf_lo(b.x), bf_hi(b.x), bf_lo(b.y), bf_hi(b.y), bf_lo(b.z), bf_hi(b.z), bf_lo(b.w), bf_hi(b.w)};
        float cc[8] = {c0[0], c0[1], c0[2], c0[3], c1[0], c1[1], c1[2], c1[3]}, ss[8] = {s0[0], s0[1], s0[2], s0[3], s1[0], s1[1], s1[2], s1[3]};
        float y1[8], y2[8];
#pragma unroll
        for (int i = 0; i < 8; ++i) { y1[i] = x1[i] * cc[i] - x2[i] * ss[i]; y2[i] = x1[i] * ss[i] + x2[i] * cc[i]; }
        u32x4 o1, o2; o1.x = pk2(y1[0], y1[1]); o1.y = pk2(y1[2], y1[3]); o1.z = pk2(y1[4], y1[5]); o1.w = pk2(y1[6], y1[7]);
        o2.x = pk2(y2[0], y2[1]); o2.y = pk2(y2[2], y2[3]); o2.z = pk2(y2[4], y2[5]); o2.w = pk2(y2[6], y2[7]);
        *(u32x4*)x1p = o1; *(u32x4*)x2p = o2;
    }
}
DI void vt_items(const Ctx& C, const bf16_t* src, int pitch, int col0, int hstride, int HV, int DV, bf16_t* Vt) {
    const int dvb_n = DV >> 6, items = NB * HV * dvb_n * 36;
    for (int it = C.vcu * 8 + C.wave; it < items; it += C.G * 8) {
        const int kbk = it % 36; int r = it / 36; const int dvb = r % dvb_n; r /= dvb_n; const int hv = r % HV, b = r / HV;
        const int key0 = kbk * 64;
        const int row0 = key0 < CTXL ? b * CTXL + key0 : NCTX + b * SEQ + (key0 - CTXL);
        const bf16_t* sp = src + (size_t)row0 * pitch + col0 + hv * hstride + dvb * 64 + C.lane;
        bf16_t v[64];
#pragma unroll
        for (int i = 0; i < 64; ++i) v[i] = sp[(size_t)i * pitch];
        bf16_t* dp = Vt + ((size_t)(b * HV + hv) * DV + dvb * 64 + C.lane) * NKEY + key0;
#pragma unroll
        for (int j = 0; j < 8; ++j) { u32x4 w; w.x = v[8 * j] | ((unsigned)v[8 * j + 1] << 16); w.y = v[8 * j + 2] | ((unsigned)v[8 * j + 3] << 16);
            w.z = v[8 * j + 4] | ((unsigned)v[8 * j + 5] << 16); w.w = v[8 * j + 6] | ((unsigned)v[8 * j + 7] << 16); *(u32x4*)(dp + 8 * j) = w; }
    }
}
DI int latent_pos(int row) { return (row - NCTX) & (SEQ - 1); }

DI void phase_post(int wave_s, unsigned char* ws0, int l) {
    const Ctx C = make_ctx(ws0, wave_s); unsigned char* ws = C.ws; const float* rt = (const float*)(ws + WS_ROPE);
    bf16_t* RAW = (bf16_t*)(ws + WS_RAW); bf16_t* Vt = (bf16_t*)(ws + WS_VT);
    const int gw = C.vcu * 8 + C.wave, NGW = C.G * 8;
    if (l == 0) {
        for (int row = NCTX + gw; row < NT; row += NGW) rope_heads<16>(RAW + (size_t)row * 1536, 20, 64, rt, RT16, latent_pos(row), C.lane);
        vt_items(C, RAW, 1536, 1280, 64, 4, 64, Vt);
    } else if (l == 1) {
        const float* qn = inp(C, I_AXG_QN); const float* kn = inp(C, I_AXG_KN);
        const int hs = C.lane >> 5, half = (C.lane >> 4) & 1, q2 = (C.lane & 15) * 2, d1 = half * 64 + q2, d2 = d1 + 32;
        const f32x2 gq1 = *(const f32x2*)(qn + d1), gq2 = *(const f32x2*)(qn + d2), gk1 = *(const f32x2*)(kn + d1), gk2 = *(const f32x2*)(kn + d2);
        for (int row = gw; row < NT; row += NGW) {
            bf16_t* p = RAW + (size_t)row * 1536; const bool lat = row >= NCTX;
            f32x2 cs = {1.f, 1.f}, sn = {0.f, 0.f};
            if (lat) { const int pos = latent_pos(row); cs = *(const f32x2*)(rt + RT32 + (pos * 2 + half) * 32 + q2); sn = *(const f32x2*)(rt + RT32 + 2048 * 2 * 32 + (pos * 2 + half) * 32 + q2); }
            unsigned w1[5], w2[5];
#pragma unroll
            for (int ps = 0; ps < 5; ++ps) { const int hh = ps * 2 + hs; w1[ps] = *(const unsigned*)(p + hh * 128 + d1); w2[ps] = *(const unsigned*)(p + hh * 128 + d2); }
#pragma unroll
            for (int ps = 0; ps < 5; ++ps) { const int hh = ps * 2 + hs;
                float a0 = bf_lo(w1[ps]), a1 = bf_hi(w1[ps]), b0 = bf_lo(w2[ps]), b1 = bf_hi(w2[ps]);
                float ss = (a0 * a0 + a1 * a1) + (b0 * b0 + b1 * b1);
#pragma unroll
                for (int o = 1; o < 32; o <<= 1) ss += shx(ss, o, C.lane);
                const float r = 1.0f / sqrtf(ss * (1.0f / 128.0f) + NORM_EPS);
                const bool isq = hh < 8; const f32x2 g1 = isq ? gq1 : gk1, g2 = isq ? gq2 : gk2;
                a0 = a0 * r * g1[0]; a1 = a1 * r * g1[1]; b0 = b0 * r * g2[0]; b1 = b1 * r * g2[1];
                *(unsigned*)(p + hh * 128 + d1) = pk2(a0 * cs[0] - b0 * sn[0], a1 * cs[1] - b1 * sn[1]);
                *(unsigned*)(p + hh * 128 + d2) = pk2(a0 * sn[0] + b0 * cs[0], a1 * sn[1] + b1 * cs[1]);
            }
        }
        vt_items(C, RAW, 1536, 1280, 128, 2, 128, Vt);
    } else if (l == 2) {
        bf16_t* CQ = (bf16_t*)(ws + WS_CQ); bf16_t* CKV = (bf16_t*)(ws + WS_CKV); bf16_t* KPE = (bf16_t*)(ws + WS_KPE);
        const float* qn = inp(C, I_MLA_QN); const float* kvn = inp(C, I_MLA_KVN);
        for (int row = gw; row < NT; row += NGW) {
            const bf16_t* p = RAW + (size_t)row * 768;
            float q[6], ssq = 0.f;
#pragma unroll
            for (int j = 0; j < 6; ++j) { q[j] = bf2f(p[j * 64 + C.lane]); ssq += q[j] * q[j]; }
            const float rq = 1.0f / sqrtf(wave_sum(ssq, C.lane) * (1.0f / 384.0f) + NORM_EPS);
#pragma unroll
            for (int j = 0; j < 6; ++j) CQ[(size_t)row * 384 + j * 64 + C.lane] = f2bf(q[j] * rq * qn[j * 64 + C.lane]);
            float kv[4], ssk = 0.f;
#pragma unroll
            for (int j = 0; j < 4; ++j) { kv[j] = bf2f(p[384 + j * 64 + C.lane]); ssk += kv[j] * kv[j]; }
            const float rk = 1.0f / sqrtf(wave_sum(ssk, C.lane) * (1.0f / 256.0f) + NORM_EPS);
#pragma unroll
            for (int j = 0; j < 4; ++j) CKV[(size_t)row * 256 + j * 64 + C.lane] = f2bf(kv[j] * rk * kvn[j * 64 + C.lane]);
            if (C.lane < 16) {
                const int half = C.lane >> 3, f = C.lane & 7; float x1 = bf2f(p[640 + half * 16 + f]), x2 = bf2f(p[640 + half * 16 + 8 + f]);
                float cs = 1.f, sn = 0.f;
                if (row >= NCTX) { const int pos = latent_pos(row); cs = rt[RT8 + (pos * 2 + half) * 8 + f]; sn = rt[RT8 + 2048 * 2 * 8 + (pos * 2 + half) * 8 + f]; }
                KPE[(size_t)row * 32 + half * 16 + f] = f2bf(x1 * cs - x2 * sn); KPE[(size_t)row * 32 + half * 16 + 8 + f] = f2bf(x1 * sn + x2 * cs);
            }
        }
    } else {
        for (int row = NCTX + gw; row < NT; row += NGW) rope_heads<16>(RAW + (size_t)row * 3072, 32, 64, rt, RT16, latent_pos(row), C.lane);
        vt_items(C, RAW, 3072, 2048, 128, 8, 128, Vt);
    }
}
DI void phase_postb(int wave_s, unsigned char* ws0) {
    const Ctx C = make_ctx(ws0, wave_s); unsigned char* ws = C.ws; const float* rt = (const float*)(ws + WS_ROPE);
    bf16_t* Q2 = (bf16_t*)(ws + WS_Q2); const bf16_t* KV2 = (const bf16_t*)(ws + WS_KV2); const bf16_t* KPE = (const bf16_t*)(ws + WS_KPE); bf16_t* KF = (bf16_t*)(ws + WS_KF);
    const int gw = C.vcu * 8 + C.wave, NGW = C.G * 8;
    for (int row = gw; row < NT; row += NGW) {
        if (row >= NCTX) rope_heads<8>(Q2 + (size_t)row * 1536 + 64, 16, 96, rt, RT8, latent_pos(row), C.lane);
        for (int c = C.lane; c < 192; c += 64) { const int h = c / 12, j = c - h * 12;
            const u32x4 v = j < 8 ? *(const u32x4*)(KV2 + (size_t)row * 2048 + h * 128 + j * 8) : *(const u32x4*)(KPE + (size_t)row * 32 + (j - 8) * 8);
            *(u32x4*)(KF + (size_t)row * 1536 + h * 96 + j * 8) = v; }
    }
    vt_items(C, KV2, 2048, 64, 128, 16, 64, (bf16_t*)(ws + WS_VT));
}

struct AttnP { const bf16_t* Q; int qp; const bf16_t* K; int kp; const bf16_t* Vt; bf16_t* O; int G; int HV; float cscale; const float* sink; float lam; float osc; const float* subln; };
DI int crow(int reg, int h) { return (reg & 3) + 8 * (reg >> 2) + 4 * h; }

template <int DQK, int DV, bool WIN>
DI void attn_qksm(const LAS unsigned char* kb_, const bf16x8 (&qf)[DQK / 16], f32x16 (&o)[DV / 32], bf16x8 (&pf)[2][2], float& m_run, float& l_run,
                  const float cscale, const bool domask, const int qpos, const int kp0, const int h, const int lane) {
    constexpr int KS = DQK * 2 + 16, NKS = DQK / 16, NDV = DV / 32;
    f32x16 s0, s1;
#pragma unroll
    for (int i = 0; i < 16; ++i) { s0[i] = 0.f; s1[i] = 0.f; }
    {
        constexpr int NF = 2 * NKS, KPF = 4;
        bf16x8 kf[NF];
#pragma unroll
        for (int f = 0; f < KPF && f < NF; ++f) kf[f] = *(const LAS bf16x8*)(kb_ + (f & 1) * 32 * KS + (f >> 1) * 32);
#pragma unroll
        for (int f = 0; f < NF; ++f) {
            if (f + KPF < NF) kf[f + KPF] = *(const LAS bf16x8*)(kb_ + ((f + KPF) & 1) * 32 * KS + ((f + KPF) >> 1) * 32);
            __builtin_amdgcn_sched_barrier(0);
            if (f & 1) s1 = __builtin_amdgcn_mfma_f32_32x32x16_bf16(kf[f], qf[f >> 1], s1, 0, 0, 0);
            else       s0 = __builtin_amdgcn_mfma_f32_32x32x16_bf16(kf[f], qf[f >> 1], s0, 0, 0, 0);
            __builtin_amdgcn_sched_barrier(0);
        }
    }
    if (WIN) { if (domask) {
#pragma unroll
        for (int i = 0; i < 16; ++i) { const int k0 = kp0 + crow(i, h), d0 = qpos - k0, d1 = d0 - 32;
            if (d0 > 128 || d0 < -128) s0[i] = -INFINITY; if (d1 > 128 || d1 < -128) s1[i] = -INFINITY; } } }
    float mx = -INFINITY;
#pragma unroll
    for (int i = 0; i < 16; ++i) mx = fmaxf(mx, fmaxf(s0[i], s1[i]));
    mx = fmaxf(mx, shx(mx, 32, lane)) * cscale;
    if (!__all(mx <= m_run + ATT_THR)) {
        const float m_new = fmaxf(m_run, mx);
        const float alpha = __builtin_amdgcn_exp2f(m_run - m_new);
        l_run *= alpha; m_run = m_new;
#pragma unroll
        for (int d = 0; d < NDV; ++d)
#pragma unroll
            for (int i = 0; i < 16; ++i) o[d][i] *= alpha;
    }
    float rs = 0.f;
#pragma unroll
    for (int i = 0; i < 16; ++i) { s0[i] = __builtin_amdgcn_exp2f(fmaf(s0[i], cscale, -m_run)); s1[i] = __builtin_amdgcn_exp2f(fmaf(s1[i], cscale, -m_run)); rs += s0[i] + s1[i]; }
    rs += shx(rs, 32, lane);
    l_run += rs;
#pragma unroll
    for (int s = 0; s < 2; ++s) {
        u32x4 w0, w1;
        w0.x = pk2(s0[8 * s + 0], s0[8 * s + 1]); w0.y = pk2(s0[8 * s + 2], s0[8 * s + 3]); w0.z = pk2(s0[8 * s + 4], s0[8 * s + 5]); w0.w = pk2(s0[8 * s + 6], s0[8 * s + 7]);
        w1.x = pk2(s1[8 * s + 0], s1[8 * s + 1]); w1.y = pk2(s1[8 * s + 2], s1[8 * s + 3]); w1.z = pk2(s1[8 * s + 4], s1[8 * s + 5]); w1.w = pk2(s1[8 * s + 6], s1[8 * s + 7]);
        pf[0][s] = __builtin_bit_cast(bf16x8, w0); pf[1][s] = __builtin_bit_cast(bf16x8, w1);
    }
}
template <int DV>
DI void attn_pv(const LAS unsigned char* vb_, const bf16x8 (&pf)[2][2], f32x16 (&o)[DV / 32]) {
    constexpr int VS = 144, NDV = DV / 32;
    constexpr int NFV = NDV * 4, VPF = 4;
    bf16x8 vf[NFV];
#pragma unroll
    for (int f = 0; f < VPF && f < NFV; ++f) vf[f] = *(const LAS bf16x8*)(vb_ + (f >> 2) * 32 * VS + ((f >> 1) & 1) * 64 + (f & 1) * 32);
#pragma unroll
    for (int f = 0; f < NFV; ++f) {
        if (f + VPF < NFV) vf[f + VPF] = *(const LAS bf16x8*)(vb_ + ((f + VPF) >> 2) * 32 * VS + (((f + VPF) >> 1) & 1) * 64 + ((f + VPF) & 1) * 32);
        __builtin_amdgcn_sched_barrier(0);
        o[f >> 2] = __builtin_amdgcn_mfma_f32_32x32x16_bf16(vf[f], pf[(f >> 1) & 1][f & 1], o[f >> 2], 0, 0, 0);
        __builtin_amdgcn_sched_barrier(0);
    }
}

template <int DQK, int DV, bool DIFF, bool WIN, int PD  >
DI void attn_unit(const Ctx& C, const AttnP& P, int b, int hsel, int qt, bool ctxq, unsigned long long& probe_acc) {
    constexpr int KH = DIFF ? 2 : 1, KS = DQK * 2 + 16, VS = 144, KBYTES = KH * 64 * KS, VBYTES = DV * VS, VOFF = 2 * KBYTES;
    constexpr int KCH = DQK / 8, NKC = KH * 64 * KCH, NKL = (NKC + 511) / 512, NVC = DV * 8, NVL = NVC / 512;
    constexpr int QROWS = DIFF ? 128 : 256, NKS = DQK / 16, NDV = DV / 32;
    static_assert(2 * KBYTES + 3 * VBYTES <= RING_BYTES, "attention LDS");
    const int tid = C.tid, lane = C.lane, wave = C.wave, r = lane & 31, h = lane >> 5;
    const int grp = wave >> 2;
    const int wg = DIFF ? grp : 0, wrow = (DIFF ? (wave & 3) : wave) * 32;
    const int hq = DIFF ? 2 * hsel + wg : hsel, hk0 = DIFF ? 2 * hsel : hsel / P.G, hv = DIFF ? hsel : hsel / P.G;
    const int qrow0 = ctxq ? b * CTXL : NCTX + b * SEQ + qt * QROWS;
    int t_lo = 0, t_hi = 0;
    if (!ctxq) { if (WIN) { t_lo = 4 * qt - 2; if (t_lo < 0) t_lo = 0; t_hi = 4 * qt + 6; if (t_hi > 32) t_hi = 32; } else { t_lo = 0; t_hi = 32; } }
    const int ntile = 4 + (t_hi - t_lo);
    LAS unsigned char* lds = C.lds;
    bf16x8 qf[NKS];
    { const bf16_t* qptr = P.Q + (size_t)(qrow0 + wrow + r) * P.qp + hq * DQK + 8 * h;
#pragma unroll
      for (int ks = 0; ks < NKS; ++ks) qf[ks] = *(const bf16x8*)(qptr + ks * 16); }
    u32x4 kregA[NKL], vregA[NVL], kregB[NKL], vregB[NVL];
    const bf16_t* vbase = P.Vt + (size_t)(b * P.HV + hv) * DV * NKEY;
#define ATT_LOAD(j, KR, VR) do { const int _j = (j); const int krow0 = _j < 4 ? b * CTXL + _j * 64 : NCTX + b * SEQ + (t_lo + _j - 4) * 64; const int vkey0 = _j < 4 ? _j * 64 : CTXL + (t_lo + _j - 4) * 64; \
        _Pragma("unroll") for (int i = 0; i < NKL; ++i) { const int c = tid + i * 512; if (NKC % 512 == 0 || c < NKC) { const int kh = c / (64 * KCH), rem = c - kh * (64 * KCH), key = rem / KCH, dc = rem - key * KCH; \
            KR[i] = *(const u32x4*)(P.K + (size_t)(krow0 + key) * P.kp + (hk0 + kh) * DQK + dc * 8); } } \
        _Pragma("unroll") for (int i = 0; i < NVL; ++i) { const int c = tid + i * 512; const int dv = c >> 3, kc = c & 7; VR[i] = *(const u32x4*)(vbase + (size_t)dv * NKEY + vkey0 + kc * 8); } } while (0)
#define ATT_WRITE(t, KR, VR) do { const int _w = (t); LAS unsigned char* _kb = lds + (_w & 1) * KBYTES; LAS unsigned char* _vb = lds + VOFF + (_w % 3) * VBYTES; \
        _Pragma("unroll") for (int i = 0; i < NKL; ++i) { const int c = tid + i * 512; if (NKC % 512 == 0 || c < NKC) { const int kh = c / (64 * KCH), rem = c - kh * (64 * KCH), key = rem / KCH, dc = rem - key * KCH; \
            *(LAS u32x4*)(_kb + kh * 64 * KS + key * KS + dc * 16) = KR[i]; } } \
        _Pragma("unroll") for (int i = 0; i < NVL; ++i) { const int c = tid + i * 512; const int dv = c >> 3, kc = c & 7; LAS unsigned char* d = _vb + dv * VS + (kc >> 2) * 64 + ((kc >> 1) & 1) * 32 + (kc & 1) * 8; \
            *(LAS u32x2*)d = (u32x2){VR[i].x, VR[i].y}; *(LAS u32x2*)(d + 16) = (u32x2){VR[i].z, VR[i].w}; } } while (0)
    f32x16 o[NDV];
#pragma unroll
    for (int d = 0; d < NDV; ++d)
#pragma unroll
        for (int i = 0; i < 16; ++i) o[d][i] = 0.f;
    bf16x8 pf[2][2];
#pragma unroll
    for (int i = 0; i < 2; ++i)
#pragma unroll
        for (int k = 0; k < 2; ++k) pf[i][k] = (bf16x8){0, 0, 0, 0, 0, 0, 0, 0};
    float m_run = -INFINITY, l_run = 0.f;
    const int qpos = qt * QROWS + wrow + r;
    __syncthreads();
    ATT_LOAD(0, kregA, vregA); ATT_WRITE(0, kregA, vregA);
    if (ntile > 1) ATT_LOAD(1, kregA, vregA);
    if (PD == 2) { if (ntile > 2) ATT_LOAD(2, kregB, vregB); }
    __syncthreads();
#define ATT_KPTR(t) (lds + ((t) & 1) * KBYTES + wg * 64 * KS + r * KS + 16 * h)
#define ATT_VPTR(t) (lds + VOFF + ((t) % 3) * VBYTES + r * VS + 16 * h)
#define ATT_TILE(j, KR, VR) do { const int _t = (j); const unsigned long long _p0 = (ATT_PROBE && DIFF) ? __builtin_amdgcn_s_memtime() : 0ull; \
        if (grp == 1 && _t > 0) attn_pv<DV>(ATT_VPTR(_t - 1), pf, o); \
        attn_qksm<DQK, DV, WIN>(ATT_KPTR(_t), qf, o, pf, m_run, l_run, P.cscale, WIN && !ctxq && _t >= 4, qpos, (t_lo + _t - 4) * 64, h, lane); \
        if (grp == 0) attn_pv<DV>(ATT_VPTR(_t), pf, o); \
        const unsigned long long _p1 = (ATT_PROBE && DIFF) ? __builtin_amdgcn_s_memtime() : 0ull; \
        if (_t + 1 < ntile) ATT_WRITE(_t + 1, KR, VR); \
        const unsigned long long _p2 = (ATT_PROBE && DIFF) ? __builtin_amdgcn_s_memtime() : 0ull; \
        __syncthreads(); \
        const unsigned long long _p3 = (ATT_PROBE && DIFF) ? __builtin_amdgcn_s_memtime() : 0ull; \
        if (ATT_PROBE == 1) probe_acc += _p1 - _p0; if (ATT_PROBE == 2) probe_acc += _p2 - _p1; if (ATT_PROBE == 3) probe_acc += _p3 - _p2; \
        if (_t + 1 + PD < ntile) ATT_LOAD(_t + 1 + PD, KR, VR); } while (0)
    if (PD == 2) { for (int j = 0; j < ntile; j += 2) { ATT_TILE(j, kregA, vregA); if (j + 1 < ntile) ATT_TILE(j + 1, kregB, vregB); } }
    else { for (int j = 0; j < ntile; ++j) ATT_TILE(j, kregA, vregA); }
    if (grp == 1) attn_pv<DV>(ATT_VPTR(ntile - 1), pf, o);
#undef ATT_TILE
#undef ATT_KPTR
#undef ATT_VPTR
#undef ATT_LOAD
#undef ATT_WRITE
    float lfin = l_run, fsc = 1.0f;
    if (WIN) { const float sk = P.sink[hq] * LOG2E; const float m2 = fmaxf(m_run, sk); fsc = __builtin_amdgcn_exp2f(m_run - m2); lfin = l_run * fsc + __builtin_amdgcn_exp2f(sk - m2); }
    const float inv = fsc / lfin;
    bf16_t* orow = P.O + (size_t)(qrow0 + wrow + r) * DM;
    if (!DIFF) {
#pragma unroll
        for (int d = 0; d < NDV; ++d)
#pragma unroll
            for (int g = 0; g < 4; ++g) { u32x2 w; w.x = pk2(o[d][4 * g] * inv, o[d][4 * g + 1] * inv); w.y = pk2(o[d][4 * g + 2] * inv, o[d][4 * g + 3] * inv);
                *(u32x2*)(orow + hq * DV + d * 32 + 8 * g + 4 * h) = w; }
    } else {
        LAS float* o2 = (LAS float*)lds;
        if (wg == 1) {
#pragma unroll
            for (int d = 0; d < NDV; ++d)
#pragma unroll
                for (int g = 0; g < 4; ++g) *(LAS f32x4*)(o2 + (wrow + r) * 132 + d * 32 + 8 * g + 4 * h) = (f32x4){o[d][4 * g] * inv, o[d][4 * g + 1] * inv, o[d][4 * g + 2] * inv, o[d][4 * g + 3] * inv};
        }
        __syncthreads();
        if (wg == 0) {
            float ssq = 0.f;
#pragma unroll
            for (int d = 0; d < NDV; ++d)
#pragma unroll
                for (int g = 0; g < 4; ++g) { const f32x4 t = *(const LAS f32x4*)(o2 + (wrow + r) * 132 + d * 32 + 8 * g + 4 * h);
#pragma unroll
                    for (int i = 0; i < 4; ++i) { const float v = o[d][4 * g + i] * inv - P.lam * t[i]; o[d][4 * g + i] = v; ssq += v * v; } }
            ssq += shx(ssq, 32, lane);
            const float rn = P.osc / sqrtf(ssq * (1.0f / DV) + NORM_EPS);
#pragma unroll
            for (int d = 0; d < NDV; ++d)
#pragma unroll
                for (int g = 0; g < 4; ++g) { const int dv = d * 32 + 8 * g + 4 * h; const f32x4 sg = *(const f32x4*)(P.subln + dv);
                    u32x2 w; w.x = pk2(o[d][4 * g] * rn * sg[0], o[d][4 * g + 1] * rn * sg[1]); w.y = pk2(o[d][4 * g + 2] * rn * sg[2], o[d][4 * g + 3] * rn * sg[3]);
                    *(u32x2*)(orow + hsel * DV + dv) = w; }
        }
    }
}

DI AttnP attn_base(unsigned char* ws) { AttnP P; P.Vt = (const bf16_t*)(ws + WS_VT); P.O = (bf16_t*)(ws + WS_O); P.sink = nullptr; P.lam = 0.f; P.osc = 1.f; P.subln = nullptr; return P; }
DI void ph_attn0(int wave_s, unsigned char* ws0) {
    unsigned long long pacc = 0ull;
    const Ctx C = make_ctx(ws0, wave_s); unsigned char* ws = C.ws; const float* sink = inp(C, I_WIN_SINK); AttnP P = attn_base(ws); const bf16_t* RAW = (const bf16_t*)(ws + WS_RAW);
    P.Q = RAW; P.qp = 1536; P.K = RAW + 1024; P.kp = 1536; P.G = 4; P.HV = 4; P.cscale = 0.125f * LOG2E; P.sink = sink;
    for (int u = C.vcu; u < 1024 + 128; u += C.G) {
        if (u < 1024) { const int b = u >> 7, rem = u & 127; attn_unit<64, 64, false, true, 2>(C, P, b, rem >> 3, rem & 7, false, pacc); }
        else { const int v = u - 1024; attn_unit<64, 64, false, true, 2>(C, P, v >> 4, v & 15, 0, true, pacc); }
    }
}
DI void ph_attn1(int wave_s, unsigned char* ws0) {
    unsigned long long pacc = 0ull;
    const Ctx C = make_ctx(ws0, wave_s); unsigned char* ws = C.ws; AttnP P = attn_base(ws); const bf16_t* RAW = (const bf16_t*)(ws + WS_RAW);
    P.Q = RAW; P.qp = 1536; P.K = RAW + 1024; P.kp = 1536; P.G = 4; P.HV = 2; P.cscale = 0.08838834764831845f * LOG2E;
    for (int u = C.vcu; u < 512 + 64; u += C.G) {
        if (u < 512) { const int b = u >> 6, rem = u & 63; attn_unit<128, 128, false, false, 1>(C, P, b, rem >> 3, rem & 7, false, pacc); }
        else { const int v = u - 512; attn_unit<128, 128, false, false, 1>(C, P, v >> 3, v & 7, 0, true, pacc); }
    }
}
DI void ph_attn2(int wave_s, unsigned char* ws0) {
    unsigned long long pacc = 0ull;
    const Ctx C = make_ctx(ws0, wave_s); unsigned char* ws = C.ws; AttnP P = attn_base(ws);
    P.Q = (const bf16_t*)(ws + WS_Q2); P.qp = 1536; P.K = (const bf16_t*)(ws + WS_KF); P.kp = 1536; P.G = 1; P.HV = 16; P.cscale = 0.10206207261596577f * LOG2E;
    for (int u = C.vcu; u < 1024 + 128; u += C.G) {
        if (u < 1024) { const int b = u >> 7, rem = u & 127; attn_unit<96, 64, false, false, 2>(C, P, b, rem >> 3, rem & 7, false, pacc); }
        else { const int v = u - 1024; attn_unit<96, 64, false, false, 2>(C, P, v >> 4, v & 15, 0, true, pacc); }
    }
}
DI void ph_attn3(int wave_s, unsigned char* ws0) {
    unsigned long long pacc = 0ull;
    const Ctx C = make_ctx(ws0, wave_s); unsigned char* ws = C.ws; const float* lp = inp(C, I_DIFF_LAM); const float* subln = inp(C, I_DIFF_SUBLN); AttnP P = attn_base(ws); const bf16_t* RAW = (const bf16_t*)(ws + WS_RAW);
    P.Q = RAW; P.qp = 3072; P.K = RAW + 1024; P.kp = 3072; P.G = 1; P.HV = 8; P.cscale = 0.125f * LOG2E; P.subln = subln;
    const float linit = 0.8f - 0.6f * expf(-0.3f * 3.0f);
    const float s1 = wave_sum(lp[C.lane] * lp[64 + C.lane], C.lane), s2 = wave_sum(lp[128 + C.lane] * lp[192 + C.lane], C.lane);
    P.lam = expf(s1) - expf(s2) + linit; P.osc = 1.0f - linit;
    for (int u = C.vcu; u < 1024; u += C.G) { const int b = u >> 7, rem = u & 127; attn_unit<64, 128, true, false, 2>(C, P, b, rem >> 4, rem & 15, false, pacc); }
    if (ATT_PROBE) { const unsigned long long t0 = __builtin_amdgcn_s_memtime(); while (__builtin_amdgcn_s_memtime() - t0 < pacc) __builtin_amdgcn_s_sleep(8); }
}

DI void moe_tables(const Ctx& C, int l) {
    const unsigned* cnt = (const unsigned*)(C.ws + WS_CTL) + CW_CNT + l * 32;
    __syncthreads();
    if (C.tid == 0) {
        unsigned t = 0, c = 0;
#pragma nounroll
        for (int e = 0; e < NEXP; ++e) { const unsigned n = __hip_atomic_load(cnt + e, __ATOMIC_RELAXED, __HIP_MEMORY_SCOPE_AGENT); C.misc[MW_TP + e] = t; C.misc[MW_CP + e] = c; C.misc[MW_CN + e] = n; const unsigned nt = (n + 255u) >> 8;
            for (unsigned i = 0; i < nt; ++i) C.misc[MW_TEXP + t + i] = (unsigned)e; t += nt; c += n; }
        C.misc[MW_TP + 32] = t; C.misc[MW_CP + 32] = c;
    }
    __syncthreads();
    __builtin_amdgcn_sched_barrier(0);
}

DI void ln1_rows2(const Ctx& C, int l, int row0, int row1, bool two) {
    unsigned char* ws = C.ws; float* X = (float*)(ws + WS_X); const float* Y = (const float*)(ws + WS_Y); bf16_t* H = (bf16_t*)(ws + WS_H); bf16_t* HLO = (bf16_t*)(ws + WS_HLO);
    f32x4 xa[4], ya[4], xb[4], yb[4];
    ld_row(X + (size_t)row0 * DM, C.lane, xa); ld_row(Y + (size_t)row0 * DM, C.lane, ya);
    if (two) { ld_row(X + (size_t)row1 * DM, C.lane, xb); ld_row(Y + (size_t)row1 * DM, C.lane, yb); }
#pragma unroll
    for (int rr = 0; rr < 2; ++rr) {
        if (rr == 1 && !two) break;
        const int row = rr ? row1 : row0; const int m = modidx(row);
        f32x4 x[4], g1[4], h[4]; ld_row(modp(C, l, m, 2), C.lane, g1);
#pragma unroll
        for (int j = 0; j < 4; ++j) x[j] = (rr ? xb[j] : xa[j]) * DN_ALPHA + g1[j] * (rr ? yb[j] : ya[j]);
        layernorm_row(x, inp(C, I_LN1G) + l * DM, inp(C, I_LN1B) + l * DM, C.lane);
        st_row(X + (size_t)row * DM, C.lane, x);
        modulate_row(x, modp(C, l, m, 3), modp(C, l, m, 4), C.lane, h);
#pragma unroll
        for (int j = 0; j < 4; ++j) {
            u32x2 whi; whi.x = pk2(h[j][0], h[j][1]); whi.y = pk2(h[j][2], h[j][3]);
            u32x2 wlo; wlo.x = pk2(h[j][0] - bf_lo(whi.x), h[j][1] - bf_hi(whi.x)); wlo.y = pk2(h[j][2] - bf_lo(whi.y), h[j][3] - bf_hi(whi.y));
            *(u32x2*)(H + (size_t)row * DM + j * 256 + C.lane * 4) = whi; *(u32x2*)(HLO + (size_t)row * DM + j * 256 + C.lane * 4) = wlo;
        }
    }
}
DI void phase_ln1(int wave_s, unsigned char* ws0, int l) {
    const Ctx C = make_ctx(ws0, wave_s); unsigned char* ws = C.ws;
    LAS float* part = (LAS float*)C.lds;
    LAS float* logits = part + 8 * 80 * 33;
    LAS int* lsel = (LAS int*)(logits + 80 * 33);
    LAS int* lslot = lsel + 288;
    LAS int* lrank = lslot + 288;
    LAS int* lcnt = lrank + 288;
    LAS int* lbase = lcnt + 32;
    const int rbase = l == 3 ? NCTX : 0, nrows = NT - rbase;
    const int rpb = (nrows + C.G - 1) / C.G;
    const int brow0 = rbase + C.vcu * rpb; int bn = NT - brow0; if (bn > rpb) bn = rpb; if (bn < 0) bn = 0; if (bn > 72) bn = 72;
    for (int i = C.wave; i < bn; i += 16) ln1_rows2(C, l, brow0 + i, brow0 + i + 8, i + 8 < bn);
    if (C.tid < 32) lcnt[C.tid] = 0;
    asm volatile("s_waitcnt vmcnt(0)" ::: "memory");
    __syncthreads();
    const bf16_t* H = (const bf16_t*)(ws + WS_H); const bf16_t* HLO = (const bf16_t*)(ws + WS_HLO);
    const bf16_t* RWH = (const bf16_t*)(ws + WS_RWT) + (size_t)l * 2 * 32 * 1024; const bf16_t* RWL = RWH + 32 * 1024;
    const float* rb = inp(C, I_RB) + l * NEXP; float* gate = (float*)(ws + WS_GATE);
    const int ntile = (bn + 15) >> 4;
    if (bn > 0) {
        const int fr = C.lane & 15, fq = C.lane >> 4, kw = C.wave * 128 + fq * 8;
        f32x4 acc[5][2];
#pragma unroll
        for (int t = 0; t < 5; ++t) { acc[t][0] = (f32x4){0.f, 0.f, 0.f, 0.f}; acc[t][1] = (f32x4){0.f, 0.f, 0.f, 0.f}; }
#pragma unroll
        for (int ks = 0; ks < 4; ++ks) {
            const int k0 = kw + ks * 32;
            const bf16x8 bh0 = *(const bf16x8*)(RWH + (size_t)fr * DM + k0), bl0 = *(const bf16x8*)(RWL + (size_t)fr * DM + k0);
            const bf16x8 bh1 = *(const bf16x8*)(RWH + (size_t)(16 + fr) * DM + k0), bl1 = *(const bf16x8*)(RWL + (size_t)(16 + fr) * DM + k0);
#pragma unroll
            for (int t = 0; t < 5; ++t) if (t < ntile) {
                int ar = t * 16 + fr; if (ar >= bn) ar = bn - 1;
                const bf16x8 ah = *(const bf16x8*)(H + (size_t)(brow0 + ar) * DM + k0), al = *(const bf16x8*)(HLO + (size_t)(brow0 + ar) * DM + k0);
                acc[t][0] = __builtin_amdgcn_mfma_f32_16x16x32_bf16(ah, bh0, acc[t][0], 0, 0, 0); acc[t][0] = __builtin_amdgcn_mfma_f32_16x16x32_bf16(al, bh0, acc[t][0], 0, 0, 0); acc[t][0] = __builtin_amdgcn_mfma_f32_16x16x32_bf16(ah, bl0, acc[t][0], 0, 0, 0);
                acc[t][1] = __builtin_amdgcn_mfma_f32_16x16x32_bf16(ah, bh1, acc[t][1], 0, 0, 0); acc[t][1] = __builtin_amdgcn_mfma_f32_16x16x32_bf16(al, bh1, acc[t][1], 0, 0, 0); acc[t][1] = __builtin_amdgcn_mfma_f32_16x16x32_bf16(ah, bl1, acc[t][1], 0, 0, 0);
            }
        }
        LAS float* pw = part + C.wave * 80 * 33;
#pragma unroll
        for (int t = 0; t < 5; ++t) if (t < ntile) {
#pragma unroll
            for (int i = 0; i < 4; ++i) { pw[(t * 16 + 4 * fq + i) * 33 + fr] = acc[t][0][i]; pw[(t * 16 + 4 * fq + i) * 33 + 16 + fr] = acc[t][1][i]; } }
    }
    __syncthreads();
    for (int idx = C.tid; idx < bn * 32; idx += 512) { const int r = idx >> 5, e = idx & 31; float sm = 0.f;
#pragma unroll
        for (int w = 0; w < 8; ++w) sm += part[(w * 80 + r) * 33 + e];
        logits[r * 33 + e] = sm + rb[e]; }
    __syncthreads();
    if (C.tid < bn) {
        const int r = C.tid, li = r * 4, grow = brow0 + r;
        float v0 = -INFINITY, v1 = -INFINITY, v2 = -INFINITY, v3 = -INFINITY; int i0 = 0, i1 = 0, i2 = 0, i3 = 0;
        for (int e = 0; e < 32; ++e) { const float x = logits[r * 33 + e];
            if (x > v3) { if (x > v2) { v3 = v2; i3 = i2; if (x > v1) { v2 = v1; i2 = i1; if (x > v0) { v1 = v0; i1 = i0; v0 = x; i0 = e; } else { v1 = x; i1 = e; } } else { v2 = x; i2 = e; } } else { v3 = x; i3 = e; } } }
        const float e1 = expf(v1 - v0), e2 = expf(v2 - v0), e3 = expf(v3 - v0), inv = 1.0f / (1.0f + e1 + e2 + e3);
        lsel[li] = i0; lsel[li + 1] = i1; lsel[li + 2] = i2; lsel[li + 3] = i3;
        lslot[li] = grow * 4; lslot[li + 1] = grow * 4 + 1; lslot[li + 2] = grow * 4 + 2; lslot[li + 3] = grow * 4 + 3;
        *(f32x4*)(gate + (size_t)grow * 4) = (f32x4){inv, e1 * inv, e2 * inv, e3 * inv};
    }
    __syncthreads();
    const int nsel = bn * 4;
    if (C.tid < nsel) lrank[C.tid] = __hip_atomic_fetch_add(lcnt + lsel[C.tid], 1, __ATOMIC_RELAXED, __HIP_MEMORY_SCOPE_WORKGROUP);
    __syncthreads();
    if (C.tid < 32) { const int n = lcnt[C.tid]; int base = 0;
        if (n) base = (int)__hip_atomic_fetch_add((unsigned*)(ws + WS_CTL) + CW_CNT + l * 32 + C.tid, (unsigned)n, __ATOMIC_RELAXED, __HIP_MEMORY_SCOPE_AGENT);
        lbase[C.tid] = base; }
    __syncthreads();
    if (C.tid < nsel) { const int e = lsel[C.tid]; ((int*)(ws + WS_LIST))[(size_t)e * CAP + lbase[e] + lrank[C.tid]] = lslot[C.tid]; }
    __syncthreads();
}

DI void phase_ln2(int wave_s, unsigned char* ws0, int l) {
    const Ctx C = make_ctx(ws0, wave_s); unsigned char* ws = C.ws; float* X = (float*)(ws + WS_X); bf16_t* H = (bf16_t*)(ws + WS_H); const bf16_t* YS = (const bf16_t*)(ws + WS_YS);
    const int r0 = l == 3 ? NCTX : 0;
    for (int rowa = r0 + C.vcu * 8 + C.wave; rowa < NT; rowa += 2 * C.G * 8) {
        const int rowb = rowa + C.G * 8; const bool two = rowb < NT;
        f32x4 xs[2][4], ys[2][4];
#pragma unroll
        for (int rr = 0; rr < 2; ++rr) { if (rr == 1 && !two) break; const int row = rr ? rowb : rowa;
            ld_row(X + (size_t)row * DM, C.lane, xs[rr]);
            u32x2 w[4][4];
#pragma unroll
            for (int k = 0; k < 4; ++k)
#pragma unroll
                for (int j = 0; j < 4; ++j) w[k][j] = *(const u32x2*)(YS + ((size_t)row * 4 + k) * DM + j * 256 + C.lane * 4);
#pragma unroll
            for (int j = 0; j < 4; ++j) { ys[rr][j] = (f32x4){0.f, 0.f, 0.f, 0.f};
#pragma unroll
                for (int k = 0; k < 4; ++k) ys[rr][j] += (f32x4){bf_lo(w[k][j].x), bf_hi(w[k][j].x), bf_lo(w[k][j].y), bf_hi(w[k][j].y)}; } }
#pragma unroll
        for (int rr = 0; rr < 2; ++rr) { if (rr == 1 && !two) break; const int row = rr ? rowb : rowa; const int m = modidx(row);
            f32x4 x[4], g2[4]; ld_row(modp(C, l, m, 5), C.lane, g2);
#pragma unroll
            for (int j = 0; j < 4; ++j) x[j] = xs[rr][j] * DN_ALPHA + g2[j] * ys[rr][j];
            layernorm_row(x, inp(C, I_LN2G) + l * DM, inp(C, I_LN2B) + l * DM, C.lane);
            if (l == 3) { st_row((float*)inp(C, 36) + (size_t)(row - NCTX) * DM, C.lane, x); }
            else { st_row(X + (size_t)row * DM, C.lane, x); f32x4 h[4]; modulate_row(x, modp(C, l + 1, m, 0), modp(C, l + 1, m, 1), C.lane, h); st_row_bf(H + (size_t)row * DM, C.lane, h); } }
    }
}

DI void ph_gemm_bf16(int wave_s, unsigned char* ws0, const bf16_t* A, const bf16_t* Bt, int M, int N, int K, bf16_t* out, int ldc, int bias_idx) {
    const Ctx C = make_ctx(ws0, wave_s); const float* bias = bias_idx >= 0 ? inp(C, bias_idx) : nullptr;
    pg8::DenseOrder S; S.nN = N / 256; S.nunits = (M / 256) * S.nN; S.G = C.G; S.c = C.vcu; S.r0 = 0; S.step = 256u * (unsigned)K * 2u;
    pg8::EpiBf16 E{out, ldc, bias};
    pg8::gemm_phase<false, pg8::EpiBf16, pg8::DenseOrder>(C.lds, nullptr, nullptr, C.tid, K, pg8::make_rsrc(A), pg8::make_rsrc(Bt), S, E);
}
DI void ph_gemm_wo(int wave_s, unsigned char* ws0, const bf16_t* W, int r0, int bias_idx) {
    const Ctx C = make_ctx(ws0, wave_s); unsigned char* ws = C.ws; const float* bias = bias_idx >= 0 ? inp(C, bias_idx) : nullptr;
    pg8::DenseOrder S; S.nN = 4; S.nunits = ((NT - r0) / 256) * 4; S.G = C.G; S.c = C.vcu; S.r0 = r0; S.step = 256u * 1024u * 2u;
    pg8::EpiF32 E{(float*)(ws + WS_Y), DM, bias};
    pg8::gemm_phase<false, pg8::EpiF32, pg8::DenseOrder>(C.lds, nullptr, nullptr, C.tid, 1024, pg8::make_rsrc((const bf16_t*)(ws + WS_O) + (size_t)r0 * DM), pg8::make_rsrc(W), S, E);
}
DI void ph_moe1(int wave_s, unsigned char* ws0, int l) {
    const Ctx C = make_ctx(ws0, wave_s); unsigned char* ws = C.ws; const float* b_in = inp(C, I_BIN);
    moe_tables(C, l);
    pg8::MoeOrder<3, 2048> S; S.misc = C.misc; S.G = C.G; S.c = C.vcu;
    pg8::EpiSwiglu E{(bf16_t*)(ws + WS_ACT), b_in + (size_t)l * 32 * 2048};
    pg8::gemm_phase<true, pg8::EpiSwiglu, pg8::MoeOrder<3, 2048>>(C.lds, (LAS int*)(C.lds + MISC_OFF) + MW_IDX, (const int*)(ws + WS_LIST), C.tid, 1024,
        pg8::make_rsrc(ws + WS_H), pg8::make_rsrc(ws + WS_WIN + (size_t)l * 32 * 2048 * 1024 * 2), S, E);
}
DI void ph_moe2(int wave_s, unsigned char* ws0, int l) {
    const Ctx C = make_ctx(ws0, wave_s); unsigned char* ws = C.ws; const float* b_out = inp(C, I_BOUT);
    moe_tables(C, l);
    pg8::MoeOrder<2, 1024> S; S.misc = C.misc; S.G = C.G; S.c = C.vcu;
    pg8::EpiMoe2 E{(bf16_t*)(ws + WS_YS), b_out + (size_t)l * 32 * 1024, (const float*)(ws + WS_GATE), (const int*)(ws + WS_LIST)};
    pg8::gemm_phase<false, pg8::EpiMoe2, pg8::MoeOrder<2, 1024>>(C.lds, nullptr, nullptr, C.tid, 1024,
        pg8::make_rsrc(ws + WS_ACT), pg8::make_rsrc(ws + WS_WOUT + (size_t)l * 32 * 1024 * 1024 * 2), S, E);
}

constexpr int NPHASE = 2 + 11 * DEPTH;

__global__ void __launch_bounds__(512, 2) dit_fwd(Args args) {
    {
        LAS unsigned* mz = (LAS unsigned*)((LAS unsigned char*)lds_raw + MISC_OFF);
        for (int u = threadIdx.x; u < (LDS_BYTES - MISC_OFF) / 4; u += 512) mz[u] = 0u;
        __syncthreads();
        if (threadIdx.x == 0) {
#pragma unroll
            for (int i = 0; i < 36; ++i) { const unsigned long long p = (unsigned long long)args.in[i]; mz[MW_PTR + 2 * i] = (unsigned)p; mz[MW_PTR + 2 * i + 1] = (unsigned)(p >> 32); }
            const unsigned long long p = (unsigned long long)args.out; mz[MW_PTR + 72] = (unsigned)p; mz[MW_PTR + 73] = (unsigned)(p >> 32);
        }
        __syncthreads();
    }
    const int wave_s = __builtin_amdgcn_readfirstlane((int)threadIdx.x >> 6);
    const int lo = args.ph_lo, hi = args.ph_hi;
    unsigned char* ws = args.ws;
    XcdBarrier bar; bar.bar = (unsigned*)(ws + WS_CTL) + CW_BAR; bar.x = 0; bar.st = nullptr;
    if (hi - lo > 1) bar = xcd_barrier_post((unsigned*)(ws + WS_CTL) + CW_BAR, (volatile LAS unsigned*)((LAS unsigned char*)lds_raw + MISC_OFF) + 8);
#define IN(k) (lo <= (k) && (k) < hi)
#define SEAM(k) do { if ((k) + 1 < hi) xcd_barrier(bar); } while (0)
    bf16_t* wsm = (bf16_t*)(ws + WS_WSMALL);
    if (IN(0)) { PREP(0) phase_prologue(wave_s, ws); SEAM(0); }
    if (IN(1)) { phase_modh0(wave_s, ws); SEAM(1); }
    for (int l = 0; l < DEPTH; ++l) {
        const int pb = 2 + 11 * l;
        if (IN(pb + 0)) {
            const bf16_t* W = wsm + (l == 0 ? OFF_WQKV0 : l == 1 ? OFF_WQKV1 : l == 2 ? OFF_WA : OFF_WQKV3) / 2;
            const int N = l == 2 ? 768 : (l == 3 ? 3072 : 1536);
            PREP(1) ph_gemm_bf16(wave_s, ws, (const bf16_t*)(ws + WS_H), W, NT, N, 1024, (bf16_t*)(ws + WS_RAW), N, l == 0 ? (int)I_WIN_BQKV : -1);
            SEAM(pb + 0);
        }
        if (IN(pb + 1)) { phase_post(wave_s, ws, l); SEAM(pb + 1); }
        if (l == 2) {
            if (IN(pb + 2)) {
                PREP(1) for (int j = 0; j < 2; ++j)
                    ph_gemm_bf16(wave_s, ws, (const bf16_t*)(ws + (j == 0 ? WS_CQ : WS_CKV)), wsm + (j == 0 ? OFF_WQB : OFF_WKVB) / 2, NT, j == 0 ? 1536 : 2048, j == 0 ? 384 : 256,
                                 (bf16_t*)(ws + (j == 0 ? WS_Q2 : WS_KV2)), j == 0 ? 1536 : 2048, -1);
                SEAM(pb + 2);
            }
            if (IN(pb + 3)) { phase_postb(wave_s, ws); SEAM(pb + 3); }
        }
        if (IN(pb + 4)) {
            PREP(2) if (l == 0) ph_attn0(wave_s, ws); else if (l == 1) ph_attn1(wave_s, ws); else if (l == 2) ph_attn2(wave_s, ws); else ph_attn3(wave_s, ws);
            SEAM(pb + 4);
        }
        if (IN(pb + 5)) {
            const bf16_t* W = wsm + (l == 0 ? OFF_WO0 : l == 1 ? OFF_WO1 : l == 2 ? OFF_WO2 : OFF_WO3) / 2;
            PREP(3) ph_gemm_wo(wave_s, ws, W, l == 3 ? NCTX : 0, l == 0 ? (int)I_WIN_BO : -1);
            SEAM(pb + 5);
        }
        if (IN(pb + 6)) { phase_ln1(wave_s, ws, l); SEAM(pb + 6); }
        if (IN(pb + 8)) { PREP(5) ph_moe1(wave_s, ws, l); SEAM(pb + 8); }
        if (IN(pb + 9)) { PREP(6) ph_moe2(wave_s, ws, l); SEAM(pb + 9); }
        if (IN(pb + 10)) { phase_ln2(wave_s, ws, l); SEAM(pb + 10); }
    }
#undef IN
#undef SEAM
}

extern "C" void kernel_launch(void* const* d_in, const int* in_sizes, int n_in, void* d_out, int out_size, void* d_ws, size_t ws_size, hipStream_t stream) {
    static int grid = 0;
    if (grid == 0) {
        if (n_in != 36 || out_size != NB * SEQ * DM || ws_size < WS_END) { fprintf(stderr, "kernel_launch: unexpected shapes (n_in %d out %d ws %zu need %zu)\n", n_in, out_size, ws_size, (size_t)WS_END); grid = -1; return; }
        int dev = 0, cus = 0, per_cu = 0;
        if (hipGetDevice(&dev) != hipSuccess || hipDeviceGetAttribute(&cus, hipDeviceAttributeMultiprocessorCount, dev) != hipSuccess) { grid = -1; return; }
        if (hipFuncSetAttribute((const void*)dit_fwd, hipFuncAttributeMaxDynamicSharedMemorySize, LDS_BYTES) != hipSuccess) { fprintf(stderr, "kernel_launch: hipFuncSetAttribute failed\n"); grid = -1; return; }
        if (hipOccupancyMaxActiveBlocksPerMultiprocessor(&per_cu, (const void*)dit_fwd, 512, LDS_BYTES) != hipSuccess || per_cu < 1) fprintf(stderr, "kernel_launch: occupancy query says %d\n", per_cu);
        (void)hipGetLastError();
        grid = cus;
    }
    if (grid < 0) return;
    (void)hipMemsetAsync((char*)d_ws + WS_CTL, 0, CTL_BYTES, stream);
    Args a{};
    for (int i = 0; i < 36; ++i) a.in[i] = (const float*)d_in[i];
    a.out = (float*)d_out; a.ws = (unsigned char*)d_ws;
#if MK_PER_PHASE
    for (int ph = 0; ph < NPHASE; ++ph) {
        const int l = ph < 2 ? 0 : (ph - 2) / 11, s = ph < 2 ? 0 : (ph - 2) % 11;
        if (ph >= 2 && (s == 2 || s == 3) && l != 2) continue;
        a.ph_lo = ph; a.ph_hi = ph + 1;
        hipLaunchKernelGGL(dit_fwd, dim3(grid), dim3(512), LDS_BYTES, stream, a);
    }
#else
    a.ph_lo = 0; a.ph_hi = NPHASE;
    hipLaunchKernelGGL(dit_fwd, dim3(grid), dim3(512), LDS_BYTES, stream, a);
#endif
    const hipError_t le = hipPeekAtLastError();
    if (le != hipSuccess) fprintf(stderr, "kernel_launch: launch failed: %s\n", hipGetErrorName(le));
}
```

```cpp
#include <hip/hip_runtime.h>
#include <cstdio>
#include <cstdint>

#ifndef MK_PER_PHASE
#define MK_PER_PHASE 0
#endif

#ifndef PROBE_DOUBLE
#define PROBE_DOUBLE 0
#endif
#ifndef ATT_PROBE
#define ATT_PROBE 0
#endif
#define PREP(bit) for (int rep_ = 0; rep_ < 1 + ((PROBE_DOUBLE >> (bit)) & 1); ++rep_)
#define DI __device__ __forceinline__
#define GAS __attribute__((address_space(1)))
#define LAS __attribute__((address_space(3)))
typedef unsigned short bf16_t;
typedef short bf16x8 __attribute__((ext_vector_type(8)));
typedef float f32x2 __attribute__((ext_vector_type(2)));
typedef float f32x4 __attribute__((ext_vector_type(4)));
typedef float f32x16 __attribute__((ext_vector_type(16)));
typedef unsigned u32x2 __attribute__((ext_vector_type(2)));
typedef unsigned u32x4 __attribute__((ext_vector_type(4)));
typedef __bf16 bfv2 __attribute__((ext_vector_type(2)));

DI unsigned pk2(float lo, float hi) { f32x2 v = {lo, hi}; return __builtin_bit_cast(unsigned, __builtin_convertvector(v, bfv2)); }
DI float bf_lo(unsigned w) { return __uint_as_float(w << 16); }
DI float bf_hi(unsigned w) { return __uint_as_float(w & 0xffff0000u); }
DI float bf2f(bf16_t h) { return __uint_as_float((unsigned)h << 16); }
DI bf16_t f2bf(float f) { return (bf16_t)(pk2(f, 0.f) & 0xffffu); }
DI float shx(float v, int m, int lane) { return __int_as_float(__builtin_amdgcn_ds_bpermute((lane ^ m) << 2, __float_as_int(v))); }
DI float wave_sum(float v, int lane) {
#pragma unroll
    for (int o = 1; o < 64; o <<= 1) v += shx(v, o, lane);
    return v;
}

constexpr int NB = 8, SEQ = 2048, CTXL = 256, DM = 1024, DEPTH = 4;
constexpr int NCTX = NB * CTXL;
constexpr int NT = NCTX + NB * SEQ;
constexpr int NKEY = CTXL + SEQ;
constexpr int NEXP = 32, FF = 1024, CAP = NT;
constexpr int MAXT = 320;
constexpr float DN_ALPHA = 1.681792830507429f;
constexpr float LN_EPS = 1e-5f, NORM_EPS = 1e-6f;
constexpr float LOG2E = 1.4426950408889634f;
constexpr float ATT_THR = 8.0f;

constexpr size_t MiB = 1u << 20;
constexpr size_t WS_CTL = 0, CTL_BYTES = 1 * MiB;
constexpr size_t WS_MOD = 1 * MiB;
constexpr size_t WS_ROPE = 2 * MiB;
constexpr size_t WS_WSMALL = 4 * MiB;
constexpr size_t OFF_WQKV0 = 0, OFF_WO0 = 3 * MiB, OFF_WQKV1 = 5 * MiB, OFF_WO1 = 8 * MiB, OFF_WA = 10 * MiB, OFF_WQB = 12 * MiB,
                 OFF_WKVB = 14 * MiB, OFF_WO2 = 15 * MiB, OFF_WQKV3 = 17 * MiB, OFF_WO3 = 23 * MiB;
constexpr size_t WS_WIN = 32 * MiB;
constexpr size_t WS_WOUT = WS_WIN + 512 * MiB;
constexpr size_t WS_X = WS_WOUT + 256 * MiB;
constexpr size_t WS_H = WS_X + 72 * MiB;
constexpr size_t WS_RAW = WS_H + 36 * MiB;
constexpr size_t WS_CQ = WS_RAW + 108 * MiB;
constexpr size_t WS_CKV = WS_CQ + 14 * MiB;
constexpr size_t WS_KPE = WS_CKV + 9 * MiB;
constexpr size_t WS_Q2 = WS_KPE + 2 * MiB;
constexpr size_t WS_KV2 = WS_Q2 + 54 * MiB;
constexpr size_t WS_KF = WS_KV2 + 72 * MiB;
constexpr size_t WS_VT = WS_KF + 54 * MiB;
constexpr size_t WS_O = WS_VT + 36 * MiB;
constexpr size_t WS_Y = WS_O + 36 * MiB;
constexpr size_t WS_LIST = WS_Y + 72 * MiB;
constexpr size_t WS_GATE = WS_LIST + 3 * MiB;
constexpr size_t WS_POS = WS_GATE + 1 * MiB;
constexpr size_t WS_GS = WS_POS + 1 * MiB;
constexpr size_t WS_HS = WS_GS + 1 * MiB;
constexpr size_t WS_ACT = WS_HS + 160 * MiB;
constexpr size_t WS_YS = WS_ACT + 160 * MiB;
constexpr size_t WS_HLO = WS_YS + 160 * MiB;
constexpr size_t WS_RWT = WS_HLO + 36 * MiB;
constexpr size_t WS_END = WS_RWT + 1 * MiB;
constexpr int CW_CNT = 64;
constexpr int CW_BAR = 4096;

constexpr int RT16 = 0, RT32 = RT16 + 2 * 2048 * 2 * 16, RT8 = RT32 + 2 * 2048 * 2 * 32, RT_END = RT8 + 2 * 2048 * 2 * 8;

constexpr int RING_BYTES = 131072;
constexpr int MISC_OFF = RING_BYTES;
constexpr int LDS_BYTES = 147456;
constexpr int MW_TP = 64, MW_CP = 128, MW_TEXP = 192, MW_PTR = 512, MW_CN = 600, MW_IDX = 1024;

namespace pg8 {
constexpr int BM = 256, BK = 64, HALF = 128, HTB = HALF * BK * 2, STAGE_BYTES = 8 * HTB;
__host__ __device__ __forceinline__ int lds_byte(int r, int c) { const int st = (r >> 4) * 2 + (c >> 5), rr = r & 15, cc = c & 31, ob = rr * 64 + cc * 2; return st * 1024 + (ob ^ (((ob >> 9) & 1) << 5)); }
__host__ __device__ __forceinline__ void stage_rc(int b, int& R, int& C) { const int st = b / 1024, sb = b % 1024, swz = sb ^ (((sb >> 9) & 1) << 5); R = (st >> 1) * 16 + swz / 64; C = (st & 1) * 32 + (swz % 64) / 2; }
__host__ __device__ __forceinline__ int perm32(int rho) { const int n = rho >> 4, i = rho & 15; return 8 * (i >> 2) + 4 * n + (i & 3); }

struct Unit { unsigned ao, bo; int r0, c0, aux; unsigned io; int nvalid; };
typedef __amdgpu_buffer_rsrc_t rsrc_t;
DI rsrc_t make_rsrc(const void* base) { return __builtin_amdgcn_make_buffer_rsrc((void*)base, 0, 0x7fffffff, 0x00020000); }

template <bool GATHER, class Epi, class Sched>
__device__ __forceinline__ void gemm_phase(LAS unsigned char* lds, LAS int* idxbuf, const int* list, const int tid, const int K, const rsrc_t rsA, const rsrc_t rsB, const Sched& S, const Epi& E) {
    const int wid = __builtin_amdgcn_readfirstlane(tid >> 6), lane = tid & 63, wr = wid >> 2, wc = wid & 3, fr = lane & 15, fq = lane >> 4;
    const int nt = K / BK;
    unsigned voffA[2], voffB[2], offc[2][2];
#pragma unroll
    for (int i = 0; i < 2; ++i) { int R, C; stage_rc(tid * 16 + i * 8192, R, C); const int Rb = Epi::PERM ? ((R & ~31) + perm32(R & 31)) : R;
        voffA[i] = (unsigned)(R * K + C) * 2u; voffB[i] = (unsigned)(Rb * K + C) * 2u; offc[0][i] = 0u; offc[1][i] = 0u; }
    const unsigned hstep = (unsigned)(HALF * K * 2);
    const unsigned ldsw = (unsigned)wid * 1024u;
    const int aoff = lds_byte(wr * 64 + fr, fq * 8), boff = lds_byte(wc * 32 + fr, fq * 8);
#define PG8_SA(b, h) (((b) * 2 + (h)) * HTB)
#define PG8_SB(b, h) ((4 + (b) * 2 + (h)) * HTB)
#define PG8_STAGE(rs, bufoff, soff, voff) do { _Pragma("unroll") for (int _i = 0; _i < 2; ++_i) \
        __builtin_amdgcn_raw_ptr_buffer_load_lds((rs), (LAS void*)(lds + (bufoff) + ldsw + _i * 8192), 16, (voff)[_i], (soff), 0, 0); } while (0)
#define PG8_STAGEA(b, h, ub, kt) do { if constexpr (GATHER) PG8_STAGE(rsA, PG8_SA(b, h), (unsigned)(kt) * 128u, offc[h]); else PG8_STAGE(rsA, PG8_SA(b, h), (ub) + (unsigned)(h) * hstep + (unsigned)(kt) * 128u, voffA); } while (0)
#define PG8_STAGEB(b, h, ub, kt) PG8_STAGE(rsB, PG8_SB(b, h), (ub) + (unsigned)(h) * hstep + (unsigned)(kt) * 128u, voffB)
#define PG8_LDA(dst, b, h) do { _Pragma("unroll") for (int m = 0; m < 4; ++m) _Pragma("unroll") for (int k = 0; k < 2; ++k) dst[m][k] = *(const LAS bf16x8*)(lds + PG8_SA(b, h) + aoff + m * 2048 + k * 1024); } while (0)
#define PG8_LDB(dst, b, h) do { _Pragma("unroll") for (int n = 0; n < 2; ++n) _Pragma("unroll") for (int k = 0; k < 2; ++k) dst[n][k] = *(const LAS bf16x8*)(lds + PG8_SB(b, h) + boff + n * 2048 + k * 1024); } while (0)
#define PG8_MMA(ai, bj, At, Bt) do { __builtin_amdgcn_s_setprio(1); _Pragma("unroll") for (int m = 0; m < 4; ++m) _Pragma("unroll") for (int n = 0; n < 2; ++n) _Pragma("unroll") for (int k = 0; k < 2; ++k) \
        acc[ai][bj][m][n] = __builtin_amdgcn_mfma_f32_16x16x32_bf16(Bt[n][k], At[m][k], acc[ai][bj][m][n], 0, 0, 0); __builtin_amdgcn_s_setprio(0); } while (0)
#define PG8_WAIT_V(n) asm volatile("s_waitcnt vmcnt(" #n ")" ::: "memory")
#define PG8_WAIT_L(n) asm volatile("s_waitcnt lgkmcnt(" #n ")" ::: "memory")
#define PG8_BAR __builtin_amdgcn_s_barrier()
#define PG8_SCHED __builtin_amdgcn_sched_barrier(0)
    Unit cur, nxt; int ui = 0;
    if (!S.next(0, cur)) return;
    if constexpr (GATHER) {
#pragma unroll
        for (int h = 0; h < 2; ++h)
#pragma unroll
            for (int i = 0; i < 2; ++i) { int R, C; stage_rc(tid * 16 + i * 8192, R, C); const int r = h * HALF + R; const int sl = r < cur.nvalid ? list[cur.io + r] : 0; offc[h][i] = (unsigned)(sl >> 2) * (unsigned)(K * 2) + (unsigned)C * 2u; }
    }
    f32x4 acc[2][2][4][2];
#pragma unroll
    for (int a = 0; a < 2; ++a)
#pragma unroll
        for (int b = 0; b < 2; ++b)
#pragma unroll
            for (int m = 0; m < 4; ++m)
#pragma unroll
                for (int n = 0; n < 2; ++n) acc[a][b][m][n] = (f32x4){0.f, 0.f, 0.f, 0.f};
    bf16x8 At[4][2], B0[2][2], B1[2][2];
    unsigned cA = cur.ao, cB = cur.bo;
    PG8_STAGEB(0, 0, cB, 0); PG8_STAGEB(0, 1, cB, 0); PG8_STAGEA(0, 0, cA, 0); PG8_STAGEA(0, 1, cA, 0);
    if (wr == 1) PG8_BAR;
    PG8_WAIT_V(2); PG8_BAR;
    PG8_STAGEB(1, 0, cB, 1); PG8_STAGEA(1, 0, cA, 1); PG8_STAGEB(1, 1, cB, 1);
    PG8_WAIT_V(6); PG8_BAR;
    for (;;) {
        const bool has_next = S.next(ui + 1, nxt);
        const unsigned nA = has_next ? nxt.ao : cA, nB = has_next ? nxt.bo : cB;
        if constexpr (GATHER) { if (has_next && wid == 0) __builtin_amdgcn_global_load_lds((const unsigned*)(list + nxt.io + lane * 4), (LAS unsigned*)idxbuf, 16, 0, 0); }
        for (int t = 0; t < nt; t += 2) {
            const bool last = (t == nt - 2);
            const unsigned a2 = last ? nA : cA, b2 = last ? nB : cB; const int kt2 = last ? 0 : t + 2;
            PG8_LDB(B0, 0, 0); PG8_LDB(B1, 0, 1); PG8_SCHED; PG8_LDA(At, 0, 0); PG8_STAGEA(1, 1, cA, t + 1);
            PG8_WAIT_V(8); PG8_WAIT_L(0); PG8_BAR; PG8_MMA(0, 0, At, B0); PG8_MMA(0, 1, At, B1); PG8_BAR; PG8_SCHED;
            if constexpr (GATHER) { if (last && has_next) {
#pragma unroll
                for (int h = 0; h < 2; ++h)
#pragma unroll
                    for (int i = 0; i < 2; ++i) { int R, C; stage_rc(tid * 16 + i * 8192, R, C); const int r = h * HALF + R; const int sl = r < nxt.nvalid ? idxbuf[r] : 0; offc[h][i] = (unsigned)(sl >> 2) * (unsigned)(K * 2) + (unsigned)C * 2u; }
            } }
            PG8_LDA(At, 0, 1); PG8_STAGEB(0, 0, b2, kt2); PG8_STAGEB(0, 1, b2, kt2); PG8_STAGEA(0, 0, a2, kt2);
            PG8_WAIT_V(8); PG8_WAIT_L(0); PG8_BAR; PG8_MMA(1, 0, At, B0); PG8_MMA(1, 1, At, B1); PG8_BAR; PG8_SCHED;
            PG8_LDB(B0, 1, 0); PG8_LDB(B1, 1, 1); PG8_SCHED; PG8_LDA(At, 1, 0); PG8_STAGEA(0, 1, a2, kt2);
            PG8_WAIT_V(8); PG8_WAIT_L(0); PG8_BAR; PG8_MMA(0, 0, At, B0); PG8_MMA(0, 1, At, B1); PG8_BAR; PG8_SCHED;
            PG8_LDA(At, 1, 1); PG8_STAGEB(1, 0, b2, kt2 + 1); PG8_STAGEB(1, 1, b2, kt2 + 1); PG8_STAGEA(1, 0, a2, kt2 + 1);
            PG8_WAIT_V(8); PG8_WAIT_L(0); PG8_BAR; PG8_MMA(1, 0, At, B0); PG8_MMA(1, 1, At, B1); PG8_BAR; PG8_SCHED;
        }
        if (wr == 0) PG8_BAR;
        E(acc, cur, wr, wc, fr, fq);
        if (!has_next) break;
#pragma unroll
        for (int a = 0; a < 2; ++a)
#pragma unroll
            for (int b = 0; b < 2; ++b)
#pragma unroll
                for (int m = 0; m < 4; ++m)
#pragma unroll
                    for (int n = 0; n < 2; ++n) acc[a][b][m][n] = (f32x4){0.f, 0.f, 0.f, 0.f};
        cur = nxt; cA = nA; cB = nB; ++ui;
        if (wr == 1) PG8_BAR;
    }
    PG8_WAIT_V(0);
    PG8_BAR;
#undef PG8_SA
#undef PG8_SB
#undef PG8_STAGE
#undef PG8_STAGEA
#undef PG8_STAGEB
#undef PG8_LDA
#undef PG8_LDB
#undef PG8_MMA
#undef PG8_WAIT_V
#undef PG8_WAIT_L
#undef PG8_BAR
#undef PG8_SCHED
}

struct EpiBf16 {
    static constexpr bool PERM = true;
    bf16_t* O; int ldc; const float* bias;
    DI void operator()(const f32x4 (&acc)[2][2][4][2], const Unit& u, int wr, int wc, int fr, int fq) const {
        const int row0 = u.r0 + wr * 64 + fr, col0 = u.c0 + wc * 32 + 8 * fq;
        f32x4 bv[2][2];
#pragma unroll
        for (int bj = 0; bj < 2; ++bj)
#pragma unroll
            for (int n = 0; n < 2; ++n) bv[bj][n] = bias ? *(const f32x4*)(bias + col0 + bj * HALF + 4 * n) : (f32x4){0.f, 0.f, 0.f, 0.f};
#pragma unroll
        for (int ai = 0; ai < 2; ++ai)
#pragma unroll
            for (int m = 0; m < 4; ++m) { bf16_t* rowp = O + (size_t)(row0 + ai * HALF + m * 16) * ldc + col0;
#pragma unroll
                for (int bj = 0; bj < 2; ++bj) { const f32x4 v0 = acc[ai][bj][m][0] + bv[bj][0], v1 = acc[ai][bj][m][1] + bv[bj][1];
                    u32x4 w; w.x = pk2(v0[0], v0[1]); w.y = pk2(v0[2], v0[3]); w.z = pk2(v1[0], v1[1]); w.w = pk2(v1[2], v1[3]);
                    *(u32x4*)(rowp + bj * HALF) = w; } }
    }
};
struct EpiF32 {
    static constexpr bool PERM = false;
    float* Y; int ldc; const float* bias;
    DI void operator()(const f32x4 (&acc)[2][2][4][2], const Unit& u, int wr, int wc, int fr, int fq) const {
        const int row0 = u.r0 + wr * 64 + fr, col0 = u.c0 + wc * 32 + 4 * fq;
        f32x4 bv[2][2];
#pragma unroll
        for (int bj = 0; bj < 2; ++bj)
#pragma unroll
            for (int n = 0; n < 2; ++n) bv[bj][n] = bias ? *(const f32x4*)(bias + col0 + bj * HALF + 16 * n) : (f32x4){0.f, 0.f, 0.f, 0.f};
#pragma unroll
        for (int ai = 0; ai < 2; ++ai)
#pragma unroll
            for (int m = 0; m < 4; ++m) { float* rowp = Y + (size_t)(row0 + ai * HALF + m * 16) * ldc + col0;
#pragma unroll
                for (int bj = 0; bj < 2; ++bj)
#pragma unroll
                    for (int n = 0; n < 2; ++n) *(f32x4*)(rowp + bj * HALF + 16 * n) = acc[ai][bj][m][n] + bv[bj][n]; }
    }
};
DI float swiglu1(float g, float lin) {
    g = fminf(g, 7.0f); lin = fminf(fmaxf(lin, -7.0f), 7.0f);
    const float s = __builtin_amdgcn_rcpf(1.0f + __builtin_amdgcn_exp2f(-1.702f * LOG2E * g));
    return g * s * (lin + 1.0f);
}
struct EpiSwiglu {
    static constexpr bool PERM = true;
    bf16_t* O; const float* bias;
    DI void operator()(const f32x4 (&acc)[2][2][4][2], const Unit& u, int wr, int wc, int fr, int fq) const {
        const int row0 = u.r0 + wr * 64 + fr, col0 = u.c0 + wc * 32 + 8 * fq;
        const float* bp = bias + (size_t)u.aux * (2 * FF) + col0;
        f32x4 bv[2][2];
#pragma unroll
        for (int bj = 0; bj < 2; ++bj)
#pragma unroll
            for (int n = 0; n < 2; ++n) bv[bj][n] = *(const f32x4*)(bp + bj * HALF + 4 * n);
#pragma unroll
        for (int ai = 0; ai < 2; ++ai)
#pragma unroll
            for (int m = 0; m < 4; ++m) { bf16_t* rowp = O + (size_t)(row0 + ai * HALF + m * 16) * FF + (col0 >> 1);
#pragma unroll
                for (int bj = 0; bj < 2; ++bj) { const f32x4 v0 = acc[ai][bj][m][0] + bv[bj][0], v1 = acc[ai][bj][m][1] + bv[bj][1];
                    u32x2 w; w.x = pk2(swiglu1(v0[0], v0[1]), swiglu1(v0[2], v0[3])); w.y = pk2(swiglu1(v1[0], v1[1]), swiglu1(v1[2], v1[3]));
                    *(u32x2*)(rowp + bj * (HALF / 2)) = w; } }
    }
};
struct EpiMoe2 {
    static constexpr bool PERM = true;
    bf16_t* O; const float* bias; const float* gate; const int* list;
    DI void operator()(const f32x4 (&acc)[2][2][4][2], const Unit& u, int wr, int wc, int fr, int fq) const {
        const int rl0 = wr * 64 + fr, col0 = u.c0 + wc * 32 + 8 * fq;
        const float* bp = bias + (size_t)u.aux * DM + col0;
        f32x4 bv[2][2];
#pragma unroll
        for (int bj = 0; bj < 2; ++bj)
#pragma unroll
            for (int n = 0; n < 2; ++n) bv[bj][n] = *(const f32x4*)(bp + bj * HALF + 4 * n);
#pragma unroll
        for (int ai = 0; ai < 2; ++ai)
#pragma unroll
            for (int m = 0; m < 4; ++m) { const int rl = rl0 + ai * HALF + m * 16;
                if (rl < u.nvalid) { const int slot = list[u.io + rl]; const float g = gate[slot]; bf16_t* rowp = O + (size_t)slot * DM + col0;
#pragma unroll
                    for (int bj = 0; bj < 2; ++bj) { const f32x4 v0 = (acc[ai][bj][m][0] + bv[bj][0]) * g, v1 = (acc[ai][bj][m][1] + bv[bj][1]) * g;
                        u32x4 w; w.x = pk2(v0[0], v0[1]); w.y = pk2(v0[2], v0[3]); w.z = pk2(v1[0], v1[1]); w.w = pk2(v1[2], v1[3]);
                        *(u32x4*)(rowp + bj * HALF) = w; } } }
    }
};
struct DenseOrder {
    int nN, nunits, G, c, r0; unsigned step;
    DI bool next(int i, Unit& u) const {
        const int L = i * G + c; if (L >= nunits) return false;
        const int pm = L / nN, pn = L - pm * nN;
        u.ao = (unsigned)pm * step; u.bo = (unsigned)pn * step; u.r0 = r0 + pm * BM; u.c0 = pn * BM; u.aux = 0; u.io = 0u; u.nvalid = 256; return true;
    }
};
template <int LGN, int BROWS>
struct MoeOrder {
    const volatile LAS unsigned* misc; int G, c;
    DI bool next(int i, Unit& u) const {
        const int L = i * G + c; const int ntile = __builtin_amdgcn_readfirstlane((int)misc[MW_TP + 32]);
        if (L >= (ntile << LGN)) return false;
        const int T = L >> LGN, pn = L & ((1 << LGN) - 1); const int e = __builtin_amdgcn_readfirstlane((int)misc[MW_TEXP + T]);
        const int mt = T - __builtin_amdgcn_readfirstlane((int)misc[MW_TP + e]); int nv = __builtin_amdgcn_readfirstlane((int)misc[MW_CN + e]) - mt * 256; if (nv > 256) nv = 256;
        u.ao = (unsigned)T * (256u * 1024u * 2u); u.bo = (unsigned)(e * BROWS + pn * 256) * (1024u * 2u); u.r0 = T * BM; u.c0 = pn * BM; u.aux = e;
        u.io = (unsigned)(e * CAP + mt * 256); u.nvalid = nv; return true;
    }
};
}

#define XB_TMO      128
#define XB_XCNT(j)  (256  + 64 * (j))
#define XB_XSUB(j)  (1280 + 64 * (j))
#define XB_XGEN(j)  (2304 + 64 * (j))
#define XB_TOP      3328
#define XB_TOPGEN   3392
#define XCD_BAR_WORDS 3456
#define XB_SPIN_CAP (1u << 18)
DI unsigned xb_ld(unsigned* p)              { return __hip_atomic_load(p, __ATOMIC_RELAXED, __HIP_MEMORY_SCOPE_AGENT); }
DI unsigned xb_add(unsigned* p, unsigned v) { return __hip_atomic_fetch_add(p, v, __ATOMIC_RELAXED, __HIP_MEMORY_SCOPE_AGENT); }
DI unsigned xb_xcc_id() { return (unsigned)__builtin_amdgcn_s_getreg((3 << 11) | 20) & 0xFu; }
#define XB_SPIN(cond, bar) do { unsigned _sp = 0; while (cond) { __builtin_amdgcn_s_sleep(1); \
    if ((++_sp & 255u) == 0u) { if (xb_ld(&(bar)[XB_TMO])) break; if (_sp > XB_SPIN_CAP) { atomicAdd(&(bar)[XB_TMO], 1u); break; } } } } while (0)
struct XcdBarrier { unsigned* bar; unsigned x; volatile LAS unsigned* st; };
DI XcdBarrier xcd_barrier_post(unsigned* bar, volatile LAS unsigned* st) {
    XcdBarrier b; b.bar = bar; b.x = xb_xcc_id(); b.st = st;
    if (threadIdx.x == 0) (void)xb_add(&bar[XB_XCNT(b.x)], 1u);
    return b;
}
DI void xcd_barrier_complete(unsigned* bar, unsigned x, unsigned& nloc, unsigned& nx) {
    const unsigned G = gridDim.x * gridDim.y * gridDim.z;
    unsigned sum, cnt, mine, sp = 0u;
    for (;;) {
        sum = 0u; cnt = 0u; mine = 0u;
#pragma unroll
        for (unsigned j = 0; j < 16; ++j) { const unsigned c = xb_ld(&bar[XB_XCNT(j)]); sum += c; cnt += (c > 0u) ? 1u : 0u; mine = (j == x) ? c : mine; }
        if (sum == G) break;
        __builtin_amdgcn_s_sleep(1);
        if ((++sp & 255u) == 0u) { if (xb_ld(&bar[XB_TMO])) break; if (sp > XB_SPIN_CAP) { atomicAdd(&bar[XB_TMO], 1u); break; } }
    }
    nloc = mine > 0u ? mine : 1u; nx = cnt > 0u ? cnt : 1u;
}
DI void xcd_barrier(const XcdBarrier& b) {
    asm volatile("s_waitcnt vmcnt(0)" ::: "memory");
    __syncthreads();
    if (threadIdx.x == 0) {
        unsigned* bar = b.bar;
        __builtin_amdgcn_s_waitcnt(0);
        unsigned nloc = b.st[0], nx = b.st[1];
        if (nloc == 0u) { xcd_barrier_complete(bar, b.x, nloc, nx); b.st[0] = nloc; b.st[1] = nx; }
        const unsigned old = xb_add(&bar[XB_XSUB(b.x)], 1u);
        const unsigned gen = old / nloc;
        if (old + 1u == (gen + 1u) * nloc) {
            __builtin_amdgcn_fence(__ATOMIC_RELEASE, "agent");
            asm volatile("s_waitcnt vmcnt(0)" ::: "memory");
            const unsigned og = xb_add(&bar[XB_TOP], 1u);
            const unsigned tg = og / nx;
            if (og + 1u == (tg + 1u) * nx) xb_add(&bar[XB_TOPGEN], 1u);
            else XB_SPIN(xb_ld(&bar[XB_TOPGEN]) == tg, bar);
            __builtin_amdgcn_fence(__ATOMIC_ACQUIRE, "agent");
            xb_add(&bar[XB_XGEN(b.x)], 1u);
            asm volatile("s_waitcnt vmcnt(0)" ::: "memory");
        } else {
            XB_SPIN(xb_ld(&bar[XB_XGEN(b.x)]) == gen, bar);
            __builtin_amdgcn_fence(__ATOMIC_ACQUIRE, "agent");
            asm volatile("s_waitcnt vmcnt(0)" ::: "memory");
        }
    }
    __syncthreads();
}

struct Args { const float* in[36]; float* out; unsigned char* ws; int ph_lo, ph_hi; };
enum { I_X = 0, I_C, I_CTX, I_CCTX, I_ADAW, I_ADAB, I_LN1G, I_LN1B, I_LN2G, I_LN2B, I_WIN_WQKV, I_WIN_BQKV, I_WIN_SINK, I_WIN_WO, I_WIN_BO,
       I_AXG_WQKV, I_AXG_QN, I_AXG_KN, I_AXG_WO, I_MLA_WQA, I_MLA_QN, I_MLA_WQB, I_MLA_WKVA, I_MLA_KVN, I_MLA_WKVB, I_MLA_WO,
       I_DIFF_WQKV, I_DIFF_LAM, I_DIFF_SUBLN, I_DIFF_WO, I_RW, I_RB, I_WIN, I_BIN, I_WOUT, I_BOUT };

struct Ctx {
    LAS unsigned char* lds; volatile LAS unsigned* misc; unsigned char* ws; int tid, lane, wave, vcu, G;
};
extern __shared__ __attribute__((aligned(16))) unsigned char lds_raw[];
DI Ctx make_ctx(unsigned char* ws, int wave_s) {
    int bx = blockIdx.x, G = gridDim.x;
    asm volatile("" : "+s"(bx), "+s"(G), "+s"(wave_s)); GAS unsigned char* gws = (GAS unsigned char*)ws; asm volatile("" : "+s"(gws));
    unsigned z = 0u; asm volatile("" : "+v"(z));
    const int tid = wave_s * 64 + (int)__builtin_amdgcn_mbcnt_hi(~0u, __builtin_amdgcn_mbcnt_lo(~0u, z));
    Ctx C; C.lds = (LAS unsigned char*)lds_raw; C.misc = (volatile LAS unsigned*)(C.lds + MISC_OFF); C.ws = (unsigned char*)gws;
    C.tid = tid; C.lane = tid & 63; C.wave = wave_s;
    C.G = G; C.vcu = (G % 8 == 0) ? (bx % 8) * (G / 8) + bx / 8 : bx;
    return C;
}
DI const float* inp(const Ctx& C, int i) {
    const unsigned lo = __builtin_amdgcn_readfirstlane(C.misc[MW_PTR + 2 * i]), hi = __builtin_amdgcn_readfirstlane(C.misc[MW_PTR + 2 * i + 1]);
    return (const float*)(const GAS float*)(((unsigned long long)hi << 32) | lo);
}
DI int modidx(int row) { return row < NCTX ? 8 : ((row - NCTX) >> 11); }
DI const float* modp(const Ctx& C, int l, int m, int part) { return (const float*)(C.ws + WS_MOD) + ((size_t)(l * 9 + m) * 6 + part) * DM; }

DI void sincos_acc(float ang, float& s, float& c) {
    const double x = (double)ang; const int q = (int)__builtin_rint(x * 0.6366197723675814); const double rd = x - (double)q * 1.5707963267948966;
    const float r = (float)rd, r2 = r * r;
    const float sp = r + r * r2 * (-1.6666654611e-1f + r2 * (8.3321608736e-3f + r2 * (-1.9515295891e-4f)));
    const float cp = 1.0f - 0.5f * r2 + r2 * r2 * (4.166664568298827e-2f + r2 * (-1.388731625493765e-3f + r2 * 2.443315711809948e-5f));
    switch (q & 3) { case 0: s = sp; c = cp; break; case 1: s = cp; c = -sp; break; case 2: s = -sp; c = -cp; break; default: s = -cp; c = sp; break; }
}
DI void cvt_item(const float* src, int N, bf16_t* dst, int Kd, int row_off, int k0, int n0, int lane) {
    const int n = n0 + lane; const bool valid = n < N;
    const float* sp = src + (size_t)k0 * N + (valid ? n : 0);
    float v[64];
#pragma unroll
    for (int i = 0; i < 64; ++i) v[i] = __builtin_nontemporal_load(sp + (size_t)i * N);
    if (valid) {
        bf16_t* dp = dst + (size_t)(row_off + n) * Kd + k0;
#pragma unroll
        for (int j = 0; j < 8; ++j) { u32x4 w; w.x = pk2(v[8 * j], v[8 * j + 1]); w.y = pk2(v[8 * j + 2], v[8 * j + 3]); w.z = pk2(v[8 * j + 4], v[8 * j + 5]); w.w = pk2(v[8 * j + 6], v[8 * j + 7]);
            *(u32x4*)(dp + 8 * j) = w; }
    }
}
DI bool cvt_mat(int& r, const float* src, int K, int N, bf16_t* dst, int row_off, int lane) {
    const int nb = (N + 63) >> 6, items = (K >> 6) * nb;
    if (r < items) { const int kb = r / nb, nbk = r - kb * nb; cvt_item(src, N, dst, K, row_off, kb * 64, nbk * 64, lane); return true; }
    r -= items; return false;
}
DI void phase_prologue(int wave_s, unsigned char* ws0) {
    const Ctx C = make_ctx(ws0, wave_s); unsigned char* ws = C.ws;
    if (C.vcu < 384) {
        LAS float* sv = (LAS float*)C.lds; LAS float* part = sv + 9 * 1024;
        for (int i = C.tid; i < 9 * 1024; i += 512) { const int m = i >> 10, k = i & 1023; const float c = m < 8 ? inp(C, I_C)[m * 1024 + k] : inp(C, I_CCTX)[k]; sv[i] = c / (1.0f + expf(-c)); }
        __syncthreads();
        for (int it = C.vcu; it < 384; it += C.G) {
            const int l = it / 96, cg = it - l * 96;
            const float* w = inp(C, I_ADAW) + (size_t)l * 1024 * 6144 + cg * 64 + C.lane;
            float acc[9];
#pragma unroll
            for (int m = 0; m < 9; ++m) acc[m] = 0.f;
#pragma unroll 32
            for (int kk = 0; kk < 128; ++kk) { const int k = C.wave * 128 + kk; const float wv = w[(size_t)k * 6144];
#pragma unroll
                for (int m = 0; m < 9; ++m) acc[m] += sv[m * 1024 + k] * wv; }
#pragma unroll
            for (int m = 0; m < 9; ++m) part[(C.wave * 9 + m) * 64 + C.lane] = acc[m];
            __syncthreads();
            for (int i = C.tid; i < 576; i += 512) { const int m = i >> 6, j = i & 63; float s = 0.f;
#pragma unroll
                for (int w8 = 0; w8 < 8; ++w8) s += part[(w8 * 9 + m) * 64 + j];
                const int col = cg * 64 + j; ((float*)(ws + WS_MOD))[(size_t)(l * 9 + m) * 6144 + col] = s + inp(C, I_ADAB)[l * 6144 + col]; }
            __syncthreads();
        }
    }
    {
        float* rt = (float*)(ws + WS_ROPE);
        const int total = 2048 * 2 * (16 + 32 + 8);
        for (int i = C.vcu * 512 + C.tid; i < total; i += C.G * 512) {
            int nf, base, idx = i;
            if (idx < 2048 * 2 * 16) { nf = 16; base = RT16; } else if ((idx -= 2048 * 2 * 16) < 2048 * 2 * 32) { nf = 32; base = RT32; } else { idx -= 2048 * 2 * 32; nf = 8; base = RT8; }
            const int f = idx % nf, half = (idx / nf) & 1, pos = idx / (2 * nf);
            const float pv = (float)(half == 0 ? (pos >> 6) : (pos & 63));
            const float inv = exp2f(-((float)f / (float)nf) * 13.287712379549449f);
            const float ang = pv * inv; float s, c; sincos_acc(ang, s, c);
            rt[base + idx] = c; rt[base + 2048 * 2 * nf + idx] = s;
        }
    }
    {
        bf16_t* wsm = (bf16_t*)(ws + WS_WSMALL);
        const int gw = C.vcu * 8 + C.wave, NGW = C.G * 8;
        constexpr int NI_IN = 128 * 512, NI_OUT = 128 * 256, NI_SMALL = 384 + 256 + 384 + 256 + 96 + 80 + 144 + 128 + 256 + 768 + 256;
        for (int it = gw; it < NI_IN + NI_OUT + NI_SMALL; it += NGW) {
            int r = it;
            if (r < NI_IN) { const int le = r >> 9, q = r & 511; cvt_item(inp(C, I_WIN) + (size_t)le * 1024 * 2048, 2048, (bf16_t*)(ws + WS_WIN) + (size_t)le * 2048 * 1024, 1024, 0, (q >> 5) * 64, (q & 31) * 64, C.lane); continue; }
            r -= NI_IN;
            if (r < NI_OUT) { const int le = r >> 8, q = r & 255; cvt_item(inp(C, I_WOUT) + (size_t)le * 1024 * 1024, 1024, (bf16_t*)(ws + WS_WOUT) + (size_t)le * 1024 * 1024, 1024, 0, (q >> 4) * 64, (q & 15) * 64, C.lane); continue; }
            r -= NI_OUT;
            if (cvt_mat(r, inp(C, I_WIN_WQKV), 1024, 1536, wsm + OFF_WQKV0 / 2, 0, C.lane)) continue;
            if (cvt_mat(r, inp(C, I_WIN_WO), 1024, 1024, wsm + OFF_WO0 / 2, 0, C.lane)) continue;
            if (cvt_mat(r, inp(C, I_AXG_WQKV), 1024, 1536, wsm + OFF_WQKV1 / 2, 0, C.lane)) continue;
            if (cvt_mat(r, inp(C, I_AXG_WO), 1024, 1024, wsm + OFF_WO1 / 2, 0, C.lane)) continue;
            if (cvt_mat(r, inp(C, I_MLA_WQA), 1024, 384, wsm + OFF_WA / 2, 0, C.lane)) continue;
            if (cvt_mat(r, inp(C, I_MLA_WKVA), 1024, 288, wsm + OFF_WA / 2, 384, C.lane)) continue;
            if (cvt_mat(r, inp(C, I_MLA_WQB), 384, 1536, wsm + OFF_WQB / 2, 0, C.lane)) continue;
            if (cvt_mat(r, inp(C, I_MLA_WKVB), 256, 2048, wsm + OFF_WKVB / 2, 0, C.lane)) continue;
            if (cvt_mat(r, inp(C, I_MLA_WO), 1024, 1024, wsm + OFF_WO2 / 2, 0, C.lane)) continue;
            if (cvt_mat(r, inp(C, I_DIFF_WQKV), 1024, 3072, wsm + OFF_WQKV3 / 2, 0, C.lane)) continue;
            cvt_mat(r, inp(C, I_DIFF_WO), 1024, 1024, wsm + OFF_WO3 / 2, 0, C.lane);
        }
        for (int i = C.vcu * 512 + C.tid; i < 4 * 32 * 1024; i += C.G * 512) { const int k = i & 1023, e = (i >> 10) & 31, l = i >> 15;
            const float w = inp(C, I_RW)[((size_t)l * 1024 + k) * 32 + e]; const bf16_t hi = f2bf(w); bf16_t* rwt = (bf16_t*)(ws + WS_RWT) + (size_t)l * 2 * 32 * 1024;
            rwt[e * 1024 + k] = hi; rwt[32 * 1024 + e * 1024 + k] = f2bf(w - bf2f(hi)); }
        for (int i = C.vcu * 512 + C.tid; i < 96 * 1024 / 8; i += C.G * 512) *(u32x4*)(wsm + OFF_WA / 2 + (size_t)672 * 1024 + (size_t)i * 8) = (u32x4){0u, 0u, 0u, 0u};
    }
}

DI void ld_row(const float* p, int lane, f32x4 (&v)[4]) {
#pragma unroll
    for (int j = 0; j < 4; ++j) v[j] = *(const f32x4*)(p + j * 256 + lane * 4);
}
DI void st_row(float* p, int lane, const f32x4 (&v)[4]) {
#pragma unroll
    for (int j = 0; j < 4; ++j) *(f32x4*)(p + j * 256 + lane * 4) = v[j];
}
DI void st_row_bf(bf16_t* p, int lane, const f32x4 (&v)[4]) {
#pragma unroll
    for (int j = 0; j < 4; ++j) { u32x2 w; w.x = pk2(v[j][0], v[j][1]); w.y = pk2(v[j][2], v[j][3]); *(u32x2*)(p + j * 256 + lane * 4) = w; }
}
DI void layernorm_row(f32x4 (&v)[4], const float* g, const float* b, int lane) {
    float s = 0.f;
#pragma unroll
    for (int j = 0; j < 4; ++j) s += (v[j][0] + v[j][1]) + (v[j][2] + v[j][3]);
    const float mean = wave_sum(s, lane) * (1.0f / DM); float q = 0.f;
#pragma unroll
    for (int j = 0; j < 4; ++j) { v[j] = v[j] - mean; q += (v[j][0] * v[j][0] + v[j][1] * v[j][1]) + (v[j][2] * v[j][2] + v[j][3] * v[j][3]); }
    const float rstd = 1.0f / sqrtf(wave_sum(q, lane) * (1.0f / DM) + LN_EPS);
    f32x4 gg[4], bb[4]; ld_row(g, lane, gg); ld_row(b, lane, bb);
#pragma unroll
    for (int j = 0; j < 4; ++j) v[j] = (v[j] * rstd) * gg[j] + bb[j];
}
DI void modulate_row(const f32x4 (&x)[4], const float* sh, const float* sc, int lane, f32x4 (&h)[4]) {
    f32x4 a[4], b[4]; ld_row(sc, lane, a); ld_row(sh, lane, b);
#pragma unroll
    for (int j = 0; j < 4; ++j) h[j] = x[j] * (1.0f + a[j]) + b[j];
}

DI void phase_modh0(int wave_s, unsigned char* ws_) {
    const Ctx C = make_ctx(ws_, wave_s);
    float* X = (float*)(C.ws + WS_X); bf16_t* H = (bf16_t*)(C.ws + WS_H);
    for (int row = C.vcu * 8 + C.wave; row < NT; row += C.G * 8) {
        const float* src = row < NCTX ? inp(C, I_CTX) + (size_t)row * DM : inp(C, I_X) + (size_t)(row - NCTX) * DM;
        f32x4 v[4], h[4]; ld_row(src, C.lane, v); st_row(X + (size_t)row * DM, C.lane, v);
        const int m = modidx(row); modulate_row(v, modp(C, 0, m, 0), modp(C, 0, m, 1), C.lane, h);
        st_row_bf(H + (size_t)row * DM, C.lane, h);
    }
}

template <int NF> DI void rope_heads(bf16_t* p, int nheads, int stride, const float* rt, int rtbase, int pos, int lane) {
    constexpr int CPH = 2 * (NF / 8);
    const float* ct = rt + rtbase + (size_t)pos * 2 * NF; const float* st = ct + 2048 * 2 * NF;
    for (int c = lane; c < nheads * CPH; c += 64) {
        const int hh = c / CPH, rem = c - hh * CPH, half = rem / (NF / 8), sub = rem - half * (NF / 8);
        bf16_t* x1p = p + hh * stride + half * 2 * NF + sub * 8; bf16_t* x2p = x1p + NF;
        const u32x4 a = *(const u32x4*)x1p, b = *(const u32x4*)x2p;
        const f32x4 c0 = *(const f32x4*)(ct + half * NF + sub * 8), c1 = *(const f32x4*)(ct + half * NF + sub * 8 + 4);
        const f32x4 s0 = *(const f32x4*)(st + half * NF + sub * 8), s1 = *(const f32x4*)(st + half * NF + sub * 8 + 4);
        float x1[8] = {bf_lo(a.x), bf_hi(a.x), bf_lo(a.y), bf_hi(a.y), bf_lo(a.z), bf_hi(a.z), bf_lo(a.w), bf_hi(a.w)};
        float x2[8] = {bf_lo(b.x), bf_hi(b.x), bf_lo(b.y), bf_hi(b.y), bf_lo(b.z), bf_hi(b.z), bf_lo(b.w), bf_hi(b.w)};
        float cc[8] = {c0[0], c0[1], c0[2], c0[3], c1[0], c1[1], c1[2], c1[3]}, ss[8] = {s0[0], s0[1], s0[2], s0[3], s1[0], s1[1], s1[2], s1[3]};
        float y1[8], y2[8];
#pragma unroll
        for (int i = 0; i < 8; ++i) { y1[i] = x1[i] * cc[i] - x2[i] * ss[i]; y2[i] = x1[i] * ss[i] + x2[i] * cc[i]; }
        u32x4 o1, o2; o1.x = pk2(y1[0], y1[1]); o1.y = pk2(y1[2], y1[3]); o1.z = pk2(y1[4], y1[5]); o1.w = pk2(y1[6], y1[7]);
        o2.x = pk2(y2[0], y2[1]); o2.y = pk2(y2[2], y2[3]); o2.z = pk2(y2[4], y2[5]); o2.w = pk2(y2[6], y2[7]);
        *(u32x4*)x1p = o1; *(u32x4*)x2p = o2;
    }
}
DI void vt_items(const Ctx& C, const bf16_t* src, int pitch, int col0, int hstride, int HV, int DV, bf16_t* Vt) {
    const int dvb_n = DV >> 6, items = NB * HV * dvb_n * 36;
    for (int it = C.vcu * 8 + C.wave; it < items; it += C.G * 8) {
        const int kbk = it % 36; int r = it / 36; const int dvb = r % dvb_n; r /= dvb_n; const int hv = r % HV, b = r / HV;
        const int key0 = kbk * 64;
        const int row0 = key0 < CTXL ? b * CTXL + key0 : NCTX + b * SEQ + (key0 - CTXL);
        const bf16_t* sp = src + (size_t)row0 * pitch + col0 + hv * hstride + dvb * 64 + C.lane;
        bf16_t v[64];
#pragma unroll
        for (int i = 0; i < 64; ++i) v[i] = sp[(size_t)i * pitch];
        bf16_t* dp = Vt + ((size_t)(b * HV + hv) * DV + dvb * 64 + C.lane) * NKEY + key0;
#pragma unroll
        for (int j = 0; j < 8; ++j) { u32x4 w; w.x = v[8 * j] | ((unsigned)v[8 * j + 1] << 16); w.y = v[8 * j + 2] | ((unsigned)v[8 * j + 3] << 16);
            w.z = v[8 * j + 4] | ((unsigned)v[8 * j + 5] << 16); w.w = v[8 * j + 6] | ((unsigned)v[8 * j + 7] << 16); *(u32x4*)(dp + 8 * j) = w; }
    }
}
DI int latent_pos(int row) { return (row - NCTX) & (SEQ - 1); }

DI void phase_post(int wave_s, unsigned char* ws0, int l) {
    const Ctx C = make_ctx(ws0, wave_s); unsigned char* ws = C.ws; const float* rt = (const float*)(ws + WS_ROPE);
    bf16_t* RAW = (bf16_t*)(ws + WS_RAW); bf16_t* Vt = (bf16_t*)(ws + WS_VT);
    const int gw = C.vcu * 8 + C.wave, NGW = C.G * 8;
    if (l == 0) {
        for (int row = NCTX + gw; row < NT; row += NGW) rope_heads<16>(RAW + (size_t)row * 1536, 20, 64, rt, RT16, latent_pos(row), C.lane);
        vt_items(C, RAW, 1536, 1280, 64, 4, 64, Vt);
    } else if (l == 1) {
        const float* qn = inp(C, I_AXG_QN); const float* kn = inp(C, I_AXG_KN);
        const int hs = C.lane >> 5, half = (C.lane >> 4) & 1, q2 = (C.lane & 15) * 2, d1 = half * 64 + q2, d2 = d1 + 32;
        const f32x2 gq1 = *(const f32x2*)(qn + d1), gq2 = *(const f32x2*)(qn + d2), gk1 = *(const f32x2*)(kn + d1), gk2 = *(const f32x2*)(kn + d2);
        for (int row = gw; row < NT; row += NGW) {
            bf16_t* p = RAW + (size_t)row * 1536; const bool lat = row >= NCTX;
            f32x2 cs = {1.f, 1.f}, sn = {0.f, 0.f};
            if (lat) { const int pos = latent_pos(row); cs = *(const f32x2*)(rt + RT32 + (pos * 2 + half) * 32 + q2); sn = *(const f32x2*)(rt + RT32 + 2048 * 2 * 32 + (pos * 2 + half) * 32 + q2); }
            unsigned w1[5], w2[5];
#pragma unroll
            for (int ps = 0; ps < 5; ++ps) { const int hh = ps * 2 + hs; w1[ps] = *(const unsigned*)(p + hh * 128 + d1); w2[ps] = *(const unsigned*)(p + hh * 128 + d2); }
#pragma unroll
            for (int ps = 0; ps < 5; ++ps) { const int hh = ps * 2 + hs;
                float a0 = bf_lo(w1[ps]), a1 = bf_hi(w1[ps]), b0 = bf_lo(w2[ps]), b1 = bf_hi(w2[ps]);
                float ss = (a0 * a0 + a1 * a1) + (b0 * b0 + b1 * b1);
#pragma unroll
                for (int o = 1; o < 32; o <<= 1) ss += shx(ss, o, C.lane);
                const float r = 1.0f / sqrtf(ss * (1.0f / 128.0f) + NORM_EPS);
                const bool isq = hh < 8; const f32x2 g1 = isq ? gq1 : gk1, g2 = isq ? gq2 : gk2;
                a0 = a0 * r * g1[0]; a1 = a1 * r * g1[1]; b0 = b0 * r * g2[0]; b1 = b1 * r * g2[1];
                *(unsigned*)(p + hh * 128 + d1) = pk2(a0 * cs[0] - b0 * sn[0], a1 * cs[1] - b1 * sn[1]);
                *(unsigned*)(p + hh * 128 + d2) = pk2(a0 * sn[0] + b0 * cs[0], a1 * sn[1] + b1 * cs[1]);
            }
        }
        vt_items(C, RAW, 1536, 1280, 128, 2, 128, Vt);
    } else if (l == 2) {
        bf16_t* CQ = (bf16_t*)(ws + WS_CQ); bf16_t* CKV = (bf16_t*)(ws + WS_CKV); bf16_t* KPE = (bf16_t*)(ws + WS_KPE);
        const float* qn = inp(C, I_MLA_QN); const float* kvn = inp(C, I_MLA_KVN);
        for (int row = gw; row < NT; row += NGW) {
            const bf16_t* p = RAW + (size_t)row * 768;
            float q[6], ssq = 0.f;
#pragma unroll
            for (int j = 0; j < 6; ++j) { q[j] = bf2f(p[j * 64 + C.lane]); ssq += q[j] * q[j]; }
            const float rq = 1.0f / sqrtf(wave_sum(ssq, C.lane) * (1.0f / 384.0f) + NORM_EPS);
#pragma unroll
            for (int j = 0; j < 6; ++j) CQ[(size_t)row * 384 + j * 64 + C.lane] = f2bf(q[j] * rq * qn[j * 64 + C.lane]);
            float kv[4], ssk = 0.f;
#pragma unroll
            for (int j = 0; j < 4; ++j) { kv[j] = bf2f(p[384 + j * 64 + C.lane]); ssk += kv[j] * kv[j]; }
            const float rk = 1.0f / sqrtf(wave_sum(ssk, C.lane) * (1.0f / 256.0f) + NORM_EPS);
#pragma unroll
            for (int j = 0; j < 4; ++j) CKV[(size_t)row * 256 + j * 64 + C.lane] = f2bf(kv[j] * rk * kvn[j * 64 + C.lane]);
            if (C.lane < 16) {
                const int half = C.lane >> 3, f = C.lane & 7; float x1 = bf2f(p[640 + half * 16 + f]), x2 = bf2f(p[640 + half * 16 + 8 + f]);
                float cs = 1.f, sn = 0.f;
                if (row >= NCTX) { const int pos = latent_pos(row); cs = rt[RT8 + (pos * 2 + half) * 8 + f]; sn = rt[RT8 + 2048 * 2 * 8 + (pos * 2 + half) * 8 + f]; }
                KPE[(size_t)row * 32 + half * 16 + f] = f2bf(x1 * cs - x2 * sn); KPE[(size_t)row * 32 + half * 16 + 8 + f] = f2bf(x1 * sn + x2 * cs);
            }
        }
    } else {
        for (int row = NCTX + gw; row < NT; row += NGW) rope_heads<16>(RAW + (size_t)row * 3072, 32, 64, rt, RT16, latent_pos(row), C.lane);
        vt_items(C, RAW, 3072, 2048, 128, 8, 128, Vt);
    }
}
DI void phase_postb(int wave_s, unsigned char* ws0) {
    const Ctx C = make_ctx(ws0, wave_s); unsigned char* ws = C.ws; const float* rt = (const float*)(ws + WS_ROPE);
    bf16_t* Q2 = (bf16_t*)(ws + WS_Q2); const bf16_t* KV2 = (const bf16_t*)(ws + WS_KV2); const bf16_t* KPE = (const bf16_t*)(ws + WS_KPE); bf16_t* KF = (bf16_t*)(ws + WS_KF);
    const int gw = C.vcu * 8 + C.wave, NGW = C.G * 8;
    for (int row = gw; row < NT; row += NGW) {
        if (row >= NCTX) rope_heads<8>(Q2 + (size_t)row * 1536 + 64, 16, 96, rt, RT8, latent_pos(row), C.lane);
        for (int c = C.lane; c < 192; c += 64) { const int h = c / 12, j = c - h * 12;
            const u32x4 v = j < 8 ? *(const u32x4*)(KV2 + (size_t)row * 2048 + h * 128 + j * 8) : *(const u32x4*)(KPE + (size_t)row * 32 + (j - 8) * 8);
            *(u32x4*)(KF + (size_t)row * 1536 + h * 96 + j * 8) = v; }
    }
    vt_items(C, KV2, 2048, 64, 128, 16, 64, (bf16_t*)(ws + WS_VT));
}

struct AttnP { const bf16_t* Q; int qp; const bf16_t* K; int kp; const bf16_t* Vt; bf16_t* O; int G; int HV; float cscale; const float* sink; float lam; float osc; const float* subln; };
DI int crow(int reg, int h) { return (reg & 3) + 8 * (reg >> 2) + 4 * h; }

template <int DQK, int DV, bool WIN>
DI void attn_qksm(const LAS unsigned char* kb_, const bf16x8 (&qf)[DQK / 16], f32x16 (&o)[DV / 32], bf16x8 (&pf)[2][2], float& m_run, float& l_run,
                  const float cscale, const bool domask, const int qpos, const int kp0, const int h, const int lane) {
    constexpr int KS = DQK * 2 + 16, NKS = DQK / 16, NDV = DV / 32;
    f32x16 s0, s1;
#pragma unroll
    for (int i = 0; i < 16; ++i) { s0[i] = 0.f; s1[i] = 0.f; }
    {
        constexpr int NF = 2 * NKS, KPF = 4;
        bf16x8 kf[NF];
#pragma unroll
        for (int f = 0; f < KPF && f < NF; ++f) kf[f] = *(const LAS bf16x8*)(kb_ + (f & 1) * 32 * KS + (f >> 1) * 32);
#pragma unroll
        for (int f = 0; f < NF; ++f) {
            if (f + KPF < NF) kf[f + KPF] = *(const LAS bf16x8*)(kb_ + ((f + KPF) & 1) * 32 * KS + ((f + KPF) >> 1) * 32);
            __builtin_amdgcn_sched_barrier(0);
            if (f & 1) s1 = __builtin_amdgcn_mfma_f32_32x32x16_bf16(kf[f], qf[f >> 1], s1, 0, 0, 0);
            else       s0 = __builtin_amdgcn_mfma_f32_32x32x16_bf16(kf[f], qf[f >> 1], s0, 0, 0, 0);
            __builtin_amdgcn_sched_barrier(0);
        }
    }
    if (WIN) { if (domask) {
#pragma unroll
        for (int i = 0; i < 16; ++i) { const int k0 = kp0 + crow(i, h), d0 = qpos - k0, d1 = d0 - 32;
            if (d0 > 128 || d0 < -128) s0[i] = -INFINITY; if (d1 > 128 || d1 < -128) s1[i] = -INFINITY; } } }
    float mx = -INFINITY;
#pragma unroll
    for (int i = 0; i < 16; ++i) mx = fmaxf(mx, fmaxf(s0[i], s1[i]));
    mx = fmaxf(mx, shx(mx, 32, lane)) * cscale;
    if (!__all(mx <= m_run + ATT_THR)) {
        const float m_new = fmaxf(m_run, mx);
        const float alpha = __builtin_amdgcn_exp2f(m_run - m_new);
        l_run *= alpha; m_run = m_new;
#pragma unroll
        for (int d = 0; d < NDV; ++d)
#pragma unroll
            for (int i = 0; i < 16; ++i) o[d][i] *= alpha;
    }
    float rs = 0.f;
#pragma unroll
    for (int i = 0; i < 16; ++i) { s0[i] = __builtin_amdgcn_exp2f(fmaf(s0[i], cscale, -m_run)); s1[i] = __builtin_amdgcn_exp2f(fmaf(s1[i], cscale, -m_run)); rs += s0[i] + s1[i]; }
    rs += shx(rs, 32, lane);
    l_run += rs;
#pragma unroll
    for (int s = 0; s < 2; ++s) {
        u32x4 w0, w1;
        w0.x = pk2(s0[8 * s + 0], s0[8 * s + 1]); w0.y = pk2(s0[8 * s + 2], s0[8 * s + 3]); w0.z = pk2(s0[8 * s + 4], s0[8 * s + 5]); w0.w = pk2(s0[8 * s + 6], s0[8 * s + 7]);
        w1.x = pk2(s1[8 * s + 0], s1[8 * s + 1]); w1.y = pk2(s1[8 * s + 2], s1[8 * s + 3]); w1.z = pk2(s1[8 * s + 4], s1[8 * s + 5]); w1.w = pk2(s1[8 * s + 6], s1[8 * s + 7]);
        pf[0][s] = __builtin_bit_cast(bf16x8, w0); pf[1][s] = __builtin_bit_cast(bf16x8, w1);
    }
}
template <int DV>
DI void attn_pv(const LAS unsigned char* vb_, const bf16x8 (&pf)[2][2], f32x16 (&o)[DV / 32]) {
    constexpr int VS = 144, NDV = DV / 32;
    constexpr int NFV = NDV * 4, VPF = 4;
    bf16x8 vf[NFV];
#pragma unroll
    for (int f = 0; f < VPF && f < NFV; ++f) vf[f] = *(const LAS bf16x8*)(vb_ + (f >> 2) * 32 * VS + ((f >> 1) & 1) * 64 + (f & 1) * 32);
#pragma unroll
    for (int f = 0; f < NFV; ++f) {
        if (f + VPF < NFV) vf[f + VPF] = *(const LAS bf16x8*)(vb_ + ((f + VPF) >> 2) * 32 * VS + (((f + VPF) >> 1) & 1) * 64 + ((f + VPF) & 1) * 32);
        __builtin_amdgcn_sched_barrier(0);
        o[f >> 2] = __builtin_amdgcn_mfma_f32_32x32x16_bf16(vf[f], pf[(f >> 1) & 1][f & 1], o[f >> 2], 0, 0, 0);
        __builtin_amdgcn_sched_barrier(0);
    }
}

template <int DQK, int DV, bool DIFF, bool WIN, int PD  >
DI void attn_unit(const Ctx& C, const AttnP& P, int b, int hsel, int qt, bool ctxq, unsigned long long& probe_acc) {
    constexpr int KH = DIFF ? 2 : 1, KS = DQK * 2 + 16, VS = 144, KBYTES = KH * 64 * KS, VBYTES = DV * VS, VOFF = 2 * KBYTES;
    constexpr int KCH = DQK / 8, NKC = KH * 64 * KCH, NKL = (NKC + 511) / 512, NVC = DV * 8, NVL = NVC / 512;
    constexpr int QROWS = DIFF ? 128 : 256, NKS = DQK / 16, NDV = DV / 32;
    static_assert(2 * KBYTES + 3 * VBYTES <= RING_BYTES, "attention LDS");
    const int tid = C.tid, lane = C.lane, wave = C.wave, r = lane & 31, h = lane >> 5;
    const int grp = wave >> 2;
    const int wg = DIFF ? grp : 0, wrow = (DIFF ? (wave & 3) : wave) * 32;
    const int hq = DIFF ? 2 * hsel + wg : hsel, hk0 = DIFF ? 2 * hsel : hsel / P.G, hv = DIFF ? hsel : hsel / P.G;
    const int qrow0 = ctxq ? b * CTXL : NCTX + b * SEQ + qt * QROWS;
    int t_lo = 0, t_hi = 0;
    if (!ctxq) { if (WIN) { t_lo = 4 * qt - 2; if (t_lo < 0) t_lo = 0; t_hi = 4 * qt + 6; if (t_hi > 32) t_hi = 32; } else { t_lo = 0; t_hi = 32; } }
    const int ntile = 4 + (t_hi - t_lo);
    LAS unsigned char* lds = C.lds;
    bf16x8 qf[NKS];
    { const bf16_t* qptr = P.Q + (size_t)(qrow0 + wrow + r) * P.qp + hq * DQK + 8 * h;
#pragma unroll
      for (int ks = 0; ks < NKS; ++ks) qf[ks] = *(const bf16x8*)(qptr + ks * 16); }
    u32x4 kregA[NKL], vregA[NVL], kregB[NKL], vregB[NVL];
    const bf16_t* vbase = P.Vt + (size_t)(b * P.HV + hv) * DV * NKEY;
#define ATT_LOAD(j, KR, VR) do { const int _j = (j); const int krow0 = _j < 4 ? b * CTXL + _j * 64 : NCTX + b * SEQ + (t_lo + _j - 4) * 64; const int vkey0 = _j < 4 ? _j * 64 : CTXL + (t_lo + _j - 4) * 64; \
        _Pragma("unroll") for (int i = 0; i < NKL; ++i) { const int c = tid + i * 512; if (NKC % 512 == 0 || c < NKC) { const int kh = c / (64 * KCH), rem = c - kh * (64 * KCH), key = rem / KCH, dc = rem - key * KCH; \
            KR[i] = *(const u32x4*)(P.K + (size_t)(krow0 + key) * P.kp + (hk0 + kh) * DQK + dc * 8); } } \
        _Pragma("unroll") for (int i = 0; i < NVL; ++i) { const int c = tid + i * 512; const int dv = c >> 3, kc = c & 7; VR[i] = *(const u32x4*)(vbase + (size_t)dv * NKEY + vkey0 + kc * 8); } } while (0)
#define ATT_WRITE(t, KR, VR) do { const int _w = (t); LAS unsigned char* _kb = lds + (_w & 1) * KBYTES; LAS unsigned char* _vb = lds + VOFF + (_w % 3) * VBYTES; \
        _Pragma("unroll") for (int i = 0; i < NKL; ++i) { const int c = tid + i * 512; if (NKC % 512 == 0 || c < NKC) { const int kh = c / (64 * KCH), rem = c - kh * (64 * KCH), key = rem / KCH, dc = rem - key * KCH; \
            *(LAS u32x4*)(_kb + kh * 64 * KS + key * KS + dc * 16) = KR[i]; } } \
        _Pragma("unroll") for (int i = 0; i < NVL; ++i) { const int c = tid + i * 512; const int dv = c >> 3, kc = c & 7; LAS unsigned char* d = _vb + dv * VS + (kc >> 2) * 64 + ((kc >> 1) & 1) * 32 + (kc & 1) * 8; \
            *(LAS u32x2*)d = (u32x2){VR[i].x, VR[i].y}; *(LAS u32x2*)(d + 16) = (u32x2){VR[i].z, VR[i].w}; } } while (0)
    f32x16 o[NDV];
#pragma unroll
    for (int d = 0; d < NDV; ++d)
#pragma unroll
        for (int i = 0; i < 16; ++i) o[d][i] = 0.f;
    bf16x8 pf[2][2];
#pragma unroll
    for (int i = 0; i < 2; ++i)
#pragma unroll
        for (int k = 0; k < 2; ++k) pf[i][k] = (bf16x8){0, 0, 0, 0, 0, 0, 0, 0};
    float m_run = -INFINITY, l_run = 0.f;
    const int qpos = qt * QROWS + wrow + r;
    __syncthreads();
    ATT_LOAD(0, kregA, vregA); ATT_WRITE(0, kregA, vregA);
    if (ntile > 1) ATT_LOAD(1, kregA, vregA);
    if (PD == 2) { if (ntile > 2) ATT_LOAD(2, kregB, vregB); }
    __syncthreads();
#define ATT_KPTR(t) (lds + ((t) & 1) * KBYTES + wg * 64 * KS + r * KS + 16 * h)
#define ATT_VPTR(t) (lds + VOFF + ((t) % 3) * VBYTES + r * VS + 16 * h)
#define ATT_TILE(j, KR, VR) do { const int _t = (j); const unsigned long long _p0 = (ATT_PROBE && DIFF) ? __builtin_amdgcn_s_memtime() : 0ull; \
        if (grp == 1 && _t > 0) attn_pv<DV>(ATT_VPTR(_t - 1), pf, o); \
        attn_qksm<DQK, DV, WIN>(ATT_KPTR(_t), qf, o, pf, m_run, l_run, P.cscale, WIN && !ctxq && _t >= 4, qpos, (t_lo + _t - 4) * 64, h, lane); \
        if (grp == 0) attn_pv<DV>(ATT_VPTR(_t), pf, o); \
        const unsigned long long _p1 = (ATT_PROBE && DIFF) ? __builtin_amdgcn_s_memtime() : 0ull; \
        if (_t + 1 < ntile) ATT_WRITE(_t + 1, KR, VR); \
        const unsigned long long _p2 = (ATT_PROBE && DIFF) ? __builtin_amdgcn_s_memtime() : 0ull; \
        __syncthreads(); \
        const unsigned long long _p3 = (ATT_PROBE && DIFF) ? __builtin_amdgcn_s_memtime() : 0ull; \
        if (ATT_PROBE == 1) probe_acc += _p1 - _p0; if (ATT_PROBE == 2) probe_acc += _p2 - _p1; if (ATT_PROBE == 3) probe_acc += _p3 - _p2; \
        if (_t + 1 + PD < ntile) ATT_LOAD(_t + 1 + PD, KR, VR); } while (0)
    if (PD == 2) { for (int j = 0; j < ntile; j += 2) { ATT_TILE(j, kregA, vregA); if (j + 1 < ntile) ATT_TILE(j + 1, kregB, vregB); } }
    else { for (int j = 0; j < ntile; ++j) ATT_TILE(j, kregA, vregA); }
    if (grp == 1) attn_pv<DV>(ATT_VPTR(ntile - 1), pf, o);
#undef ATT_TILE
#undef ATT_KPTR
#undef ATT_VPTR
#undef ATT_LOAD
#undef ATT_WRITE
    float lfin = l_run, fsc = 1.0f;
    if (WIN) { const float sk = P.sink[hq] * LOG2E; const float m2 = fmaxf(m_run, sk); fsc = __builtin_amdgcn_exp2f(m_run - m2); lfin = l_run * fsc + __builtin_amdgcn_exp2f(sk - m2); }
    const float inv = fsc / lfin;
    bf16_t* orow = P.O + (size_t)(qrow0 + wrow + r) * DM;
    if (!DIFF) {
#pragma unroll
        for (int d = 0; d < NDV; ++d)
#pragma unroll
            for (int g = 0; g < 4; ++g) { u32x2 w; w.x = pk2(o[d][4 * g] * inv, o[d][4 * g + 1] * inv); w.y = pk2(o[d][4 * g + 2] * inv, o[d][4 * g + 3] * inv);
                *(u32x2*)(orow + hq * DV + d * 32 + 8 * g + 4 * h) = w; }
    } else {
        LAS float* o2 = (LAS float*)lds;
        if (wg == 1) {
#pragma unroll
            for (int d = 0; d < NDV; ++d)
#pragma unroll
                for (int g = 0; g < 4; ++g) *(LAS f32x4*)(o2 + (wrow + r) * 132 + d * 32 + 8 * g + 4 * h) = (f32x4){o[d][4 * g] * inv, o[d][4 * g + 1] * inv, o[d][4 * g + 2] * inv, o[d][4 * g + 3] * inv};
        }
        __syncthreads();
        if (wg == 0) {
            float ssq = 0.f;
#pragma unroll
            for (int d = 0; d < NDV; ++d)
#pragma unroll
                for (int g = 0; g < 4; ++g) { const f32x4 t = *(const LAS f32x4*)(o2 + (wrow + r) * 132 + d * 32 + 8 * g + 4 * h);
#pragma unroll
                    for (int i = 0; i < 4; ++i) { const float v = o[d][4 * g + i] * inv - P.lam * t[i]; o[d][4 * g + i] = v; ssq += v * v; } }
            ssq += shx(ssq, 32, lane);
            const float rn = P.osc / sqrtf(ssq * (1.0f / DV) + NORM_EPS);
#pragma unroll
            for (int d = 0; d < NDV; ++d)
#pragma unroll
                for (int g = 0; g < 4; ++g) { const int dv = d * 32 + 8 * g + 4 * h; const f32x4 sg = *(const f32x4*)(P.subln + dv);
                    u32x2 w; w.x = pk2(o[d][4 * g] * rn * sg[0], o[d][4 * g + 1] * rn * sg[1]); w.y = pk2(o[d][4 * g + 2] * rn * sg[2], o[d][4 * g + 3] * rn * sg[3]);
                    *(u32x2*)(orow + hsel * DV + dv) = w; }
        }
    }
}

DI AttnP attn_base(unsigned char* ws) { AttnP P; P.Vt = (const bf16_t*)(ws + WS_VT); P.O = (bf16_t*)(ws + WS_O); P.sink = nullptr; P.lam = 0.f; P.osc = 1.f; P.subln = nullptr; return P; }
DI void ph_attn0(int wave_s, unsigned char* ws0) {
    unsigned long long pacc = 0ull;
    const Ctx C = make_ctx(ws0, wave_s); unsigned char* ws = C.ws; const float* sink = inp(C, I_WIN_SINK); AttnP P = attn_base(ws); const bf16_t* RAW = (const bf16_t*)(ws + WS_RAW);
    P.Q = RAW; P.qp = 1536; P.K = RAW + 1024; P.kp = 1536; P.G = 4; P.HV = 4; P.cscale = 0.125f * LOG2E; P.sink = sink;
    for (int u = C.vcu; u < 1024 + 128; u += C.G) {
        if (u < 1024) { const int b = u >> 7, rem = u & 127; attn_unit<64, 64, false, true, 2>(C, P, b, rem >> 3, rem & 7, false, pacc); }
        else { const int v = u - 1024; attn_unit<64, 64, false, true, 2>(C, P, v >> 4, v & 15, 0, true, pacc); }
    }
}
DI void ph_attn1(int wave_s, unsigned char* ws0) {
    unsigned long long pacc = 0ull;
    const Ctx C = make_ctx(ws0, wave_s); unsigned char* ws = C.ws; AttnP P = attn_base(ws); const bf16_t* RAW = (const bf16_t*)(ws + WS_RAW);
    P.Q = RAW; P.qp = 1536; P.K = RAW + 1024; P.kp = 1536; P.G = 4; P.HV = 2; P.cscale = 0.08838834764831845f * LOG2E;
    for (int u = C.vcu; u < 512 + 64; u += C.G) {
        if (u < 512) { const int b = u >> 6, rem = u & 63; attn_unit<128, 128, false, false, 1>(C, P, b, rem >> 3, rem & 7, false, pacc); }
        else { const int v = u - 512; attn_unit<128, 128, false, false, 1>(C, P, v >> 3, v & 7, 0, true, pacc); }
    }
}
DI void ph_attn2(int wave_s, unsigned char* ws0) {
    unsigned long long pacc = 0ull;
    const Ctx C = make_ctx(ws0, wave_s); unsigned char* ws = C.ws; AttnP P = attn_base(ws);
    P.Q = (const bf16_t*)(ws + WS_Q2); P.qp = 1536; P.K = (const bf16_t*)(ws + WS_KF); P.kp = 1536; P.G = 1; P.HV = 16; P.cscale = 0.10206207261596577f * LOG2E;
    for (int u = C.vcu; u < 1024 + 128; u += C.G) {
        if (u < 1024) { const int b = u >> 7, rem = u & 127; attn_unit<96, 64, false, false, 2>(C, P, b, rem >> 3, rem & 7, false, pacc); }
        else { const int v = u - 1024; attn_unit<96, 64, false, false, 2>(C, P, v >> 4, v & 15, 0, true, pacc); }
    }
}
DI void ph_attn3(int wave_s, unsigned char* ws0) {
    unsigned long long pacc = 0ull;
    const Ctx C = make_ctx(ws0, wave_s); unsigned char* ws = C.ws; const float* lp = inp(C, I_DIFF_LAM); const float* subln = inp(C, I_DIFF_SUBLN); AttnP P = attn_base(ws); const bf16_t* RAW = (const bf16_t*)(ws + WS_RAW);
    P.Q = RAW; P.qp = 3072; P.K = RAW + 1024; P.kp = 3072; P.G = 1; P.HV = 8; P.cscale = 0.125f * LOG2E; P.subln = subln;
    const float linit = 0.8f - 0.6f * expf(-0.3f * 3.0f);
    const float s1 = wave_sum(lp[C.lane] * lp[64 + C.lane], C.lane), s2 = wave_sum(lp[128 + C.lane] * lp[192 + C.lane], C.lane);
    P.lam = expf(s1) - expf(s2) + linit; P.osc = 1.0f - linit;
    for (int u = C.vcu; u < 1024; u += C.G) { const int b = u >> 7, rem = u & 127; attn_unit<64, 128, true, false, 2>(C, P, b, rem >> 4, rem & 15, false, pacc); }
    if (ATT_PROBE) { const unsigned long long t0 = __builtin_amdgcn_s_memtime(); while (__builtin_amdgcn_s_memtime() - t0 < pacc) __builtin_amdgcn_s_sleep(8); }
}

DI void moe_tables(const Ctx& C, int l) {
    const unsigned* cnt = (const unsigned*)(C.ws + WS_CTL) + CW_CNT + l * 32;
    __syncthreads();
    if (C.tid == 0) {
        unsigned t = 0, c = 0;
#pragma nounroll
        for (int e = 0; e < NEXP; ++e) { const unsigned n = __hip_atomic_load(cnt + e, __ATOMIC_RELAXED, __HIP_MEMORY_SCOPE_AGENT); C.misc[MW_TP + e] = t; C.misc[MW_CP + e] = c; C.misc[MW_CN + e] = n; const unsigned nt = (n + 255u) >> 8;
            for (unsigned i = 0; i < nt; ++i) C.misc[MW_TEXP + t + i] = (unsigned)e; t += nt; c += n; }
        C.misc[MW_TP + 32] = t; C.misc[MW_CP + 32] = c;
    }
    __syncthreads();
    __builtin_amdgcn_sched_barrier(0);
}

DI void ln1_rows2(const Ctx& C, int l, int row0, int row1, bool two) {
    unsigned char* ws = C.ws; float* X = (float*)(ws + WS_X); const float* Y = (const float*)(ws + WS_Y); bf16_t* H = (bf16_t*)(ws + WS_H); bf16_t* HLO = (bf16_t*)(ws + WS_HLO);
    f32x4 xa[4], ya[4], xb[4], yb[4];
    ld_row(X + (size_t)row0 * DM, C.lane, xa); ld_row(Y + (size_t)row0 * DM, C.lane, ya);
    if (two) { ld_row(X + (size_t)row1 * DM, C.lane, xb); ld_row(Y + (size_t)row1 * DM, C.lane, yb); }
#pragma unroll
    for (int rr = 0; rr < 2; ++rr) {
        if (rr == 1 && !two) break;
        const int row = rr ? row1 : row0; const int m = modidx(row);
        f32x4 x[4], g1[4], h[4]; ld_row(modp(C, l, m, 2), C.lane, g1);
#pragma unroll
        for (int j = 0; j < 4; ++j) x[j] = (rr ? xb[j] : xa[j]) * DN_ALPHA + g1[j] * (rr ? yb[j] : ya[j]);
        layernorm_row(x, inp(C, I_LN1G) + l * DM, inp(C, I_LN1B) + l * DM, C.lane);
        st_row(X + (size_t)row * DM, C.lane, x);
        modulate_row(x, modp(C, l, m, 3), modp(C, l, m, 4), C.lane, h);
#pragma unroll
        for (int j = 0; j < 4; ++j) {
            u32x2 whi; whi.x = pk2(h[j][0], h[j][1]); whi.y = pk2(h[j][2], h[j][3]);
            u32x2 wlo; wlo.x = pk2(h[j][0] - bf_lo(whi.x), h[j][1] - bf_hi(whi.x)); wlo.y = pk2(h[j][2] - bf_lo(whi.y), h[j][3] - bf_hi(whi.y));
            *(u32x2*)(H + (size_t)row * DM + j * 256 + C.lane * 4) = whi; *(u32x2*)(HLO + (size_t)row * DM + j * 256 + C.lane * 4) = wlo;
        }
    }
}
DI void phase_ln1(int wave_s, unsigned char* ws0, int l) {
    const Ctx C = make_ctx(ws0, wave_s); unsigned char* ws = C.ws;
    LAS float* part = (LAS float*)C.lds;
    LAS float* logits = part + 8 * 80 * 33;
    LAS int* lsel = (LAS int*)(logits + 80 * 33);
    LAS int* lslot = lsel + 288;
    LAS int* lrank = lslot + 288;
    LAS int* lcnt = lrank + 288;
    LAS int* lbase = lcnt + 32;
    const int rbase = l == 3 ? NCTX : 0, nrows = NT - rbase;
    const int rpb = (nrows + C.G - 1) / C.G;
    const int brow0 = rbase + C.vcu * rpb; int bn = NT - brow0; if (bn > rpb) bn = rpb; if (bn < 0) bn = 0; if (bn > 72) bn = 72;
    for (int i = C.wave; i < bn; i += 16) ln1_rows2(C, l, brow0 + i, brow0 + i + 8, i + 8 < bn);
    if (C.tid < 32) lcnt[C.tid] = 0;
    asm volatile("s_waitcnt vmcnt(0)" ::: "memory");
    __syncthreads();
    const bf16_t* H = (const bf16_t*)(ws + WS_H); const bf16_t* HLO = (const bf16_t*)(ws + WS_HLO);
    const bf16_t* RWH = (const bf16_t*)(ws + WS_RWT) + (size_t)l * 2 * 32 * 1024; const bf16_t* RWL = RWH + 32 * 1024;
    const float* rb = inp(C, I_RB) + l * NEXP; float* gate = (float*)(ws + WS_GATE);
    const int ntile = (bn + 15) >> 4;
    if (bn > 0) {
        const int fr = C.lane & 15, fq = C.lane >> 4, kw = C.wave * 128 + fq * 8;
        f32x4 acc[5][2];
#pragma unroll
        for (int t = 0; t < 5; ++t) { acc[t][0] = (f32x4){0.f, 0.f, 0.f, 0.f}; acc[t][1] = (f32x4){0.f, 0.f, 0.f, 0.f}; }
#pragma unroll
        for (int ks = 0; ks < 4; ++ks) {
            const int k0 = kw + ks * 32;
            const bf16x8 bh0 = *(const bf16x8*)(RWH + (size_t)fr * DM + k0), bl0 = *(const bf16x8*)(RWL + (size_t)fr * DM + k0);
            const bf16x8 bh1 = *(const bf16x8*)(RWH + (size_t)(16 + fr) * DM + k0), bl1 = *(const bf16x8*)(RWL + (size_t)(16 + fr) * DM + k0);
#pragma unroll
            for (int t = 0; t < 5; ++t) if (t < ntile) {
                int ar = t * 16 + fr; if (ar >= bn) ar = bn - 1;
                const bf16x8 ah = *(const bf16x8*)(H + (size_t)(brow0 + ar) * DM + k0), al = *(const bf16x8*)(HLO + (size_t)(brow0 + ar) * DM + k0);
                acc[t][0] = __builtin_amdgcn_mfma_f32_16x16x32_bf16(ah, bh0, acc[t][0], 0, 0, 0); acc[t][0] = __builtin_amdgcn_mfma_f32_16x16x32_bf16(al, bh0, acc[t][0], 0, 0, 0); acc[t][0] = __builtin_amdgcn_mfma_f32_16x16x32_bf16(ah, bl0, acc[t][0], 0, 0, 0);
                acc[t][1] = __builtin_amdgcn_mfma_f32_16x16x32_bf16(ah, bh1, acc[t][1], 0, 0, 0); acc[t][1] = __builtin_amdgcn_mfma_f32_16x16x32_bf16(al, bh1, acc[t][1], 0, 0, 0); acc[t][1] = __builtin_amdgcn_mfma_f32_16x16x32_bf16(ah, bl1, acc[t][1], 0, 0, 0);
            }
        }
        LAS float* pw = part + C.wave * 80 * 33;
#pragma unroll
        for (int t = 0; t < 5; ++t) if (t < ntile) {
#pragma unroll
            for (int i = 0; i < 4; ++i) { pw[(t * 16 + 4 * fq + i) * 33 + fr] = acc[t][0][i]; pw[(t * 16 + 4 * fq + i) * 33 + 16 + fr] = acc[t][1][i]; } }
    }
    __syncthreads();
    for (int idx = C.tid; idx < bn * 32; idx += 512) { const int r = idx >> 5, e = idx & 31; float sm = 0.f;
#pragma unroll
        for (int w = 0; w < 8; ++w) sm += part[(w * 80 + r) * 33 + e];
        logits[r * 33 + e] = sm + rb[e]; }
    __syncthreads();
    if (C.tid < bn) {
        const int r = C.tid, li = r * 4, grow = brow0 + r;
        float v0 = -INFINITY, v1 = -INFINITY, v2 = -INFINITY, v3 = -INFINITY; int i0 = 0, i1 = 0, i2 = 0, i3 = 0;
        for (int e = 0; e < 32; ++e) { const float x = logits[r * 33 + e];
            if (x > v3) { if (x > v2) { v3 = v2; i3 = i2; if (x > v1) { v2 = v1; i2 = i1; if (x > v0) { v1 = v0; i1 = i0; v0 = x; i0 = e; } else { v1 = x; i1 = e; } } else { v2 = x; i2 = e; } } else { v3 = x; i3 = e; } } }
        const float e1 = expf(v1 - v0), e2 = expf(v2 - v0), e3 = expf(v3 - v0), inv = 1.0f / (1.0f + e1 + e2 + e3);
        lsel[li] = i0; lsel[li + 1] = i1; lsel[li + 2] = i2; lsel[li + 3] = i3;
        lslot[li] = grow * 4; lslot[li + 1] = grow * 4 + 1; lslot[li + 2] = grow * 4 + 2; lslot[li + 3] = grow * 4 + 3;
        *(f32x4*)(gate + (size_t)grow * 4) = (f32x4){inv, e1 * inv, e2 * inv, e3 * inv};
    }
    __syncthreads();
    const int nsel = bn * 4;
    if (C.tid < nsel) lrank[C.tid] = __hip_atomic_fetch_add(lcnt + lsel[C.tid], 1, __ATOMIC_RELAXED, __HIP_MEMORY_SCOPE_WORKGROUP);
    __syncthreads();
    if (C.tid < 32) { const int n = lcnt[C.tid]; int base = 0;
        if (n) base = (int)__hip_atomic_fetch_add((unsigned*)(ws + WS_CTL) + CW_CNT + l * 32 + C.tid, (unsigned)n, __ATOMIC_RELAXED, __HIP_MEMORY_SCOPE_AGENT);
        lbase[C.tid] = base; }
    __syncthreads();
    if (C.tid < nsel) { const int e = lsel[C.tid]; ((int*)(ws + WS_LIST))[(size_t)e * CAP + lbase[e] + lrank[C.tid]] = lslot[C.tid]; }
    __syncthreads();
}

DI void phase_ln2(int wave_s, unsigned char* ws0, int l) {
    const Ctx C = make_ctx(ws0, wave_s); unsigned char* ws = C.ws; float* X = (float*)(ws + WS_X); bf16_t* H = (bf16_t*)(ws + WS_H); const bf16_t* YS = (const bf16_t*)(ws + WS_YS);
    const int r0 = l == 3 ? NCTX : 0;
    for (int rowa = r0 + C.vcu * 8 + C.wave; rowa < NT; rowa += 2 * C.G * 8) {
        const int rowb = rowa + C.G * 8; const bool two = rowb < NT;
        f32x4 xs[2][4], ys[2][4];
#pragma unroll
        for (int rr = 0; rr < 2; ++rr) { if (rr == 1 && !two) break; const int row = rr ? rowb : rowa;
            ld_row(X + (size_t)row * DM, C.lane, xs[rr]);
            u32x2 w[4][4];
#pragma unroll
            for (int k = 0; k < 4; ++k)
#pragma unroll
                for (int j = 0; j < 4; ++j) w[k][j] = *(const u32x2*)(YS + ((size_t)row * 4 + k) * DM + j * 256 + C.lane * 4);
#pragma unroll
            for (int j = 0; j < 4; ++j) { ys[rr][j] = (f32x4){0.f, 0.f, 0.f, 0.f};
#pragma unroll
                for (int k = 0; k < 4; ++k) ys[rr][j] += (f32x4){bf_lo(w[k][j].x), bf_hi(w[k][j].x), bf_lo(w[k][j].y), bf_hi(w[k][j].y)}; } }
#pragma unroll
        for (int rr = 0; rr < 2; ++rr) { if (rr == 1 && !two) break; const int row = rr ? rowb : rowa; const int m = modidx(row);
            f32x4 x[4], g2[4]; ld_row(modp(C, l, m, 5), C.lane, g2);
#pragma unroll
            for (int j = 0; j < 4; ++j) x[j] = xs[rr][j] * DN_ALPHA + g2[j] * ys[rr][j];
            layernorm_row(x, inp(C, I_LN2G) + l * DM, inp(C, I_LN2B) + l * DM, C.lane);
            if (l == 3) { st_row((float*)inp(C, 36) + (size_t)(row - NCTX) * DM, C.lane, x); }
            else { st_row(X + (size_t)row * DM, C.lane, x); f32x4 h[4]; modulate_row(x, modp(C, l + 1, m, 0), modp(C, l + 1, m, 1), C.lane, h); st_row_bf(H + (size_t)row * DM, C.lane, h); } }
    }
}

DI void ph_gemm_bf16(int wave_s, unsigned char* ws0, const bf16_t* A, const bf16_t* Bt, int M, int N, int K, bf16_t* out, int ldc, int bias_idx) {
    const Ctx C = make_ctx(ws0, wave_s); const float* bias = bias_idx >= 0 ? inp(C, bias_idx) : nullptr;
    pg8::DenseOrder S; S.nN = N / 256; S.nunits = (M / 256) * S.nN; S.G = C.G; S.c = C.vcu; S.r0 = 0; S.step = 256u * (unsigned)K * 2u;
    pg8::EpiBf16 E{out, ldc, bias};
    pg8::gemm_phase<false, pg8::EpiBf16, pg8::DenseOrder>(C.lds, nullptr, nullptr, C.tid, K, pg8::make_rsrc(A), pg8::make_rsrc(Bt), S, E);
}
DI void ph_gemm_wo(int wave_s, unsigned char* ws0, const bf16_t* W, int r0, int bias_idx) {
    const Ctx C = make_ctx(ws0, wave_s); unsigned char* ws = C.ws; const float* bias = bias_idx >= 0 ? inp(C, bias_idx) : nullptr;
    pg8::DenseOrder S; S.nN = 4; S.nunits = ((NT - r0) / 256) * 4; S.G = C.G; S.c = C.vcu; S.r0 = r0; S.step = 256u * 1024u * 2u;
    pg8::EpiF32 E{(float*)(ws + WS_Y), DM, bias};
    pg8::gemm_phase<false, pg8::EpiF32, pg8::DenseOrder>(C.lds, nullptr, nullptr, C.tid, 1024, pg8::make_rsrc((const bf16_t*)(ws + WS_O) + (size_t)r0 * DM), pg8::make_rsrc(W), S, E);
}
DI void ph_moe1(int wave_s, unsigned char* ws0, int l) {
    const Ctx C = make_ctx(ws0, wave_s); unsigned char* ws = C.ws; const float* b_in = inp(C, I_BIN);
    moe_tables(C, l);
    pg8::MoeOrder<3, 2048> S; S.misc = C.misc; S.G = C.G; S.c = C.vcu;
    pg8::EpiSwiglu E{(bf16_t*)(ws + WS_ACT), b_in + (size_t)l * 32 * 2048};
    pg8::gemm_phase<true, pg8::EpiSwiglu, pg8::MoeOrder<3, 2048>>(C.lds, (LAS int*)(C.lds + MISC_OFF) + MW_IDX, (const int*)(ws + WS_LIST), C.tid, 1024,
        pg8::make_rsrc(ws + WS_H), pg8::make_rsrc(ws + WS_WIN + (size_t)l * 32 * 2048 * 1024 * 2), S, E);
}
DI void ph_moe2(int wave_s, unsigned char* ws0, int l) {
    const Ctx C = make_ctx(ws0, wave_s); unsigned char* ws = C.ws; const float* b_out = inp(C, I_BOUT);
    moe_tables(C, l);
    pg8::MoeOrder<2, 1024> S; S.misc = C.misc; S.G = C.G; S.c = C.vcu;
    pg8::EpiMoe2 E{(bf16_t*)(ws + WS_YS), b_out + (size_t)l * 32 * 1024, (const float*)(ws + WS_GATE), (const int*)(ws + WS_LIST)};
    pg8::gemm_phase<false, pg8::EpiMoe2, pg8::MoeOrder<2, 1024>>(C.lds, nullptr, nullptr, C.tid, 1024,
        pg8::make_rsrc(ws + WS_ACT), pg8::make_rsrc(ws + WS_WOUT + (size_t)l * 32 * 1024 * 1024 * 2), S, E);
}

constexpr int NPHASE = 2 + 11 * DEPTH;

__global__ void __launch_bounds__(512, 2) dit_fwd(Args args) {
    {
        LAS unsigned* mz = (LAS unsigned*)((LAS unsigned char*)lds_raw + MISC_OFF);
        for (int u = threadIdx.x; u < (LDS_BYTES - MISC_OFF) / 4; u += 512) mz[u] = 0u;
        __syncthreads();
        if (threadIdx.x == 0) {
#pragma unroll
            for (int i = 0; i < 36; ++i) { const unsigned long long p = (unsigned long long)args.in[i]; mz[MW_PTR + 2 * i] = (unsigned)p; mz[MW_PTR + 2 * i + 1] = (unsigned)(p >> 32); }
            const unsigned long long p = (unsigned long long)args.out; mz[MW_PTR + 72] = (unsigned)p; mz[MW_PTR + 73] = (unsigned)(p >> 32);
        }
        __syncthreads();
    }
    const int wave_s = __builtin_amdgcn_readfirstlane((int)threadIdx.x >> 6);
    const int lo = args.ph_lo, hi = args.ph_hi;
    unsigned char* ws = args.ws;
    XcdBarrier bar; bar.bar = (unsigned*)(ws + WS_CTL) + CW_BAR; bar.x = 0; bar.st = nullptr;
    if (hi - lo > 1) bar = xcd_barrier_post((unsigned*)(ws + WS_CTL) + CW_BAR, (volatile LAS unsigned*)((LAS unsigned char*)lds_raw + MISC_OFF) + 8);
#define IN(k) (lo <= (k) && (k) < hi)
#define SEAM(k) do { if ((k) + 1 < hi) xcd_barrier(bar); } while (0)
    bf16_t* wsm = (bf16_t*)(ws + WS_WSMALL);
    if (IN(0)) { PREP(0) phase_prologue(wave_s, ws); SEAM(0); }
    if (IN(1)) { phase_modh0(wave_s, ws); SEAM(1); }
    for (int l = 0; l < DEPTH; ++l) {
        const int pb = 2 + 11 * l;
        if (IN(pb + 0)) {
            const bf16_t* W = wsm + (l == 0 ? OFF_WQKV0 : l == 1 ? OFF_WQKV1 : l == 2 ? OFF_WA : OFF_WQKV3) / 2;
            const int N = l == 2 ? 768 : (l == 3 ? 3072 : 1536);
            PREP(1) ph_gemm_bf16(wave_s, ws, (const bf16_t*)(ws + WS_H), W, NT, N, 1024, (bf16_t*)(ws + WS_RAW), N, l == 0 ? (int)I_WIN_BQKV : -1);
            SEAM(pb + 0);
        }
        if (IN(pb + 1)) { phase_post(wave_s, ws, l); SEAM(pb + 1); }
        if (l == 2) {
            if (IN(pb + 2)) {
                PREP(1) for (int j = 0; j < 2; ++j)
                    ph_gemm_bf16(wave_s, ws, (const bf16_t*)(ws + (j == 0 ? WS_CQ : WS_CKV)), wsm + (j == 0 ? OFF_WQB : OFF_WKVB) / 2, NT, j == 0 ? 1536 : 2048, j == 0 ? 384 : 256,
                                 (bf16_t*)(ws + (j == 0 ? WS_Q2 : WS_KV2)), j == 0 ? 1536 : 2048, -1);
                SEAM(pb + 2);
            }
            if (IN(pb + 3)) { phase_postb(wave_s, ws); SEAM(pb + 3); }
        }
        if (IN(pb + 4)) {
            PREP(2) if (l == 0) ph_attn0(wave_s, ws); else if (l == 1) ph_attn1(wave_s, ws); else if (l == 2) ph_attn2(wave_s, ws); else ph_attn3(wave_s, ws);
            SEAM(pb + 4);
        }
        if (IN(pb + 5)) {
            const bf16_t* W = wsm + (l == 0 ? OFF_WO0 : l == 1 ? OFF_WO1 : l == 2 ? OFF_WO2 : OFF_WO3) / 2;
            PREP(3) ph_gemm_wo(wave_s, ws, W, l == 3 ? NCTX : 0, l == 0 ? (int)I_WIN_BO : -1);
            SEAM(pb + 5);
        }
        if (IN(pb + 6)) { phase_ln1(wave_s, ws, l); SEAM(pb + 6); }
        if (IN(pb + 8)) { PREP(5) ph_moe1(wave_s, ws, l); SEAM(pb + 8); }
        if (IN(pb + 9)) { PREP(6) ph_moe2(wave_s, ws, l); SEAM(pb + 9); }
        if (IN(pb + 10)) { phase_ln2(wave_s, ws, l); SEAM(pb + 10); }
    }
#undef IN
#undef SEAM
}

extern "C" void kernel_launch(void* const* d_in, const int* in_sizes, int n_in, void* d_out, int out_size, void* d_ws, size_t ws_size, hipStream_t stream) {
    static int grid = 0;
    if (grid == 0) {
        if (n_in != 36 || out_size != NB * SEQ * DM || ws_size < WS_END) { fprintf(stderr, "kernel_launch: unexpected shapes (n_in %d out %d ws %zu need %zu)\n", n_in, out_size, ws_size, (size_t)WS_END); grid = -1; return; }
        int dev = 0, cus = 0, per_cu = 0;
        if (hipGetDevice(&dev) != hipSuccess || hipDeviceGetAttribute(&cus, hipDeviceAttributeMultiprocessorCount, dev) != hipSuccess) { grid = -1; return; }
        if (hipFuncSetAttribute((const void*)dit_fwd, hipFuncAttributeMaxDynamicSharedMemorySize, LDS_BYTES) != hipSuccess) { fprintf(stderr, "kernel_launch: hipFuncSetAttribute failed\n"); grid = -1; return; }
        if (hipOccupancyMaxActiveBlocksPerMultiprocessor(&per_cu, (const void*)dit_fwd, 512, LDS_BYTES) != hipSuccess || per_cu < 1) fprintf(stderr, "kernel_launch: occupancy query says %d\n", per_cu);
        (void)hipGetLastError();
        grid = cus;
    }
    if (grid < 0) return;
    (void)hipMemsetAsync((char*)d_ws + WS_CTL, 0, CTL_BYTES, stream);
    Args a{};
    for (int i = 0; i < 36; ++i) a.in[i] = (const float*)d_in[i];
    a.out = (float*)d_out; a.ws = (unsigned char*)d_ws;
#if MK_PER_PHASE
    for (int ph = 0; ph < NPHASE; ++ph) {
        const int l = ph < 2 ? 0 : (ph - 2) / 11, s = ph < 2 ? 0 : (ph - 2) % 11;
        if (ph >= 2 && (s == 2 || s == 3) && l != 2) continue;
        a.ph_lo = ph; a.ph_hi = ph + 1;
        hipLaunchKernelGGL(dit_fwd, dim3(grid), dim3(512), LDS_BYTES, stream, a);
    }
#else
    a.ph_lo = 0; a.ph_hi = NPHASE;
    hipLaunchKernelGGL(dit_fwd, dim3(grid), dim3(512), LDS_BYTES, stream, a);
#endif
    const hipError_t le = hipPeekAtLastError();
    if (le != hipSuccess) fprintf(stderr, "kernel_launch: launch failed: %s\n", hipGetErrorName(le));
}
```
